# Optimizing an MI355X kernel written in HIP

```python
import math
import jax
import jax.numpy as jnp
from jax import lax
import numpy as np

D_MODEL = 1024
BATCH = 16
SEQ = 2048
DEPTH = 1

HY_WIDTH = 768
HY_ORDER = 2
HY_SHORT_CONV = 3
HY_EMB_DIM = 33
HY_FILTER_HIDDEN = 64
HY_FAST_DECAY = 0.3
HY_SLOW_DECAY = 1.5
HY_DECAY_TARGET = 1e-2
HY_MOD_SHIFT = 0.0
HEAD_DIM = 64
HEADS_PER_GROUP = 8
DILATED_GROUPS = ((128, 1), (512, 4), (2048, 16))
N_GROUPS = 3
AT_HEADS = N_GROUPS * HEADS_PER_GROUP
AT_QKV = AT_HEADS * HEAD_DIM
AT_WIDTH = HEADS_PER_GROUP * HEAD_DIM
BAND_BLOCK = 64
NORM_EPS = 1e-6
NEG_INF = -1e30
IN_COLS = 3 * HY_WIDTH + HY_WIDTH + 3 * AT_QKV + AT_WIDTH + 2 * D_MODEL

kernel_name = 'hybrid_hyena_dilated_attn_encoder_block'


def _rmsnorm(x, g):
    xf = x.astype(jnp.float32)
    y = xf * lax.rsqrt(jnp.mean(xf * xf, axis=-1, keepdims=True) + NORM_EPS)
    return (y * g.astype(jnp.float32)).astype(x.dtype)


def _alibi_slopes(n):
    return 2.0 ** (-8.0 * jnp.arange(1, n + 1, dtype=jnp.float32) / n)


def _short_conv(z, w, b):
    L = z.shape[1]
    p = HY_SHORT_CONV // 2
    zp = jnp.pad(z, ((0, 0), (p, p), (0, 0)))
    out = b
    for j in range(HY_SHORT_CONV):
        out = out + zp[:, j:j + L] * w[j]
    return out


def _hyena_filters(L, w1, b1, w2, b2, w3, b3, w4, freq):
    f32 = jnp.float32
    t = jnp.linspace(0.0, 1.0, L, dtype=f32)[:, None]
    bands = (HY_EMB_DIM - 1) // 2
    w = 2.0 * math.pi * jnp.arange(L, dtype=f32)[:, None] / L
    f = jnp.linspace(1e-4, bands - 1, bands, dtype=f32)[None, :]
    z = jnp.concatenate([t, jnp.cos(f * w), -jnp.sin(f * w)], axis=-1)
    fr = freq.astype(f32)
    h = jnp.sin(fr * (z @ w1.astype(f32) + b1.astype(f32)))
    h = jnp.sin(fr * (h @ w2.astype(f32) + b2.astype(f32)))
    h = jnp.sin(fr * (h @ w3.astype(f32) + b3.astype(f32)))
    h = (h @ w4.astype(f32)).reshape(L, HY_ORDER, 2, HY_WIDTH)
    max_decay = math.log(HY_DECAY_TARGET) / HY_FAST_DECAY
    min_decay = math.log(HY_DECAY_TARGET) / HY_SLOW_DECAY
    deltas = jnp.linspace(min_decay, max_decay, HY_WIDTH, dtype=f32)
    decay = jnp.exp(-t * jnp.abs(deltas)[None, :])
    h = h * (decay + HY_MOD_SHIFT)[:, None, None, :]
    h_fwd, h_bwd = h[:, :, 0], h[:, :, 1]
    k_circ = jnp.concatenate([h_fwd, jnp.zeros((1, HY_ORDER, HY_WIDTH), f32), h_bwd[1:][::-1]], axis=0)
    return jnp.fft.rfft(k_circ, axis=0)


def _fft_conv(u, k_f, skip):
    L = u.shape[1]
    U = jnp.fft.rfft(u, n=2 * L, axis=1)
    y = jnp.fft.irfft(U * k_f[None], n=2 * L, axis=1)[:, :L]
    return y + u * skip.astype(jnp.float32)


def _hyena(z_in, conv_w, conv_b, w1, b1, w2, b2, w3, b3, w4, freq, skip):
    L = z_in.shape[1]
    zc = _short_conv(z_in, conv_w, conv_b).astype(jnp.float32)
    v, x1, x2 = jnp.split(zc, 3, axis=-1)
    k_f = _hyena_filters(L, w1, b1, w2, b2, w3, b3, w4, freq)
    y = x1 * _fft_conv(v, k_f[:, 0], skip[0])
    y = x2 * _fft_conv(y, k_f[:, 1], skip[1])
    return y


def _band_group(q, k, v, window, dilation, slopes):
    B, H, S, Dh = q.shape
    half = window // (2 * dilation)
    n = S // dilation
    nb = -(-n // BAND_BLOCK)
    pad = nb * BAND_BLOCK - n

    def to_blocks(t):
        t = t.reshape(B, H, n, dilation, Dh).transpose(0, 1, 3, 2, 4)
        t = jnp.pad(t, ((0, 0), (0, 0), (0, 0), (0, pad), (0, 0)))
        return t.reshape(B, H, dilation, nb, BAND_BLOCK, Dh)

    def band(t):
        tp = jnp.pad(t, ((0, 0), (0, 0), (0, 0), (1, 1), (0, 0), (0, 0)))
        return jnp.concatenate([tp[:, :, :, :-2], tp[:, :, :, 1:-1], tp[:, :, :, 2:]], axis=4)

    qb = to_blocks(q)
    kw = band(to_blocks(k))
    vw = band(to_blocks(v))
    qi = jnp.arange(nb)[:, None] * BAND_BLOCK + jnp.arange(BAND_BLOCK)[None, :]
    ki = (jnp.arange(nb)[:, None] - 1) * BAND_BLOCK + jnp.arange(3 * BAND_BLOCK)[None, :]
    rel = qi[:, :, None] - ki[:, None, :]
    valid = (jnp.abs(rel) <= half) & (ki[:, None, :] >= 0) & (ki[:, None, :] < n)
    dist = (dilation * jnp.abs(rel)).astype(jnp.float32)
    s = jnp.einsum('bhrnqd,bhrnkd->bhrnqk', qb, kw) * (HEAD_DIM ** -0.5)
    s = s - slopes[None, :, None, None, None, None] * dist[None, None, None]
    s = jnp.where(valid[None, None, None], s, NEG_INF)
    m = jnp.max(s, axis=-1)
    p = jnp.exp(s - m[..., None])
    den = jnp.sum(p, axis=-1)
    o = jnp.einsum('bhrnqk,bhrnkd->bhrnqd', p, vw) / den[..., None]
    lse = m + jnp.log(den)
    o = o.reshape(B, H, dilation, nb * BAND_BLOCK, Dh)[:, :, :, :n].transpose(0, 1, 3, 2, 4).reshape(B, H, S, Dh)
    lse = lse.reshape(B, H, dilation, nb * BAND_BLOCK)[:, :, :, :n].transpose(0, 1, 3, 2).reshape(B, H, S)
    return o, lse


def _dilated_attention(q, k, v, slopes):
    outs, lses = [], []
    for g, (window, dilation) in enumerate(DILATED_GROUPS):
        o, lse = _band_group(q[:, :, g].transpose(0, 2, 1, 3), k[:, :, g].transpose(0, 2, 1, 3),
                             v[:, :, g].transpose(0, 2, 1, 3), window, dilation, slopes)
        outs.append(o)
        lses.append(lse)
    wts = jax.nn.softmax(jnp.stack(lses, axis=0), axis=0)
    return jnp.sum(wts[..., None] * jnp.stack(outs, axis=0), axis=0)


def setup_inputs(seed: int = 0) -> dict:
    key = jax.random.key(seed)
    ks = jax.random.split(key, 20)
    f32 = jnp.float32

    def nrm(k, shape, scale):
        return jax.random.normal(k, shape, f32) * scale

    return {
        'x': nrm(ks[0], (BATCH, SEQ, D_MODEL), 1.0),
        'norm_g': 1.0 + nrm(ks[1], (DEPTH, D_MODEL), 0.05),
        'w_in': nrm(ks[2], (DEPTH, D_MODEL, IN_COLS), D_MODEL ** -0.5),
        'b_in': nrm(ks[3], (DEPTH, IN_COLS), 0.02),
        'conv_w': nrm(ks[4], (DEPTH, HY_SHORT_CONV, 3 * HY_WIDTH), HY_SHORT_CONV ** -0.5),
        'conv_b': nrm(ks[5], (DEPTH, 3 * HY_WIDTH), 0.02),
        'hf_w1': nrm(ks[6], (DEPTH, HY_EMB_DIM, HY_FILTER_HIDDEN), HY_EMB_DIM ** -0.5),
        'hf_b1': nrm(ks[7], (DEPTH, HY_FILTER_HIDDEN), 0.02),
        'hf_w2': nrm(ks[8], (DEPTH, HY_FILTER_HIDDEN, HY_FILTER_HIDDEN), HY_FILTER_HIDDEN ** -0.5),
        'hf_b2': nrm(ks[9], (DEPTH, HY_FILTER_HIDDEN), 0.02),
        'hf_w3': nrm(ks[10], (DEPTH, HY_FILTER_HIDDEN, HY_FILTER_HIDDEN), HY_FILTER_HIDDEN ** -0.5),
        'hf_b3': nrm(ks[11], (DEPTH, HY_FILTER_HIDDEN), 0.02),
        'hf_w4': nrm(ks[12], (DEPTH, HY_FILTER_HIDDEN, HY_ORDER * 2 * HY_WIDTH), 0.02),
        'hf_freq': 1.0 + nrm(ks[13], (DEPTH, HY_FILTER_HIDDEN), 0.05),
        'hy_skip': nrm(ks[14], (DEPTH, HY_ORDER, HY_WIDTH), 0.1),
        'q_norm_g': 1.0 + nrm(ks[15], (DEPTH, HEAD_DIM), 0.05),
        'k_norm_g': 1.0 + nrm(ks[16], (DEPTH, HEAD_DIM), 0.05),
        'w_hy_out': nrm(ks[17], (DEPTH, HY_WIDTH, D_MODEL), HY_WIDTH ** -0.5),
        'w_at_out': nrm(ks[18], (DEPTH, AT_WIDTH, D_MODEL), AT_WIDTH ** -0.5),
        'w_out': nrm(ks[19], (DEPTH, D_MODEL, D_MODEL), D_MODEL ** -0.5),
    }


def reference(x, norm_g, w_in, b_in, conv_w, conv_b, hf_w1, hf_b1, hf_w2, hf_b2, hf_w3, hf_b3, hf_w4,
              hf_freq, hy_skip, q_norm_g, k_norm_g, w_hy_out, w_at_out, w_out):
    B, S, _ = x.shape
    f32 = jnp.float32
    slopes = _alibi_slopes(HEADS_PER_GROUP)
    o1 = 3 * HY_WIDTH
    o2 = o1 + HY_WIDTH
    o3 = o2 + 3 * AT_QKV
    o4 = o3 + AT_WIDTH
    o5 = o4 + D_MODEL
    for i in range(DEPTH):
        xn = _rmsnorm(x, norm_g[i])
        proj = xn @ w_in[i] + b_in[i]
        hy_in, hy_gate = proj[..., :o1], proj[..., o1:o2]
        qkv, at_gate = proj[..., o2:o3], proj[..., o3:o4]
        mg_h, mg_a = proj[..., o4:o5], proj[..., o5:]
        y_h = _hyena(hy_in, conv_w[i], conv_b[i], hf_w1[i], hf_b1[i], hf_w2[i], hf_b2[i], hf_w3[i], hf_b3[i],
                     hf_w4[i], hf_freq[i], hy_skip[i])
        u_h = (y_h * jax.nn.silu(hy_gate.astype(f32))).astype(x.dtype) @ w_hy_out[i]
        q, k, v = jnp.split(qkv, 3, axis=-1)
        q = _rmsnorm(q.reshape(B, S, N_GROUPS, HEADS_PER_GROUP, HEAD_DIM), q_norm_g[i]).astype(f32)
        k = _rmsnorm(k.reshape(B, S, N_GROUPS, HEADS_PER_GROUP, HEAD_DIM), k_norm_g[i]).astype(f32)
        v = v.reshape(B, S, N_GROUPS, HEADS_PER_GROUP, HEAD_DIM).astype(f32)
        o = _dilated_attention(q, k, v, slopes).transpose(0, 2, 1, 3).reshape(B, S, AT_WIDTH)
        u_a = (o * jax.nn.silu(at_gate.astype(f32))).astype(x.dtype) @ w_at_out[i]
        merged = jax.nn.sigmoid(mg_h) * u_h + jax.nn.sigmoid(mg_a) * u_a
        x = x + merged @ w_out[i]
    return x
```

```cpp
#include <hip/hip_runtime.h>
#include <hip/hip_cooperative_groups.h>
#include <cstdio>
namespace cg = cooperative_groups;
namespace pg8 {
#define PG8_LAS __attribute__((address_space(3)))
typedef unsigned short bf16_t;
typedef short bf16x8 __attribute__((ext_vector_type(8)));
typedef float f32x4 __attribute__((ext_vector_type(4)));
typedef unsigned u32x4 __attribute__((ext_vector_type(4)));
constexpr int BM = 256, BK = 64, HALF = 128, HTB = HALF * BK * 2  , STAGE_BYTES = 8 * HTB, NXCD = 8, WGM = 8;

__host__ __device__ __forceinline__ int lds_byte(int r, int c) { const int st = (r >> 4) * 2 + (c >> 5), rr = r & 15, cc = c & 31, ob = rr * 64 + cc * 2; return st * 1024 + (ob ^ (((ob >> 9) & 1) << 5)); }
__host__ __device__ __forceinline__ void stage_rc(int b, int& R, int& C) { const int st = b / 1024, sb = b % 1024, swz = sb ^ (((sb >> 9) & 1) << 5); R = (st >> 1) * 16 + swz / 64; C = (st & 1) * 32 + (swz % 64) / 2; }
__host__ __device__ __forceinline__ int perm32(int rho) { const int n = rho >> 4, i = rho & 15; return 8 * (i >> 2) + 4 * n + (i & 3); }

struct Unit { int pm, pn; };
struct Gemm { const bf16_t* A; const bf16_t* Bt; int M, N, K; };

struct StaticOrder {
    int nM, nN, nwg, G, c;
    __host__ __device__ void init(int M, int N, int G_, int c_) { nM = M / BM; nN = N / BM; nwg = nM * nN; G = G_; c = c_; }
    __host__ __device__ bool next(int i, Unit& u) const {
        const long L = (long)i * G + c; if (L >= nwg) return false;
        int wgid = (int)L; { const int q = nwg / NXCD, r = nwg % NXCD, xcd = wgid % NXCD, off = wgid / NXCD; wgid = (xcd < r ? xcd * (q + 1) : r * (q + 1) + (xcd - r) * q) + off; }
        const int nig = WGM * nN, gid = wgid / nig, fm = gid * WGM, gsz = (nM - fm) < WGM ? (nM - fm) : WGM;
        u.pm = fm + ((wgid % nig) % gsz); u.pn = (wgid % nig) / gsz; return true;
    }
    __device__ __forceinline__ void a_ready(const Unit&) const {}
    __device__ __forceinline__ void done(const Unit&) const {}
};
__device__ __forceinline__ unsigned cvt_pk_bf16(float lo, float hi) { unsigned r; asm volatile("v_cvt_pk_bf16_f32 %0, %1, %2" : "=v"(r) : "v"(lo), "v"(hi)); return r; }
typedef float f32x2 __attribute__((ext_vector_type(2)));
template <class Epi, class Sched, bool STAMP = false>
__device__ __forceinline__ void gemm_phase(PG8_LAS unsigned char* lds, const Gemm g, const Sched& S, const Epi& E, unsigned long long* stamps) {
    int tid_ = threadIdx.x; asm volatile("" : "+v"(tid_));
    const int tid = tid_, wid = __builtin_amdgcn_readfirstlane(tid >> 6), lane = tid & 63, wr = wid >> 2, wc = wid & 3, fr = lane & 15, fq = lane >> 4;
    const int K = g.K, nt = K / BK;
    int ts_lo = 0, ts_hi = 0, nts = 0; const unsigned long long rt_entry = STAMP ? (unsigned long long)wall_clock64() : 0ull;
#define PG8_STAMP() do { if (STAMP && wid == 0 && nts < 64) { const unsigned long long _c = (unsigned long long)clock64(); \
        ts_lo = (lane == nts) ? (int)(unsigned)_c : ts_lo; ts_hi = (lane == nts) ? (int)(unsigned)(_c >> 32) : ts_hi; ++nts; } } while (0)
    PG8_STAMP();
    unsigned voffA[2], voffB[2];
#pragma unroll
    for (int i = 0; i < 2; ++i) { int R, C; stage_rc(tid * 16 + i * 8192, R, C); const int Rb = Epi::PERM ? ((R & ~31) + perm32(R & 31)) : R;
        voffA[i] = (unsigned)(R * K + C) * 2u; voffB[i] = (unsigned)(Rb * K + C) * 2u; }
    const size_t kstep = (size_t)(BK * 2);
    const size_t hstep = (size_t)HALF * K * 2;
    const size_t tstep = 2 * hstep;
    const unsigned ldsw = (unsigned)wid * 1024u;
    const int aoff = lds_byte(wr * 64 + fr, fq * 8), boff = lds_byte(wc * 32 + fr, fq * 8);
#define PG8_SA(b, h) (((b) * 2 + (h)) * HTB)
#define PG8_SB(b, h) ((4 + (b) * 2 + (h)) * HTB)
#define PG8_STAGE(bufoff, gbase, voff) do { _Pragma("unroll") for (int _i = 0; _i < 2; ++_i) \
        __builtin_amdgcn_global_load_lds((const unsigned*)((const char*)(gbase) + (voff)[_i]), (PG8_LAS unsigned*)(lds + (bufoff) + ldsw + _i * 8192), 16, 0, 0); } while (0)
#define PG8_LDA(dst, b, h) do { _Pragma("unroll") for (int m = 0; m < 4; ++m) _Pragma("unroll") for (int k = 0; k < 2; ++k) dst[m][k] = *(const PG8_LAS bf16x8*)(lds + PG8_SA(b, h) + aoff + m * 2048 + k * 1024); } while (0)
#define PG8_LDB(dst, b, h) do { _Pragma("unroll") for (int n = 0; n < 2; ++n) _Pragma("unroll") for (int k = 0; k < 2; ++k) dst[n][k] = *(const PG8_LAS bf16x8*)(lds + PG8_SB(b, h) + boff + n * 2048 + k * 1024); } while (0)
#define PG8_MMA(ai, bj, At, Bt) do { __builtin_amdgcn_s_setprio(1); _Pragma("unroll") for (int m = 0; m < 4; ++m) _Pragma("unroll") for (int n = 0; n < 2; ++n) _Pragma("unroll") for (int k = 0; k < 2; ++k) \
        acc[ai][bj][m][n] = __builtin_amdgcn_mfma_f32_16x16x32_bf16(Bt[n][k], At[m][k], acc[ai][bj][m][n], 0, 0, 0); __builtin_amdgcn_s_setprio(0); } while (0)
#define PG8_WAIT_V(n) asm volatile("s_waitcnt vmcnt(" #n ")" ::: "memory")
#define PG8_WAIT_L(n) asm volatile("s_waitcnt lgkmcnt(" #n ")" ::: "memory")
#define PG8_BAR __builtin_amdgcn_s_barrier()
#define PG8_SCHED __builtin_amdgcn_sched_barrier(0)
    Unit cur, nxt; int ui = 0;
    if (!S.next(0, cur)) return;
    f32x4 acc[2][2][4][2];
#pragma unroll
    for (int a = 0; a < 2; ++a)
#pragma unroll
        for (int b = 0; b < 2; ++b)
#pragma unroll
            for (int m = 0; m < 4; ++m)
#pragma unroll
                for (int n = 0; n < 2; ++n) acc[a][b][m][n] = (f32x4){0.f, 0.f, 0.f, 0.f};
    bf16x8 At[4][2], B0[2][2], B1[2][2];
    const char* cA = (const char*)g.A + (size_t)cur.pm * tstep; const char* cB = (const char*)g.Bt + (size_t)cur.pn * tstep;
    S.a_ready(cur);
    PG8_STAGE(PG8_SB(0, 0), cB, voffB); PG8_STAGE(PG8_SA(0, 0), cA, voffA); PG8_STAGE(PG8_SB(0, 1), cB + hstep, voffB); PG8_STAGE(PG8_SA(0, 1), cA + hstep, voffA);
    if (wr == 1) PG8_BAR;
    PG8_WAIT_V(4); PG8_BAR;
    PG8_STAGE(PG8_SB(1, 0), cB + kstep, voffB); PG8_STAGE(PG8_SA(1, 0), cA + kstep, voffA); PG8_STAGE(PG8_SB(1, 1), cB + hstep + kstep, voffB);
    PG8_WAIT_V(6); PG8_BAR;
    PG8_STAMP();
    for (;;) {
        const bool has_next = S.next(ui + 1, nxt);
        const char* nA = has_next ? (const char*)g.A + (size_t)nxt.pm * tstep : cA; const char* nB = has_next ? (const char*)g.Bt + (size_t)nxt.pn * tstep : cB;
        for (int t = 0; t < nt; t += 2) {
            const bool last = (t == nt - 2);
            const char* a1 = cA + (size_t)(t + 1) * kstep;
            const char* a2 = last ? nA : cA + (size_t)(t + 2) * kstep; const char* b2 = last ? nB : cB + (size_t)(t + 2) * kstep;
            const char* a3 = a2 + kstep; const char* b3 = b2 + kstep;
            if (last && has_next) S.a_ready(nxt);
            PG8_LDB(B0, 0, 0); PG8_SCHED; PG8_LDA(At, 0, 0); PG8_STAGE(PG8_SA(1, 1), a1 + hstep, voffA);
            PG8_WAIT_L(8); PG8_BAR; PG8_WAIT_L(0); PG8_MMA(0, 0, At, B0); PG8_BAR; PG8_SCHED;
            PG8_LDB(B1, 0, 1); PG8_STAGE(PG8_SB(0, 0), b2, voffB);
            PG8_BAR; PG8_WAIT_L(0); PG8_MMA(0, 1, At, B1); PG8_BAR;
            PG8_LDA(At, 0, 1); PG8_STAGE(PG8_SA(0, 0), a2, voffA);
            PG8_BAR; PG8_WAIT_L(0); PG8_MMA(1, 0, At, B0); PG8_BAR; PG8_SCHED;
            PG8_STAGE(PG8_SB(0, 1), b2 + hstep, voffB);
            PG8_WAIT_V(6); PG8_BAR; PG8_MMA(1, 1, At, B1); PG8_BAR;
            PG8_LDB(B0, 1, 0); PG8_SCHED; PG8_LDA(At, 1, 0); PG8_STAGE(PG8_SA(0, 1), a2 + hstep, voffA);
            PG8_WAIT_L(8); PG8_BAR; PG8_WAIT_L(0); PG8_MMA(0, 0, At, B0); PG8_BAR; PG8_SCHED;
            PG8_LDB(B1, 1, 1); PG8_STAGE(PG8_SB(1, 0), b3, voffB);
            PG8_BAR; PG8_WAIT_L(0); PG8_MMA(0, 1, At, B1); PG8_BAR;
            PG8_LDA(At, 1, 1); PG8_STAGE(PG8_SA(1, 0), a3, voffA);
            PG8_BAR; PG8_WAIT_L(0); PG8_MMA(1, 0, At, B0); PG8_BAR; PG8_SCHED;
            PG8_STAGE(PG8_SB(1, 1), b3 + hstep, voffB);
            PG8_WAIT_V(6); PG8_BAR; PG8_MMA(1, 1, At, B1); PG8_BAR;
        }
        PG8_STAMP();
        if constexpr (!Epi::AFTER_DRAIN) { E(acc, cur, wr, wc, fr, fq); S.done(cur); }
        PG8_STAMP();
        if (!has_next) break;
#pragma unroll
        for (int a = 0; a < 2; ++a)
#pragma unroll
            for (int b = 0; b < 2; ++b)
#pragma unroll
                for (int m = 0; m < 4; ++m)
#pragma unroll
                    for (int n = 0; n < 2; ++n) acc[a][b][m][n] = (f32x4){0.f, 0.f, 0.f, 0.f};
        cur = nxt; cA = nA; cB = nB; ++ui;
    }
    PG8_WAIT_V(0);
    if (wr == 0) PG8_BAR;
    PG8_BAR;
    if constexpr (Epi::AFTER_DRAIN) { E.fused(acc, cur, wr, wc, fr, fq, lds, wid, lane); S.done(cur); }
    PG8_STAMP();
    if (STAMP && wid == 0) { stamps[lane] = lane < nts ? (((unsigned long long)(unsigned)ts_hi << 32) | (unsigned)ts_lo) : 0ull;
        if (lane == 62) stamps[62] = rt_entry; if (lane == 63) stamps[63] = (unsigned long long)wall_clock64(); }
#undef PG8_STAMP
#undef PG8_SA
#undef PG8_SB
#undef PG8_STAGE
#undef PG8_LDA
#undef PG8_LDB
#undef PG8_MMA
#undef PG8_WAIT_V
#undef PG8_WAIT_L
#undef PG8_BAR
#undef PG8_SCHED
}
}

#ifndef ONE_LAUNCH
#define ONE_LAUNCH 0
#endif
typedef unsigned short u16;
typedef pg8::f32x4 f32x4;
typedef pg8::u32x4 u32x4;
constexpr int MTOK = 32768, DM = 1024, SEQ = 2048, NB = 16, HYW = 768, NHY = 2304, NQKV = 4608, ATW = 512;
constexpr size_t MiB = 1024 * 1024;
constexpr size_t WS_HYT = 0;
constexpr size_t WS_QKV = 144 * MiB;
constexpr size_t WS_HYG = 432 * MiB;
constexpr size_t WS_ATG = 480 * MiB;
constexpr size_t WS_END = 512 * MiB;
constexpr size_t WS_YH = WS_HYT + 48 * MiB, WS_WOUT = WS_HYT + 96 * MiB;
constexpr size_t WS_SG = WS_QKV, WS_TMP = WS_QKV + 64 * MiB, WS_MRG = WS_QKV + 192 * MiB;
constexpr size_t DO_XN = 0, DO_WIN = 64 * MiB, DO_WHY = 84 * MiB, DO_WAT = DO_WHY + 1536 * 1024, DO_HF = 87 * MiB;
constexpr int LDS_BYTES = 144 * 1024;

struct Args { const float* in[20]; float* out; unsigned char* ws; int ph_lo, ph_hi; };
struct Frame {
    const float *x, *norm_g, *w_in, *b_in, *conv_w, *conv_b, *w1, *b1, *w2, *b2, *w3, *b3, *w4, *freq, *skip, *qg, *kg, *w_hy, *w_at, *w_out;
    float* out; unsigned char* ws; unsigned char* dob;
    int tid, lane, wid;
};

__device__ __forceinline__ u16 f2bf(float f) { unsigned u = __float_as_uint(f); u += 0x7FFFu + ((u >> 16) & 1u); return (u16)(u >> 16); }
__device__ __forceinline__ float bf2f(u16 b) { return __uint_as_float(((unsigned)b) << 16); }
__device__ __forceinline__ float bflo(unsigned w) { return __uint_as_float(w << 16); }
__device__ __forceinline__ float bfhi(unsigned w) { return __uint_as_float(w & 0xffff0000u); }
__device__ __forceinline__ unsigned pk2(float lo, float hi) { return (unsigned)f2bf(lo) | ((unsigned)f2bf(hi) << 16); }
__device__ __forceinline__ float sigmoidf_(float v) { return 1.0f / (1.0f + __expf(-v)); }
__device__ __forceinline__ float siluf_(float v) { return v / (1.0f + __expf(-v)); }

__device__ __forceinline__ void transpose_tile_f32(const float* src, int K, int N, u16* dst, int k0, int n0, u16* tile, int tid) {
    const int kl = tid >> 3, nc = (tid & 7) * 8;
    const float4* p = (const float4*)(src + (size_t)(k0 + kl) * N + n0 + nc);
    const float4 a = p[0], b = p[1];
    tile[(nc + 0) * 72 + kl] = f2bf(a.x); tile[(nc + 1) * 72 + kl] = f2bf(a.y); tile[(nc + 2) * 72 + kl] = f2bf(a.z); tile[(nc + 3) * 72 + kl] = f2bf(a.w);
    tile[(nc + 4) * 72 + kl] = f2bf(b.x); tile[(nc + 5) * 72 + kl] = f2bf(b.y); tile[(nc + 6) * 72 + kl] = f2bf(b.z); tile[(nc + 7) * 72 + kl] = f2bf(b.w);
    __syncthreads();
    const int nl = tid >> 3, kc = (tid & 7) * 8;
    const uint4 w = *(const uint4*)&tile[nl * 72 + kc];
    *(uint4*)(dst + (size_t)(n0 + nl) * K + k0 + kc) = w;
    __syncthreads();
}
__device__ void transpose_weight(const float* src, int K, int N, u16* dst, u16* tile, int tid) {
    const int nkt = K / 64, nnt = N / 64;
    for (int t = blockIdx.x; t < nkt * nnt; t += gridDim.x) transpose_tile_f32(src, K, N, dst, (t % nkt) * 64, (t / nkt) * 64, tile, tid);
}

__device__ void p0_prologue(const Frame& F, unsigned char* lds) {
    const int tid = F.tid, lane = F.lane, wid = F.wid;
    u16* XN = (u16*)(F.dob + DO_XN);
    for (int row = blockIdx.x * 8 + wid; row < MTOK; row += gridDim.x * 8) {
        const float4* xr = (const float4*)(F.x + (size_t)row * DM);
        float4 v[4]; float ss = 0.f;
#pragma unroll
        for (int i = 0; i < 4; ++i) { v[i] = xr[lane + 64 * i]; ss += v[i].x * v[i].x + v[i].y * v[i].y + v[i].z * v[i].z + v[i].w * v[i].w; }
#pragma unroll
        for (int o = 32; o >= 1; o >>= 1) ss += __shfl_xor(ss, o);
        const float rs = rsqrtf(ss * (1.0f / DM) + 1e-6f);
#pragma unroll
        for (int i = 0; i < 4; ++i) { const float4 g = ((const float4*)F.norm_g)[lane + 64 * i];
            uint2 w; w.x = pk2(v[i].x * rs * g.x, v[i].y * rs * g.y); w.y = pk2(v[i].z * rs * g.z, v[i].w * rs * g.w);
            *(uint2*)(XN + (size_t)row * DM + 4 * (lane + 64 * i)) = w; }
    }
    u16* tile = (u16*)lds;
    transpose_weight(F.w_in, DM, 10240, (u16*)(F.dob + DO_WIN), tile, tid);
    transpose_weight(F.w_hy, HYW, DM, (u16*)(F.dob + DO_WHY), tile, tid);
    transpose_weight(F.w_at, ATW, DM, (u16*)(F.dob + DO_WAT), tile, tid);
    float* HF = (float*)(F.dob + DO_HF);
    float* zs = (float*)lds;
    float* ha = zs + 8 * 40;
    float* hb = ha + 8 * 64;
    for (int blk = blockIdx.x; blk < SEQ / 8; blk += gridDim.x) {
        const int t0 = blk * 8;
        __syncthreads();
        if (tid < 8 * 33) { const int p = tid / 33, i = tid % 33; const float tt = (float)(t0 + p);
            float val;
            if (i == 0) val = tt * (1.0f / 2047.0f);
            else { const int j = (i - 1) & 15; const float f = 1e-4f + (float)j * ((15.0f - 1e-4f) / 15.0f); const float w = 6.283185307179586f * tt * (1.0f / 2048.0f); const float a = f * w;
                val = (i <= 16) ? cosf(a) : -sinf(a); }
            zs[p * 40 + i] = val; }
        __syncthreads();
        const int p = tid >> 6, j = tid & 63; const float fr = F.freq[j];
        { float a = F.b1[j];
#pragma unroll 3
          for (int i = 0; i < 33; ++i) a += zs[p * 40 + i] * F.w1[i * 64 + j]; ha[p * 64 + j] = sinf(fr * a); }
        __syncthreads();
        { float a = F.b2[j];
#pragma unroll 4
          for (int i = 0; i < 64; ++i) a += ha[p * 64 + i] * F.w2[i * 64 + j]; hb[p * 64 + j] = sinf(fr * a); }
        __syncthreads();
        { float a = F.b3[j];
#pragma unroll 4
          for (int i = 0; i < 64; ++i) a += hb[p * 64 + i] * F.w3[i * 64 + j]; ha[p * 64 + j] = sinf(fr * a); }
        __syncthreads();
#pragma unroll 1
        for (int col = tid; col < 3072; col += 512) {
            float acc[8];
#pragma unroll
            for (int q = 0; q < 8; ++q) acc[q] = 0.f;
#pragma unroll 2
            for (int k = 0; k < 64; ++k) { const float w = F.w4[k * 3072 + col];
#pragma unroll
                for (int q = 0; q < 8; ++q) acc[q] += ha[q * 64 + k] * w; }
            const int o = col / 1536, d = (col % 1536) / 768, c = col % 768;
            const float dmin = 3.0701134573253944f, dmax = 15.350567286626972f;
            const float ad = dmin + (float)c * ((dmax - dmin) / 767.0f);
#pragma unroll
            for (int q = 0; q < 8; ++q) acc[q] *= expf(-((float)(t0 + q) * (1.0f / 2047.0f)) * ad);
            float* dst = HF + ((size_t)((o * HYW + c) * 2 + d)) * SEQ + t0;
            *(float4*)dst = make_float4(acc[0], acc[1], acc[2], acc[3]); *(float4*)(dst + 4) = make_float4(acc[4], acc[5], acc[6], acc[7]);
        }
    }
    __syncthreads();
}

template <int ACT> __device__ __forceinline__ void store_rm(const f32x4 (&acc)[2][2][4][2], const f32x4 (&bv)[2][2], u16* base, int ldc, int row0, int col0) {
#pragma unroll
    for (int ai = 0; ai < 2; ++ai)
#pragma unroll
        for (int m = 0; m < 4; ++m) { u16* rowp = base + (size_t)(row0 + ai * 128 + m * 16) * ldc + col0;
#pragma unroll
            for (int bj = 0; bj < 2; ++bj) { f32x4 v0 = acc[ai][bj][m][0] + bv[bj][0], v1 = acc[ai][bj][m][1] + bv[bj][1];
                if (ACT) {
#pragma unroll
                    for (int j = 0; j < 4; ++j) { v0[j] = siluf_(v0[j]); v1[j] = siluf_(v1[j]); } }
                u32x4 w; w.x = pk2(v0[0], v0[1]); w.y = pk2(v0[2], v0[3]); w.z = pk2(v1[0], v1[1]); w.w = pk2(v1[2], v1[3]);
                *(u32x4*)(rowp + bj * 128) = w; } }
}
struct Epi1 {
    static constexpr bool PERM = true, AFTER_DRAIN = false;
    u16 *hyt, *qkv, *hyg, *atg; const float* bias;
    __device__ __forceinline__ void operator()(const f32x4 (&acc)[2][2][4][2], const pg8::Unit& u, int wr, int wc, int fr, int fq) const {
        const int row0 = u.pm * 256 + wr * 64 + fr, colg = u.pn * 256 + wc * 32 + 8 * fq;
        f32x4 bv[2][2];
#pragma unroll
        for (int bj = 0; bj < 2; ++bj)
#pragma unroll
            for (int n = 0; n < 2; ++n) bv[bj][n] = *(const f32x4*)(bias + colg + bj * 128 + 4 * n);
        if (u.pn < 9) {
#pragma unroll
            for (int ai = 0; ai < 2; ++ai)
#pragma unroll
                for (int m = 0; m < 4; ++m) { const int row = row0 + ai * 128 + m * 16;
#pragma unroll
                    for (int bj = 0; bj < 2; ++bj)
#pragma unroll
                        for (int n = 0; n < 2; ++n) { const f32x4 v = acc[ai][bj][m][n] + bv[bj][n];
#pragma unroll
                            for (int j = 0; j < 4; ++j) hyt[(size_t)(colg + bj * 128 + 4 * n + j) * MTOK + row] = f2bf(v[j]); } }
            return;
        }
        if (u.pn < 12) store_rm<1>(acc, bv, hyg, HYW, row0, colg - 2304);
        else if (u.pn < 30) store_rm<0>(acc, bv, qkv, NQKV, row0, colg - 3072);
        else store_rm<1>(acc, bv, atg, ATW, row0, colg - 7680);
    }
};
struct EpiSig {
    static constexpr bool PERM = true, AFTER_DRAIN = false;
    u16* sg; const float* bias;
    __device__ __forceinline__ void operator()(const f32x4 (&acc)[2][2][4][2], const pg8::Unit& u, int wr, int wc, int fr, int fq) const {
        const int row0 = u.pm * 256 + wr * 64 + fr, col0 = u.pn * 256 + wc * 32 + 8 * fq;
        f32x4 bv[2][2];
#pragma unroll
        for (int bj = 0; bj < 2; ++bj)
#pragma unroll
            for (int n = 0; n < 2; ++n) bv[bj][n] = *(const f32x4*)(bias + col0 + bj * 128 + 4 * n);
#pragma unroll
        for (int ai = 0; ai < 2; ++ai)
#pragma unroll
            for (int m = 0; m < 4; ++m) { u16* rowp = sg + (size_t)(row0 + ai * 128 + m * 16) * DM + col0;
#pragma unroll
                for (int bj = 0; bj < 2; ++bj) { f32x4 v0 = acc[ai][bj][m][0] + bv[bj][0], v1 = acc[ai][bj][m][1] + bv[bj][1];
#pragma unroll
                    for (int j = 0; j < 4; ++j) { v0[j] = sigmoidf_(v0[j]); v1[j] = sigmoidf_(v1[j]); }
                    u32x4 w; w.x = pk2(v0[0], v0[1]); w.y = pk2(v0[2], v0[3]); w.z = pk2(v1[0], v1[1]); w.w = pk2(v1[2], v1[3]);
                    *(u32x4*)(rowp + bj * 128) = w; } }
    }
};
template <int MODE  > struct EpiGate {
    static constexpr bool PERM = true, AFTER_DRAIN = false;
    const u16* sg; float* tmp; u16* mrg;
    __device__ __forceinline__ void operator()(const f32x4 (&acc)[2][2][4][2], const pg8::Unit& u, int wr, int wc, int fr, int fq) const {
        const int row0 = u.pm * 256 + wr * 64 + fr, col0 = u.pn * 256 + wc * 32 + 8 * fq;
#pragma unroll
        for (int ai = 0; ai < 2; ++ai)
#pragma unroll
            for (int m = 0; m < 4; ++m) { const size_t off = (size_t)(row0 + ai * 128 + m * 16) * DM + col0;
#pragma unroll
                for (int bj = 0; bj < 2; ++bj) { const u32x4 s = *(const u32x4*)(sg + off + bj * 128);
                    f32x4 v0 = acc[ai][bj][m][0], v1 = acc[ai][bj][m][1];
                    v0[0] *= bflo(s.x); v0[1] *= bfhi(s.x); v0[2] *= bflo(s.y); v0[3] *= bfhi(s.y); v1[0] *= bflo(s.z); v1[1] *= bfhi(s.z); v1[2] *= bflo(s.w); v1[3] *= bfhi(s.w);
                    if (MODE == 0) { *(f32x4*)(tmp + off + bj * 128) = v0; *(f32x4*)(tmp + off + bj * 128 + 4) = v1; }
                    else { const f32x4 t0 = *(const f32x4*)(tmp + off + bj * 128), t1 = *(const f32x4*)(tmp + off + bj * 128 + 4); v0 += t0; v1 += t1;
                        u32x4 w; w.x = pk2(v0[0], v0[1]); w.y = pk2(v0[2], v0[3]); w.z = pk2(v1[0], v1[1]); w.w = pk2(v1[2], v1[3]);
                        *(u32x4*)(mrg + off + bj * 128) = w; } } }
    }
};
struct EpiOut {
    static constexpr bool PERM = true, AFTER_DRAIN = false;
    const float* x; float* out;
    __device__ __forceinline__ void operator()(const f32x4 (&acc)[2][2][4][2], const pg8::Unit& u, int wr, int wc, int fr, int fq) const {
        const int row0 = u.pm * 256 + wr * 64 + fr, col0 = u.pn * 256 + wc * 32 + 8 * fq;
#pragma unroll
        for (int ai = 0; ai < 2; ++ai)
#pragma unroll
            for (int m = 0; m < 4; ++m) { const size_t off = (size_t)(row0 + ai * 128 + m * 16) * DM + col0;
#pragma unroll
                for (int bj = 0; bj < 2; ++bj) { const f32x4 x0 = *(const f32x4*)(x + off + bj * 128), x1 = *(const f32x4*)(x + off + bj * 128 + 4);
                    *(f32x4*)(out + off + bj * 128) = x0 + acc[ai][bj][m][0]; *(f32x4*)(out + off + bj * 128 + 4) = x1 + acc[ai][bj][m][1]; } }
    }
};

__device__ __forceinline__ void conv16(const float* KK, const float* Ub, int t0, float (&acc)[16]) {
#pragma unroll
    for (int j = 0; j < 16; ++j) acc[j] = 0.f;
    for (int s0 = 0; s0 < SEQ; s0 += 16) {
        const int Lb = t0 - s0 + 2048 - 16;
        const float* kp = KK + 17 * (Lb >> 4);
        float w[32], uu[16];
#pragma unroll
        for (int e = 1; e < 16; ++e) w[e] = kp[e];
#pragma unroll
        for (int e = 16; e < 32; ++e) w[e] = kp[e + 1];
#pragma unroll
        for (int i = 0; i < 16; ++i) uu[i] = Ub[s0 + i];
#pragma unroll
        for (int j = 0; j < 16; ++j)
#pragma unroll
            for (int i = 0; i < 16; ++i) acc[j] += w[16 + j - i] * uu[i];
    }
}
__device__ void hyena_naive(const Frame& F, unsigned char* lds) {
    int tid = threadIdx.x; asm volatile("" : "+v"(tid));
    float* KK0 = (float*)lds; float* KK1 = KK0 + 4352; float* U = KK1 + 4352; float* Y1 = U + 4 * SEQ;
    const float* HF = (const float*)(F.dob + DO_HF);
    u16* HYT = (u16*)(F.ws + WS_HYT);
    for (int c = blockIdx.x; c < HYW; c += gridDim.x) {
        __syncthreads();
        for (int L = tid; L < 4096; L += 512) { const int lag = L - 2048; float v0 = 0.f, v1 = 0.f;
            if (L != 0) { if (lag >= 0) { v0 = HF[((size_t)((0 * HYW + c) * 2 + 0)) * SEQ + lag]; v1 = HF[((size_t)((1 * HYW + c) * 2 + 0)) * SEQ + lag]; }
                          else { v0 = HF[((size_t)((0 * HYW + c) * 2 + 1)) * SEQ - lag]; v1 = HF[((size_t)((1 * HYW + c) * 2 + 1)) * SEQ - lag]; } }
            KK0[L + (L >> 4)] = v0; KK1[L + (L >> 4)] = v1; }
        const float wv0 = F.conv_w[c], wv1 = F.conv_w[NHY + c], wv2 = F.conv_w[2 * NHY + c], cbv = F.conv_b[c];
        const float wa0 = F.conv_w[HYW + c], wa1 = F.conv_w[NHY + HYW + c], wa2 = F.conv_w[2 * NHY + HYW + c], cba = F.conv_b[HYW + c];
        const float wb0 = F.conv_w[2 * HYW + c], wb1 = F.conv_w[NHY + 2 * HYW + c], wb2 = F.conv_w[2 * NHY + 2 * HYW + c], cbb = F.conv_b[2 * HYW + c];
        const float skip0 = F.skip[c], skip1 = F.skip[HYW + c];
        for (int bg = 0; bg < 4; ++bg) {
            __syncthreads();
            for (int e = tid; e < 4 * SEQ; e += 512) { const int bl = e >> 11, t = e & 2047; const u16* vr = HYT + (size_t)c * MTOK + (bg * 4 + bl) * SEQ;
                const float a = bf2f(vr[t]), am = t > 0 ? bf2f(vr[t - 1]) : 0.f, ap = t < SEQ - 1 ? bf2f(vr[t + 1]) : 0.f;
                U[e] = cbv + wv0 * am + wv1 * a + wv2 * ap; }
            __syncthreads();
            const int bl = tid >> 7, t0 = (tid & 127) * 16, b = bg * 4 + bl;
            float acc[16];
            conv16(KK0, U + bl * SEQ, t0, acc);
            { const u16* xr = HYT + (size_t)(HYW + c) * MTOK + b * SEQ;
#pragma unroll
              for (int j = 0; j < 16; ++j) { const int t = t0 + j; const float a = bf2f(xr[t]), am = t > 0 ? bf2f(xr[t - 1]) : 0.f, ap = t < SEQ - 1 ? bf2f(xr[t + 1]) : 0.f;
                  const float x1c = cba + wa0 * am + wa1 * a + wa2 * ap; const float vc = U[bl * SEQ + t];
                  Y1[bl * SEQ + t] = x1c * (acc[j] + vc * skip0); } }
            __syncthreads();
            conv16(KK1, Y1 + bl * SEQ, t0, acc);
            { const u16* xr = HYT + (size_t)(2 * HYW + c) * MTOK + b * SEQ; u16* yo = HYT + (size_t)c * MTOK + b * SEQ + t0;
              float y[16];
#pragma unroll
              for (int j = 0; j < 16; ++j) { const int t = t0 + j; const float a = bf2f(xr[t]), am = t > 0 ? bf2f(xr[t - 1]) : 0.f, ap = t < SEQ - 1 ? bf2f(xr[t + 1]) : 0.f;
                  const float x2c = cbb + wb0 * am + wb1 * a + wb2 * ap; y[j] = x2c * (acc[j] + Y1[bl * SEQ + t] * skip1); }
              uint4 w0, w1; w0.x = pk2(y[0], y[1]); w0.y = pk2(y[2], y[3]); w0.z = pk2(y[4], y[5]); w0.w = pk2(y[6], y[7]);
              w1.x = pk2(y[8], y[9]); w1.y = pk2(y[10], y[11]); w1.z = pk2(y[12], y[13]); w1.w = pk2(y[14], y[15]);
              *(uint4*)yo = w0; *(uint4*)(yo + 8) = w1; }
        }
    }
    __syncthreads();
}

__device__ void attn_naive(const Frame& F, unsigned char* lds) {
    volatile float* gqk = (volatile float*)lds;
    __syncthreads();
    if (F.tid < 64) gqk[F.tid] = F.qg[F.tid] * F.kg[F.tid];
    __syncthreads();
    const u16* QKV = (const u16*)(F.ws + WS_QKV); u16* ATG = (u16*)(F.ws + WS_ATG);
    int tid = threadIdx.x; asm volatile("" : "+v"(tid));
    for (int idx2 = blockIdx.x * 512 + tid; idx2 < NB * 8 * SEQ * 2; idx2 += gridDim.x * 512) {
        const int half = idx2 & 1, idx = idx2 >> 1;
        const int s = idx & 2047, h = (idx >> 11) & 7, b = idx >> 14;
        const float slope = exp2f(-(float)(h + 1));
        float o[32];
#pragma unroll
        for (int j = 0; j < 32; ++j) o[j] = 0.f;
        float mrun = -1e30f, l = 0.f;
        for (int g = 0; g < 3; ++g) {
            const int dsh = 2 * g, d = 1 << dsh, n = SEQ >> dsh, i = s >> dsh, r = s & (d - 1);
            float qq[64];
            { const uint4* qp = (const uint4*)(QKV + (size_t)(b * SEQ + s) * NQKV + g * 512 + h * 64); float ss = 0.f;
#pragma unroll
              for (int v = 0; v < 8; ++v) { const uint4 w = qp[v]; qq[8 * v + 0] = bflo(w.x); qq[8 * v + 1] = bfhi(w.x); qq[8 * v + 2] = bflo(w.y); qq[8 * v + 3] = bfhi(w.y);
                  qq[8 * v + 4] = bflo(w.z); qq[8 * v + 5] = bfhi(w.z); qq[8 * v + 6] = bflo(w.w); qq[8 * v + 7] = bfhi(w.w); }
#pragma unroll
              for (int j = 0; j < 64; ++j) ss += qq[j] * qq[j];
              const float rq = rsqrtf(ss * (1.0f / 64.0f) + 1e-6f) * 0.125f;
#pragma unroll
              for (int j = 0; j < 64; ++j) qq[j] *= rq * gqk[j]; }
            const int jlo = i - 64 < 0 ? 0 : i - 64, jhi = i + 64 > n - 1 ? n - 1 : i + 64;
#pragma unroll 1
            for (int jj = jlo; jj <= jhi; ++jj) {
                const size_t rowk = (size_t)(b * SEQ + (jj << dsh) + r) * NQKV + g * 512 + h * 64;
                const uint4* kp = (const uint4*)(QKV + rowk + 1536); float ss = 0.f, dot = 0.f;
#pragma unroll
                for (int v = 0; v < 8; ++v) { const uint4 w = kp[v]; float k0 = bflo(w.x), k1 = bfhi(w.x), k2 = bflo(w.y), k3 = bfhi(w.y), k4 = bflo(w.z), k5 = bfhi(w.z), k6 = bflo(w.w), k7 = bfhi(w.w);
                    ss += k0 * k0 + k1 * k1 + k2 * k2 + k3 * k3 + k4 * k4 + k5 * k5 + k6 * k6 + k7 * k7;
                    dot += qq[8 * v] * k0 + qq[8 * v + 1] * k1 + qq[8 * v + 2] * k2 + qq[8 * v + 3] * k3 + qq[8 * v + 4] * k4 + qq[8 * v + 5] * k5 + qq[8 * v + 6] * k6 + qq[8 * v + 7] * k7; }
                const int dist = (i > jj ? i - jj : jj - i) << dsh;
                const float sc = dot * rsqrtf(ss * (1.0f / 64.0f) + 1e-6f) - slope * (float)dist;
                if (sc > mrun) { const float al = __expf(mrun - sc); l *= al;
#pragma unroll
                    for (int j = 0; j < 32; ++j) o[j] *= al;
                    mrun = sc; }
                const float p = __expf(sc - mrun); l += p;
                const uint4* vp = (const uint4*)(QKV + rowk + 3072 + half * 32);
#pragma unroll
                for (int v = 0; v < 4; ++v) { const uint4 w = vp[v];
                    o[8 * v] += p * bflo(w.x); o[8 * v + 1] += p * bfhi(w.x); o[8 * v + 2] += p * bflo(w.y); o[8 * v + 3] += p * bfhi(w.y);
                    o[8 * v + 4] += p * bflo(w.z); o[8 * v + 5] += p * bfhi(w.z); o[8 * v + 6] += p * bflo(w.w); o[8 * v + 7] += p * bfhi(w.w); }
            }
        }
        const float il = 1.0f / l;
        uint4* gp = (uint4*)(ATG + (size_t)(b * SEQ + s) * ATW + h * 64 + half * 32);
#pragma unroll
        for (int v = 0; v < 4; ++v) { const uint4 w = gp[v]; uint4 r;
            r.x = pk2(o[8 * v] * il * bflo(w.x), o[8 * v + 1] * il * bfhi(w.x)); r.y = pk2(o[8 * v + 2] * il * bflo(w.y), o[8 * v + 3] * il * bfhi(w.y));
            r.z = pk2(o[8 * v + 4] * il * bflo(w.z), o[8 * v + 5] * il * bfhi(w.z)); r.w = pk2(o[8 * v + 6] * il * bflo(w.w), o[8 * v + 7] * il * bfhi(w.w));
            gp[v] = r; }
    }
}

__device__ void p2b_transpose(const Frame& F, unsigned char* lds) {
    const int tid = F.tid; u16* tl = (u16*)lds;
    const u16* HYT = (const u16*)(F.ws + WS_HYT); const u16* HYG = (const u16*)(F.ws + WS_HYG); u16* YH = (u16*)(F.ws + WS_YH);
    for (int tile = blockIdx.x; tile < 12 * 512; tile += gridDim.x) {
        const int c0 = (tile % 12) * 64, m0 = (tile / 12) * 64;
        const int cl = tid >> 3, mc = (tid & 7) * 8;
        const uint4 w = *(const uint4*)(HYT + (size_t)(c0 + cl) * MTOK + m0 + mc);
        tl[(mc + 0) * 72 + cl] = (u16)(w.x & 0xffff); tl[(mc + 1) * 72 + cl] = (u16)(w.x >> 16); tl[(mc + 2) * 72 + cl] = (u16)(w.y & 0xffff); tl[(mc + 3) * 72 + cl] = (u16)(w.y >> 16);
        tl[(mc + 4) * 72 + cl] = (u16)(w.z & 0xffff); tl[(mc + 5) * 72 + cl] = (u16)(w.z >> 16); tl[(mc + 6) * 72 + cl] = (u16)(w.w & 0xffff); tl[(mc + 7) * 72 + cl] = (u16)(w.w >> 16);
        __syncthreads();
        const int ml = tid >> 3, cc = (tid & 7) * 8;
        const uint4 y = *(const uint4*)&tl[ml * 72 + cc]; const uint4 g = *(const uint4*)(HYG + (size_t)(m0 + ml) * HYW + c0 + cc);
        uint4 r; r.x = pk2(bflo(y.x) * bflo(g.x), bfhi(y.x) * bfhi(g.x)); r.y = pk2(bflo(y.y) * bflo(g.y), bfhi(y.y) * bfhi(g.y));
        r.z = pk2(bflo(y.z) * bflo(g.z), bfhi(y.z) * bfhi(g.z)); r.w = pk2(bflo(y.w) * bflo(g.w), bfhi(y.w) * bfhi(g.w));
        *(uint4*)(YH + (size_t)(m0 + ml) * HYW + c0 + cc) = r;
        __syncthreads();
    }
    transpose_weight(F.w_out, DM, DM, (u16*)(F.ws + WS_WOUT), tl, tid);
}

__global__ void __launch_bounds__(512) mk_fwd(Args args) {
    extern __shared__ __attribute__((aligned(16))) unsigned char lds[];
    cg::grid_group grid = cg::this_grid();
    Frame F;
    F.x = args.in[0]; F.norm_g = args.in[1]; F.w_in = args.in[2]; F.b_in = args.in[3]; F.conv_w = args.in[4]; F.conv_b = args.in[5];
    F.w1 = args.in[6]; F.b1 = args.in[7]; F.w2 = args.in[8]; F.b2 = args.in[9]; F.w3 = args.in[10]; F.b3 = args.in[11]; F.w4 = args.in[12]; F.freq = args.in[13];
    F.skip = args.in[14]; F.qg = args.in[15]; F.kg = args.in[16]; F.w_hy = args.in[17]; F.w_at = args.in[18]; F.w_out = args.in[19];
    F.out = args.out; F.ws = args.ws; F.dob = (unsigned char*)args.out;
    F.tid = threadIdx.x; F.lane = F.tid & 63; F.wid = __builtin_amdgcn_readfirstlane(F.tid >> 6);
    const int lo = args.ph_lo, hi = args.ph_hi;
    PG8_LAS unsigned char* ldsa = (PG8_LAS unsigned char*)lds;
    const int G = gridDim.x, c = blockIdx.x;
#ifdef ONLY
#define IN(k) ((k) == ONLY && lo <= (k) && (k) < hi)
#elif defined(SKIP)
#define IN(k) ((k) != SKIP && lo <= (k) && (k) < hi)
#else
#define IN(k) (lo <= (k) && (k) < hi)
#endif
#define SEAM(k) do { if (IN(k) && IN((k) + 1)) grid.sync(); } while (0)
    if (IN(0)) p0_prologue(F, lds);
    SEAM(0);
    if (IN(1)) {
        pg8::Gemm g{(const u16*)(F.dob + DO_XN), (const u16*)(F.dob + DO_WIN), MTOK, 8192, DM}; pg8::StaticOrder S; S.init(MTOK, 8192, G, c);
        Epi1 E{(u16*)(F.ws + WS_HYT), (u16*)(F.ws + WS_QKV), (u16*)(F.ws + WS_HYG), (u16*)(F.ws + WS_ATG), F.b_in};
        pg8::gemm_phase<Epi1, pg8::StaticOrder>(ldsa, g, S, E, nullptr);
    }
    SEAM(1);
    if (IN(2)) {
#ifndef NO_HY
        hyena_naive(F, lds);
#endif
#ifndef NO_ATT
        attn_naive(F, lds);
#endif
    }
    SEAM(2);
    if (IN(3)) p2b_transpose(F, lds);
    SEAM(3);
    if (IN(4)) {
        pg8::StaticOrder S; S.init(MTOK, DM, G, c);
        { pg8::Gemm g{(const u16*)(F.dob + DO_XN), (const u16*)(F.dob + DO_WIN) + (size_t)8192 * DM, MTOK, DM, DM}; EpiSig E{(u16*)(F.ws + WS_SG), F.b_in + 8192};
          pg8::gemm_phase<EpiSig, pg8::StaticOrder>(ldsa, g, S, E, nullptr); }
        { pg8::Gemm g{(const u16*)(F.ws + WS_YH), (const u16*)(F.dob + DO_WHY), MTOK, DM, HYW}; EpiGate<0> E{(const u16*)(F.ws + WS_SG), (float*)(F.ws + WS_TMP), nullptr};
          pg8::gemm_phase<EpiGate<0>, pg8::StaticOrder>(ldsa, g, S, E, nullptr); }
        { pg8::Gemm g{(const u16*)(F.dob + DO_XN), (const u16*)(F.dob + DO_WIN) + (size_t)9216 * DM, MTOK, DM, DM}; EpiSig E{(u16*)(F.ws + WS_SG), F.b_in + 9216};
          pg8::gemm_phase<EpiSig, pg8::StaticOrder>(ldsa, g, S, E, nullptr); }
        { pg8::Gemm g{(const u16*)(F.ws + WS_ATG), (const u16*)(F.dob + DO_WAT), MTOK, DM, ATW}; EpiGate<1> E{(const u16*)(F.ws + WS_SG), (float*)(F.ws + WS_TMP), (u16*)(F.ws + WS_MRG)};
          pg8::gemm_phase<EpiGate<1>, pg8::StaticOrder>(ldsa, g, S, E, nullptr); }
    }
    SEAM(4);
    if (IN(5)) {
        pg8::Gemm g{(const u16*)(F.ws + WS_MRG), (const u16*)(F.ws + WS_WOUT), MTOK, DM, DM}; pg8::StaticOrder S; S.init(MTOK, DM, G, c);
        EpiOut E{F.x, F.out};
        pg8::gemm_phase<EpiOut, pg8::StaticOrder>(ldsa, g, S, E, nullptr);
    }
#undef IN
#undef SEAM
}

extern "C" void kernel_launch(void* const* d_in, const int* in_sizes, int n_in, void* d_out, int out_size, void* d_ws, size_t ws_size, hipStream_t stream) {
    static int grid = 0;
    if (grid == 0) {
        if (n_in != 20 || out_size != MTOK * DM || ws_size < WS_END) { fprintf(stderr, "kernel_launch: unexpected shapes (n_in %d out %d ws %zu)\n", n_in, out_size, ws_size); grid = -1; return; }
        int dev = 0, cus = 0, per_cu = 0;
        hipGetDevice(&dev); hipDeviceGetAttribute(&cus, hipDeviceAttributeMultiprocessorCount, dev);
        if (hipFuncSetAttribute((const void*)mk_fwd, hipFuncAttributeMaxDynamicSharedMemorySize, LDS_BYTES) != hipSuccess) { fprintf(stderr, "kernel_launch: hipFuncSetAttribute failed\n"); grid = -1; return; }
        if (hipOccupancyMaxActiveBlocksPerMultiprocessor(&per_cu, (const void*)mk_fwd, 512, LDS_BYTES) != hipSuccess || per_cu < 1) { fprintf(stderr, "kernel_launch: occupancy query failed (%d)\n", per_cu); per_cu = 1; }
        (void)hipGetLastError();
        grid = cus;
        if (grid != 256) fprintf(stderr, "kernel_launch: note: %d CUs\n", grid);
    }
    if (grid < 0) return;
    Args a{};
    for (int i = 0; i < 20; ++i) a.in[i] = (const float*)d_in[i];
    a.out = (float*)d_out; a.ws = (unsigned char*)d_ws;
#if ONE_LAUNCH
    a.ph_lo = 0; a.ph_hi = 6;
    void* kargs[] = {&a};
    hipError_t e = hipLaunchCooperativeKernel((const void*)mk_fwd, dim3(grid), dim3(512), kargs, LDS_BYTES, stream);
    if (e != hipSuccess) fprintf(stderr, "cooperative launch failed: %s (grid %d)\n", hipGetErrorString(e), grid);
#else
    for (int ph = 0; ph < 6; ++ph) { a.ph_lo = ph; a.ph_hi = ph + 1; hipLaunchKernelGGL(mk_fwd, dim3(grid), dim3(512), LDS_BYTES, stream, a); }
#endif
}
```

```cpp
#include <hip/hip_runtime.h>
#include <hip/hip_cooperative_groups.h>
#include <cstdio>
namespace cg = cooperative_groups;
namespace pg8 {
#define PG8_LAS __attribute__((address_space(3)))
typedef unsigned short bf16_t;
typedef short bf16x8 __attribute__((ext_vector_type(8)));
typedef float f32x4 __attribute__((ext_vector_type(4)));
typedef unsigned u32x4 __attribute__((ext_vector_type(4)));
constexpr int BM = 256, BK = 64, HALF = 128, HTB = HALF * BK * 2  , STAGE_BYTES = 8 * HTB, NXCD = 8, WGM = 8;

__host__ __device__ __forceinline__ int lds_byte(int r, int c) { const int st = (r >> 4) * 2 + (c >> 5), rr = r & 15, cc = c & 31, ob = rr * 64 + cc * 2; return st * 1024 + (ob ^ (((ob >> 9) & 1) << 5)); }
__host__ __device__ __forceinline__ void stage_rc(int b, int& R, int& C) { const int st = b / 1024, sb = b % 1024, swz = sb ^ (((sb >> 9) & 1) << 5); R = (st >> 1) * 16 + swz / 64; C = (st & 1) * 32 + (swz % 64) / 2; }
__host__ __device__ __forceinline__ int perm32(int rho) { const int n = rho >> 4, i = rho & 15; return 8 * (i >> 2) + 4 * n + (i & 3); }

struct Unit { int pm, pn; };
struct Gemm { const bf16_t* A; const bf16_t* Bt; int M, N, K; };

struct StaticOrder {
    int nM, nN, nwg, G, c;
    __host__ __device__ void init(int M, int N, int G_, int c_) { nM = M / BM; nN = N / BM; nwg = nM * nN; G = G_; c = c_; }
    __host__ __device__ bool next(int i, Unit& u) const {
        const long L = (long)i * G + c; if (L >= nwg) return false;
        int wgid = (int)L; { const int q = nwg / NXCD, r = nwg % NXCD, xcd = wgid % NXCD, off = wgid / NXCD; wgid = (xcd < r ? xcd * (q + 1) : r * (q + 1) + (xcd - r) * q) + off; }
        const int nig = WGM * nN, gid = wgid / nig, fm = gid * WGM, gsz = (nM - fm) < WGM ? (nM - fm) : WGM;
        u.pm = fm + ((wgid % nig) % gsz); u.pn = (wgid % nig) / gsz; return true;
    }
    __device__ __forceinline__ void a_ready(const Unit&) const {}
    __device__ __forceinline__ void done(const Unit&) const {}
};
__device__ __forceinline__ unsigned cvt_pk_bf16(float lo, float hi) { unsigned r; asm volatile("v_cvt_pk_bf16_f32 %0, %1, %2" : "=v"(r) : "v"(lo), "v"(hi)); return r; }
typedef float f32x2 __attribute__((ext_vector_type(2)));
template <class Epi, class Sched, bool STAMP = false>
__device__ __forceinline__ void gemm_phase(PG8_LAS unsigned char* lds, const Gemm g, const Sched& S, const Epi& E, unsigned long long* stamps) {
    int tid_ = threadIdx.x; asm volatile("" : "+v"(tid_));
    const int tid = tid_, wid = __builtin_amdgcn_readfirstlane(tid >> 6), lane = tid & 63, wr = wid >> 2, wc = wid & 3, fr = lane & 15, fq = lane >> 4;
    const int K = g.K, nt = K / BK;
    int ts_lo = 0, ts_hi = 0, nts = 0; const unsigned long long rt_entry = STAMP ? (unsigned long long)wall_clock64() : 0ull;
#define PG8_STAMP() do { if (STAMP && wid == 0 && nts < 64) { const unsigned long long _c = (unsigned long long)clock64(); \
        ts_lo = (lane == nts) ? (int)(unsigned)_c : ts_lo; ts_hi = (lane == nts) ? (int)(unsigned)(_c >> 32) : ts_hi; ++nts; } } while (0)
    PG8_STAMP();
    unsigned voffA[2], voffB[2];
#pragma unroll
    for (int i = 0; i < 2; ++i) { int R, C; stage_rc(tid * 16 + i * 8192, R, C); const int Rb = Epi::PERM ? ((R & ~31) + perm32(R & 31)) : R;
        voffA[i] = (unsigned)(R * K + C) * 2u; voffB[i] = (unsigned)(Rb * K + C) * 2u; }
    const size_t kstep = (size_t)(BK * 2);
    const size_t hstep = (size_t)HALF * K * 2;
    const size_t tstep = 2 * hstep;
    const unsigned ldsw = (unsigned)wid * 1024u;
    const int aoff = lds_byte(wr * 64 + fr, fq * 8), boff = lds_byte(wc * 32 + fr, fq * 8);
#define PG8_SA(b, h) (((b) * 2 + (h)) * HTB)
#define PG8_SB(b, h) ((4 + (b) * 2 + (h)) * HTB)
#define PG8_STAGE(bufoff, gbase, voff) do { _Pragma("unroll") for (int _i = 0; _i < 2; ++_i) \
        __builtin_amdgcn_global_load_lds((const unsigned*)((const char*)(gbase) + (voff)[_i]), (PG8_LAS unsigned*)(lds + (bufoff) + ldsw + _i * 8192), 16, 0, 0); } while (0)
#define PG8_LDA(dst, b, h) do { _Pragma("unroll") for (int m = 0; m < 4; ++m) _Pragma("unroll") for (int k = 0; k < 2; ++k) dst[m][k] = *(const PG8_LAS bf16x8*)(lds + PG8_SA(b, h) + aoff + m * 2048 + k * 1024); } while (0)
#define PG8_LDB(dst, b, h) do { _Pragma("unroll") for (int n = 0; n < 2; ++n) _Pragma("unroll") for (int k = 0; k < 2; ++k) dst[n][k] = *(const PG8_LAS bf16x8*)(lds + PG8_SB(b, h) + boff + n * 2048 + k * 1024); } while (0)
#define PG8_MMA(ai, bj, At, Bt) do { __builtin_amdgcn_s_setprio(1); _Pragma("unroll") for (int m = 0; m < 4; ++m) _Pragma("unroll") for (int n = 0; n < 2; ++n) _Pragma("unroll") for (int k = 0; k < 2; ++k) \
        acc[ai][bj][m][n] = __builtin_amdgcn_mfma_f32_16x16x32_bf16(Bt[n][k], At[m][k], acc[ai][bj][m][n], 0, 0, 0); __builtin_amdgcn_s_setprio(0); } while (0)
#define PG8_WAIT_V(n) asm volatile("s_waitcnt vmcnt(" #n ")" ::: "memory")
#define PG8_WAIT_L(n) asm volatile("s_waitcnt lgkmcnt(" #n ")" ::: "memory")
#define PG8_BAR __builtin_amdgcn_s_barrier()
#define PG8_SCHED __builtin_amdgcn_sched_barrier(0)
    Unit cur, nxt; int ui = 0;
    if (!S.next(0, cur)) return;
    f32x4 acc[2][2][4][2];
#pragma unroll
    for (int a = 0; a < 2; ++a)
#pragma unroll
        for (int b = 0; b < 2; ++b)
#pragma unroll
            for (int m = 0; m < 4; ++m)
#pragma unroll
                for (int n = 0; n < 2; ++n) acc[a][b][m][n] = (f32x4){0.f, 0.f, 0.f, 0.f};
    bf16x8 At[4][2], B0[2][2], B1[2][2];
    const char* cA = (const char*)g.A + (size_t)cur.pm * tstep; const char* cB = (const char*)g.Bt + (size_t)cur.pn * tstep;
    S.a_ready(cur);
    PG8_STAGE(PG8_SB(0, 0), cB, voffB); PG8_STAGE(PG8_SA(0, 0), cA, voffA); PG8_STAGE(PG8_SB(0, 1), cB + hstep, voffB); PG8_STAGE(PG8_SA(0, 1), cA + hstep, voffA);
    if (wr == 1) PG8_BAR;
    PG8_WAIT_V(4); PG8_BAR;
    PG8_STAGE(PG8_SB(1, 0), cB + kstep, voffB); PG8_STAGE(PG8_SA(1, 0), cA + kstep, voffA); PG8_STAGE(PG8_SB(1, 1), cB + hstep + kstep, voffB);
    PG8_WAIT_V(6); PG8_BAR;
    PG8_STAMP();
    for (;;) {
        const bool has_next = S.next(ui + 1, nxt);
        const char* nA = has_next ? (const char*)g.A + (size_t)nxt.pm * tstep : cA; const char* nB = has_next ? (const char*)g.Bt + (size_t)nxt.pn * tstep : cB;
        for (int t = 0; t < nt; t += 2) {
            const bool last = (t == nt - 2);
            const char* a1 = cA + (size_t)(t + 1) * kstep;
            const char* a2 = last ? nA : cA + (size_t)(t + 2) * kstep; const char* b2 = last ? nB : cB + (size_t)(t + 2) * kstep;
            const char* a3 = a2 + kstep; const char* b3 = b2 + kstep;
            if (last && has_next) S.a_ready(nxt);
            PG8_LDB(B0, 0, 0); PG8_SCHED; PG8_LDA(At, 0, 0); PG8_STAGE(PG8_SA(1, 1), a1 + hstep, voffA);
            PG8_WAIT_L(8); PG8_BAR; PG8_WAIT_L(0); PG8_MMA(0, 0, At, B0); PG8_BAR; PG8_SCHED;
            PG8_LDB(B1, 0, 1); PG8_STAGE(PG8_SB(0, 0), b2, voffB);
            PG8_BAR; PG8_WAIT_L(0); PG8_MMA(0, 1, At, B1); PG8_BAR;
            PG8_LDA(At, 0, 1); PG8_STAGE(PG8_SA(0, 0), a2, voffA);
            PG8_BAR; PG8_WAIT_L(0); PG8_MMA(1, 0, At, B0); PG8_BAR; PG8_SCHED;
            PG8_STAGE(PG8_SB(0, 1), b2 + hstep, voffB);
            PG8_WAIT_V(6); PG8_BAR; PG8_MMA(1, 1, At, B1); PG8_BAR;
            PG8_LDB(B0, 1, 0); PG8_SCHED; PG8_LDA(At, 1, 0); PG8_STAGE(PG8_SA(0, 1), a2 + hstep, voffA);
            PG8_WAIT_L(8); PG8_BAR; PG8_WAIT_L(0); PG8_MMA(0, 0, At, B0); PG8_BAR; PG8_SCHED;
            PG8_LDB(B1, 1, 1); PG8_STAGE(PG8_SB(1, 0), b3, voffB);
            PG8_BAR; PG8_WAIT_L(0); PG8_MMA(0, 1, At, B1); PG8_BAR;
            PG8_LDA(At, 1, 1); PG8_STAGE(PG8_SA(1, 0), a3, voffA);
            PG8_BAR; PG8_WAIT_L(0); PG8_MMA(1, 0, At, B0); PG8_BAR; PG8_SCHED;
            PG8_STAGE(PG8_SB(1, 1), b3 + hstep, voffB);
            PG8_WAIT_V(6); PG8_BAR; PG8_MMA(1, 1, At, B1); PG8_BAR;
        }
        PG8_STAMP();
        if constexpr (!Epi::AFTER_DRAIN) { E(acc, cur, wr, wc, fr, fq); S.done(cur); }
        PG8_STAMP();
        if (!has_next) break;
#pragma unroll
        for (int a = 0; a < 2; ++a)
#pragma unroll
            for (int b = 0; b < 2; ++b)
#pragma unroll
                for (int m = 0; m < 4; ++m)
#pragma unroll
                    for (int n = 0; n < 2; ++n) acc[a][b][m][n] = (f32x4){0.f, 0.f, 0.f, 0.f};
        cur = nxt; cA = nA; cB = nB; ++ui;
    }
    PG8_WAIT_V(0);
    if (wr == 0) PG8_BAR;
    PG8_BAR;
    if constexpr (Epi::AFTER_DRAIN) { E.fused(acc, cur, wr, wc, fr, fq, lds, wid, lane); S.done(cur); }
    PG8_STAMP();
    if (STAMP && wid == 0) { stamps[lane] = lane < nts ? (((unsigned long long)(unsigned)ts_hi << 32) | (unsigned)ts_lo) : 0ull;
        if (lane == 62) stamps[62] = rt_entry; if (lane == 63) stamps[63] = (unsigned long long)wall_clock64(); }
#undef PG8_STAMP
#undef PG8_SA
#undef PG8_SB
#undef PG8_STAGE
#undef PG8_LDA
#undef PG8_LDB
#undef PG8_MMA
#undef PG8_WAIT_V
#undef PG8_WAIT_L
#undef PG8_BAR
#undef PG8_SCHED
}
}

#ifndef ONE_LAUNCH
#define ONE_LAUNCH 1
#endif
typedef unsigned short u16;
typedef pg8::f32x4 f32x4;
typedef pg8::u32x4 u32x4;
constexpr int MTOK = 32768, DM = 1024, SEQ = 2048, NB = 16, HYW = 768, NHY = 2304, NQKV = 4608, ATW = 512;
constexpr size_t MiB = 1024 * 1024;
constexpr size_t WS_HYT = 0;
constexpr size_t WS_QKV = 144 * MiB;
constexpr size_t WS_HYG = 432 * MiB;
constexpr size_t WS_ATG = 480 * MiB;
constexpr size_t WS_END = 512 * MiB;
constexpr size_t WS_YH = WS_HYT + 48 * MiB, WS_WOUT = WS_HYT + 96 * MiB;
constexpr size_t WS_SG = WS_QKV, WS_TMP = WS_QKV + 64 * MiB, WS_MRG = WS_QKV + 192 * MiB;
constexpr size_t DO_XN = 0, DO_WIN = 64 * MiB, DO_WHY = 84 * MiB, DO_WAT = DO_WHY + 1536 * 1024, DO_HF = 87 * MiB;
constexpr int LDS_BYTES = 144 * 1024;
constexpr int KBL = 4104;
constexpr int KRP = 4112;
constexpr int UP = 2056;

struct Args { const float* in[20]; float* out; unsigned char* ws; int ph_lo, ph_hi; };
struct Frame {
    const float *x, *norm_g, *w_in, *b_in, *conv_w, *conv_b, *w1, *b1, *w2, *b2, *w3, *b3, *w4, *freq, *skip, *qg, *kg, *w_hy, *w_at, *w_out;
    float* out; unsigned char* ws; unsigned char* dob;
    int tid, lane, wid;
};

__device__ __forceinline__ u16 f2bf(float f) { unsigned u = __float_as_uint(f); u += 0x7FFFu + ((u >> 16) & 1u); return (u16)(u >> 16); }
__device__ __forceinline__ float bf2f(u16 b) { return __uint_as_float(((unsigned)b) << 16); }
__device__ __forceinline__ float bflo(unsigned w) { return __uint_as_float(w << 16); }
__device__ __forceinline__ float bfhi(unsigned w) { return __uint_as_float(w & 0xffff0000u); }
typedef float f32x2v __attribute__((ext_vector_type(2)));
typedef __bf16 bf16x2v __attribute__((ext_vector_type(2)));
__device__ __forceinline__ unsigned pk2(float lo, float hi) { const f32x2v v = {lo, hi}; return __builtin_bit_cast(unsigned, __builtin_convertvector(v, bf16x2v)); }
__device__ __forceinline__ float sigmoidf_(float v) { return __builtin_amdgcn_rcpf(1.0f + __builtin_amdgcn_exp2f(-1.4426950408889634f * v)); }
__device__ __forceinline__ float siluf_(float v) { return v * __builtin_amdgcn_rcpf(1.0f + __builtin_amdgcn_exp2f(-1.4426950408889634f * v)); }

typedef unsigned u32x4u __attribute__((ext_vector_type(4), aligned(2)));
__device__ __forceinline__ void transpose_tile_f32(const float* src, int K, int N, u16* dst, int k0, int n0, u16* tile, int tid) {
    const int kl = tid >> 3, nc = (tid & 7) * 8;
    const float4* p = (const float4*)(src + (size_t)(k0 + kl) * N + n0 + nc);
    const float4* p2 = (const float4*)(src + (size_t)(k0 + 64 + kl) * N + n0 + nc);
    const float4 a = p[0], b = p[1], c = p2[0], d = p2[1];
    tile[(nc + 0) * 136 + kl] = f2bf(a.x); tile[(nc + 1) * 136 + kl] = f2bf(a.y); tile[(nc + 2) * 136 + kl] = f2bf(a.z); tile[(nc + 3) * 136 + kl] = f2bf(a.w);
    tile[(nc + 4) * 136 + kl] = f2bf(b.x); tile[(nc + 5) * 136 + kl] = f2bf(b.y); tile[(nc + 6) * 136 + kl] = f2bf(b.z); tile[(nc + 7) * 136 + kl] = f2bf(b.w);
    tile[(nc + 0) * 136 + 64 + kl] = f2bf(c.x); tile[(nc + 1) * 136 + 64 + kl] = f2bf(c.y); tile[(nc + 2) * 136 + 64 + kl] = f2bf(c.z); tile[(nc + 3) * 136 + 64 + kl] = f2bf(c.w);
    tile[(nc + 4) * 136 + 64 + kl] = f2bf(d.x); tile[(nc + 5) * 136 + 64 + kl] = f2bf(d.y); tile[(nc + 6) * 136 + 64 + kl] = f2bf(d.z); tile[(nc + 7) * 136 + 64 + kl] = f2bf(d.w);
    __syncthreads();
    const int nl = tid >> 3, kc = (tid & 7) * 16;
    const uint4 w0 = *(const uint4*)&tile[nl * 136 + kc], w1 = *(const uint4*)&tile[nl * 136 + kc + 8];
    uint4* dp = (uint4*)(dst + (size_t)(n0 + nl) * K + k0 + kc); dp[0] = w0; dp[1] = w1;
    __syncthreads();
}
__device__ void transpose_weight(const float* src, int K, int N, u16* dst, u16* tile, int tid) {
    const int nkt = K / 128, nnt = N / 64;
    for (int t = blockIdx.x; t < nkt * nnt; t += gridDim.x) transpose_tile_f32(src, K, N, dst, (t % nkt) * 128, (t / nkt) * 64, tile, tid);
}

__device__ void p0_prologue(const Frame& F, unsigned char* lds) {
    const int tid = F.tid, lane = F.lane, wid = F.wid;
    u16* XN = (u16*)(F.dob + DO_XN);
    for (int row = (blockIdx.x * 8 + wid) * 2; row < MTOK; row += gridDim.x * 16) {
        const float4* xr = (const float4*)(F.x + (size_t)row * DM);
        float4 v[8]; float s0 = 0.f, s1 = 0.f;
#pragma unroll
        for (int i = 0; i < 8; ++i) { const f32x4 t = __builtin_nontemporal_load((const f32x4*)xr + lane + 64 * i); v[i] = make_float4(t.x, t.y, t.z, t.w); }
#pragma unroll
        for (int i = 0; i < 4; ++i) { s0 += v[i].x * v[i].x + v[i].y * v[i].y + v[i].z * v[i].z + v[i].w * v[i].w;
            s1 += v[i + 4].x * v[i + 4].x + v[i + 4].y * v[i + 4].y + v[i + 4].z * v[i + 4].z + v[i + 4].w * v[i + 4].w; }
#pragma unroll
        for (int o = 32; o >= 1; o >>= 1) { s0 += __shfl_xor(s0, o); s1 += __shfl_xor(s1, o); }
        const float r0 = rsqrtf(s0 * (1.0f / DM) + 1e-6f), r1 = rsqrtf(s1 * (1.0f / DM) + 1e-6f);
#pragma unroll
        for (int i = 0; i < 4; ++i) { const float4 g = ((const float4*)F.norm_g)[lane + 64 * i];
            uint2 w; w.x = pk2(v[i].x * r0 * g.x, v[i].y * r0 * g.y); w.y = pk2(v[i].z * r0 * g.z, v[i].w * r0 * g.w);
            *(uint2*)(XN + (size_t)row * DM + 4 * (lane + 64 * i)) = w;
            uint2 w2; w2.x = pk2(v[i + 4].x * r1 * g.x, v[i + 4].y * r1 * g.y); w2.y = pk2(v[i + 4].z * r1 * g.z, v[i + 4].w * r1 * g.w);
            *(uint2*)(XN + (size_t)(row + 1) * DM + 4 * (lane + 64 * i)) = w2; }
    }
    u16* tile = (u16*)lds;
    transpose_weight(F.w_in, DM, 10240, (u16*)(F.dob + DO_WIN), tile, tid);
    transpose_weight(F.w_hy, HYW, DM, (u16*)(F.dob + DO_WHY), tile, tid);
    transpose_weight(F.w_at, ATW, DM, (u16*)(F.dob + DO_WAT), tile, tid);
    u16* KB = (u16*)(F.dob + DO_HF);
    float* zs = (float*)lds;
    float* ha = zs + 8 * 40;
    float* hb = ha + 8 * 64;
    float* ws1 = hb + 8 * 64;
    float* ws2 = ws1 + 33 * 64;
    float* ws3 = ws2 + 64 * 64;
    __syncthreads();
    for (int e = tid; e < 33 * 16; e += 512) ((float4*)ws1)[e] = ((const float4*)F.w1)[e];
    for (int e = tid; e < 64 * 16; e += 512) { ((float4*)ws2)[e] = ((const float4*)F.w2)[e]; ((float4*)ws3)[e] = ((const float4*)F.w3)[e]; }
    for (int blk = blockIdx.x; blk < SEQ / 8; blk += gridDim.x) {
        const int t0 = blk * 8;
        __syncthreads();
        if (tid < 8 * 33) { const int p = tid / 33, i = tid % 33; const float tt = (float)(t0 + p);
            float val;
            if (i == 0) val = tt * (1.0f / 2047.0f);
            else { const int j = (i - 1) & 15; const float f = 1e-4f + (float)j * ((15.0f - 1e-4f) / 15.0f); const float w = 6.283185307179586f * tt * (1.0f / 2048.0f); const float a = f * w;
                val = (i <= 16) ? cosf(a) : -sinf(a); }
            zs[p * 40 + i] = val; }
        __syncthreads();
        const int p = tid >> 6, j = tid & 63; const float fr = F.freq[j];
        { float a = F.b1[j];
#pragma unroll 3
          for (int i = 0; i < 33; ++i) a += zs[p * 40 + i] * ws1[i * 64 + j]; ha[p * 64 + j] = sinf(fr * a); }
        __syncthreads();
        { float a = F.b2[j];
#pragma unroll 4
          for (int i = 0; i < 64; ++i) a += ha[p * 64 + i] * ws2[i * 64 + j]; hb[p * 64 + j] = sinf(fr * a); }
        __syncthreads();
        { float a = F.b3[j];
#pragma unroll 4
          for (int i = 0; i < 64; ++i) a += hb[p * 64 + i] * ws3[i * 64 + j]; ha[p * 64 + j] = sinf(fr * a); }
        __syncthreads();
#pragma unroll 1
        for (int col = tid; col < 3072; col += 512) {
            float acc[8];
#pragma unroll
            for (int q = 0; q < 8; ++q) acc[q] = 0.f;
            float wv[64];
#pragma unroll
            for (int k = 0; k < 64; ++k) wv[k] = F.w4[k * 3072 + col];
            int hoff = 0; asm volatile("" : "+v"(hoff));
#pragma unroll
            for (int k4 = 0; k4 < 16; ++k4)
#pragma unroll
                for (int q = 0; q < 8; ++q) { const float4 h = *(const float4*)&ha[hoff + q * 64 + 4 * k4];
                    acc[q] += h.x * wv[4 * k4] + h.y * wv[4 * k4 + 1] + h.z * wv[4 * k4 + 2] + h.w * wv[4 * k4 + 3]; }
            const int o = col / 1536, d = (col % 1536) / 768, c = col % 768;
            const float dmin = 3.0701134573253944f, dmax = 15.350567286626972f;
            const float ad = dmin + (float)c * ((dmax - dmin) / 767.0f);
#pragma unroll
            for (int q = 0; q < 8; ++q) acc[q] *= expf(-((float)(t0 + q) * (1.0f / 2047.0f)) * ad);
            u16* kb = KB + (size_t)(o * HYW + c) * KBL;
            if (d == 0) { u32x4u w; w.x = pk2(acc[7], acc[6]); w.y = pk2(acc[5], acc[4]); w.z = pk2(acc[3], acc[2]); w.w = pk2(acc[1], acc[0]);
                *(u32x4u*)(kb + 2041 - t0) = w;
                if (t0 == 0) { kb[0] = 0;
#pragma unroll
                    for (int q = 0; q < 8; ++q) kb[4096 + q] = 0; } }
            else if (t0 > 0) { u32x4u w; w.x = pk2(acc[0], acc[1]); w.y = pk2(acc[2], acc[3]); w.z = pk2(acc[4], acc[5]); w.w = pk2(acc[6], acc[7]); *(u32x4u*)(kb + 2048 + t0) = w; }
            else {
#pragma unroll
                for (int q = 1; q < 8; ++q) kb[2048 + q] = f2bf(acc[q]); }
        }
    }
    __syncthreads();
}

template <int ACT> __device__ __forceinline__ void store_rm(const f32x4 (&acc)[2][2][4][2], const f32x4 (&bv)[2][2], u16* base, int ldc, int row0, int col0) {
#pragma unroll
    for (int ai = 0; ai < 2; ++ai)
#pragma unroll
        for (int m = 0; m < 4; ++m) { u16* rowp = base + (size_t)(row0 + ai * 128 + m * 16) * ldc + col0;
#pragma unroll
            for (int bj = 0; bj < 2; ++bj) { f32x4 v0 = acc[ai][bj][m][0] + bv[bj][0], v1 = acc[ai][bj][m][1] + bv[bj][1];
                if (ACT) {
#pragma unroll
                    for (int j = 0; j < 4; ++j) { v0[j] = siluf_(v0[j]); v1[j] = siluf_(v1[j]); } }
                u32x4 w; w.x = pk2(v0[0], v0[1]); w.y = pk2(v0[2], v0[3]); w.z = pk2(v1[0], v1[1]); w.w = pk2(v1[2], v1[3]);
                __builtin_nontemporal_store(w, (u32x4*)(rowp + bj * 128)); } }
}
struct Epi1 {
    static constexpr bool PERM = true, AFTER_DRAIN = false;
    u16 *hyt, *qkv, *hyg, *atg; const float* bias; PG8_LAS unsigned char* tr;
    __device__ __forceinline__ void operator()(const f32x4 (&acc)[2][2][4][2], const pg8::Unit& u, int wr, int wc, int fr, int fq) const {
        const int row0 = u.pm * 256 + wr * 64 + fr, colg = u.pn * 256 + wc * 32 + 8 * fq;
        f32x4 bv[2][2];
#pragma unroll
        for (int bj = 0; bj < 2; ++bj)
#pragma unroll
            for (int n = 0; n < 2; ++n) bv[bj][n] = *(const f32x4*)(bias + colg + bj * 128 + 4 * n);
        if (u.pn < 9) {
            const int lane = fr + 16 * fq;
            PG8_LAS unsigned char* T = tr + (wr * 4 + wc) * 2048;
            const int colw = u.pn * 256 + wc * 32, roww = u.pm * 256 + wr * 64;
#pragma unroll
            for (int ai = 0; ai < 2; ++ai)
#pragma unroll
                for (int mp = 0; mp < 2; ++mp)
#pragma unroll
                    for (int bj = 0; bj < 2; ++bj) {
#pragma unroll
                        for (int mm = 0; mm < 2; ++mm)
#pragma unroll
                            for (int n = 0; n < 2; ++n) { const f32x4 v = acc[ai][bj][2 * mp + mm][n] + bv[bj][n];
#pragma unroll
                                for (int j = 0; j < 4; ++j) *(PG8_LAS u16*)(T + (8 * fq + 4 * n + j) * 64 + (16 * mm + fr) * 2) = f2bf(v[j]); }
                        asm volatile("s_waitcnt lgkmcnt(0)" ::: "memory");
                        const u32x4 w0 = *(PG8_LAS const u32x4*)(T + (lane >> 1) * 64 + (lane & 1) * 32), w1 = *(PG8_LAS const u32x4*)(T + (lane >> 1) * 64 + (lane & 1) * 32 + 16);
                        u16* dst = hyt + (size_t)(colw + bj * 128 + (lane >> 1)) * MTOK + roww + ai * 128 + 32 * mp + 16 * (lane & 1);
                        __builtin_nontemporal_store(w0, (u32x4*)dst); __builtin_nontemporal_store(w1, (u32x4*)(dst + 8));
                        asm volatile("" ::: "memory");
                    }
            return;
        }
        if (u.pn < 12) store_rm<1>(acc, bv, hyg, HYW, row0, colg - 2304);
        else if (u.pn < 30) store_rm<0>(acc, bv, qkv, NQKV, row0, colg - 3072);
        else store_rm<1>(acc, bv, atg, ATW, row0, colg - 7680);
    }
};
struct EpiSig {
    static constexpr bool PERM = true, AFTER_DRAIN = false;
    u16* sg; const float* bias;
    __device__ __forceinline__ void operator()(const f32x4 (&acc)[2][2][4][2], const pg8::Unit& u, int wr, int wc, int fr, int fq) const {
        const int row0 = u.pm * 256 + wr * 64 + fr, col0 = u.pn * 256 + wc * 32 + 8 * fq;
        f32x4 bv[2][2];
#pragma unroll
        for (int bj = 0; bj < 2; ++bj)
#pragma unroll
            for (int n = 0; n < 2; ++n) bv[bj][n] = *(const f32x4*)(bias + col0 + bj * 128 + 4 * n);
#pragma unroll
        for (int ai = 0; ai < 2; ++ai)
#pragma unroll
            for (int m = 0; m < 4; ++m) { u16* rowp = sg + (size_t)(row0 + ai * 128 + m * 16) * DM + col0;
#pragma unroll
                for (int bj = 0; bj < 2; ++bj) { f32x4 v0 = acc[ai][bj][m][0] + bv[bj][0], v1 = acc[ai][bj][m][1] + bv[bj][1];
#pragma unroll
                    for (int j = 0; j < 4; ++j) { v0[j] = sigmoidf_(v0[j]); v1[j] = sigmoidf_(v1[j]); }
                    u32x4 w; w.x = pk2(v0[0], v0[1]); w.y = pk2(v0[2], v0[3]); w.z = pk2(v1[0], v1[1]); w.w = pk2(v1[2], v1[3]);
                    *(u32x4*)(rowp + bj * 128) = w; } }
    }
};
template <int MODE  > struct EpiGate {
    static constexpr bool PERM = true, AFTER_DRAIN = false;
    const u16* sg; u16* tmp; u16* mrg;
    __device__ __forceinline__ void operator()(const f32x4 (&acc)[2][2][4][2], const pg8::Unit& u, int wr, int wc, int fr, int fq) const {
        const int row0 = u.pm * 256 + wr * 64 + fr, col0 = u.pn * 256 + wc * 32 + 8 * fq;
#pragma unroll
        for (int ai = 0; ai < 2; ++ai)
#pragma unroll
            for (int m = 0; m < 4; ++m) { const size_t off = (size_t)(row0 + ai * 128 + m * 16) * DM + col0;
#pragma unroll
                for (int bj = 0; bj < 2; ++bj) { const u32x4 s = *(const u32x4*)(sg + off + bj * 128);
                    f32x4 v0 = acc[ai][bj][m][0], v1 = acc[ai][bj][m][1];
                    v0[0] *= bflo(s.x); v0[1] *= bfhi(s.x); v0[2] *= bflo(s.y); v0[3] *= bfhi(s.y); v1[0] *= bflo(s.z); v1[1] *= bfhi(s.z); v1[2] *= bflo(s.w); v1[3] *= bfhi(s.w);
                    if (MODE == 1) { const u32x4 t = *(const u32x4*)(tmp + off + bj * 128);
                        v0[0] += bflo(t.x); v0[1] += bfhi(t.x); v0[2] += bflo(t.y); v0[3] += bfhi(t.y); v1[0] += bflo(t.z); v1[1] += bfhi(t.z); v1[2] += bflo(t.w); v1[3] += bfhi(t.w); }
                    u32x4 w; w.x = pk2(v0[0], v0[1]); w.y = pk2(v0[2], v0[3]); w.z = pk2(v1[0], v1[1]); w.w = pk2(v1[2], v1[3]);
                    *(u32x4*)((MODE == 0 ? tmp : mrg) + off + bj * 128) = w; } }
    }
};
struct EpiOut {
    static constexpr bool PERM = true, AFTER_DRAIN = false;
    const float* x; float* out;
    __device__ __forceinline__ void operator()(const f32x4 (&acc)[2][2][4][2], const pg8::Unit& u, int wr, int wc, int fr, int fq) const {
        const int row0 = u.pm * 256 + wr * 64 + fr, col0 = u.pn * 256 + wc * 32 + 8 * fq;
#pragma unroll
        for (int ai = 0; ai < 2; ++ai) {
            f32x4 xv[4][2][2];
#pragma unroll
            for (int m = 0; m < 4; ++m) { const size_t off = (size_t)(row0 + ai * 128 + m * 16) * DM + col0;
#pragma unroll
                for (int bj = 0; bj < 2; ++bj) { xv[m][bj][0] = *(const f32x4*)(x + off + bj * 128); xv[m][bj][1] = *(const f32x4*)(x + off + bj * 128 + 4); } }
            __builtin_amdgcn_sched_barrier(0);
#pragma unroll
            for (int m = 0; m < 4; ++m) { const size_t off = (size_t)(row0 + ai * 128 + m * 16) * DM + col0;
#pragma unroll
                for (int bj = 0; bj < 2; ++bj) { *(f32x4*)(out + off + bj * 128) = xv[m][bj][0] + acc[ai][bj][m][0]; *(f32x4*)(out + off + bj * 128 + 4) = xv[m][bj][1] + acc[ai][bj][m][1]; } }
            __builtin_amdgcn_sched_barrier(0);
        }
    }
};

typedef pg8::bf16x8 bf16x8;
__device__ __forceinline__ void load_conv(const u16* grow, float w0, float w1, float w2, float cb, u16* dst, int tid) {
#pragma unroll 2
    for (int k = 0; k < 8; ++k) { const int chunk = tid + 512 * k, b = chunk >> 8, t8 = (chunk & 255) * 8; const u16* p = grow + b * SEQ + t8;
        const u32x4 wq = __builtin_nontemporal_load((const u32x4*)p); const uint4 w = (uint4){wq.x, wq.y, wq.z, wq.w}; const float pm = t8 > 0 ? bf2f(p[-1]) : 0.f, pn = t8 + 8 < SEQ ? bf2f(p[8]) : 0.f;
        const float e0 = bflo(w.x), e1 = bfhi(w.x), e2 = bflo(w.y), e3 = bfhi(w.y), e4 = bflo(w.z), e5 = bfhi(w.z), e6 = bflo(w.w), e7 = bfhi(w.w);
        uint4 r; r.x = pk2(cb + w0 * pm + w1 * e0 + w2 * e1, cb + w0 * e0 + w1 * e1 + w2 * e2); r.y = pk2(cb + w0 * e1 + w1 * e2 + w2 * e3, cb + w0 * e2 + w1 * e3 + w2 * e4);
        r.z = pk2(cb + w0 * e3 + w1 * e4 + w2 * e5, cb + w0 * e4 + w1 * e5 + w2 * e6); r.w = pk2(cb + w0 * e5 + w1 * e6 + w2 * e7, cb + w0 * e6 + w1 * e7 + w2 * pn);
        *(uint4*)(dst + b * UP + t8) = r; }
}
__device__ __forceinline__ void build_kr(const u16* kb, u16* KR, int tid) {
#pragma unroll
    for (int k = 0; k < 8; ++k) { const int ch = tid + 512 * k, sg = ch >> 9, x8 = (ch & 511) * 8;
        u32x4u w = (u32x4u){0u, 0u, 0u, 0u};
        if (x8 != 0) w = *(const u32x4u*)(kb + x8 - sg);
        *(uint4*)(KR + sg * KRP + x8) = (uint4){w.x, w.y, w.z, w.w}; }
}
__device__ __forceinline__ void conv_mfma(PG8_LAS const unsigned char* KRb, PG8_LAS const unsigned char* Ub, int wid, int lane, f32x4 (&acc)[16]) {
    const int i = lane & 15, q = lane >> 4, T0 = wid * 16;
    const int abase = (i & 7) * (KRP * 2) + (8 * (q - (i >> 3)) + 2048) * 2;
    const int bbase = i * (UP * 2) + 16 * q;
#pragma unroll
    for (int t = 0; t < 16; ++t) acc[t] = (f32x4){0.f, 0.f, 0.f, 0.f};
#pragma unroll 1
    for (int sr = 0; sr < 4; ++sr) {
        const int S0 = sr * 16;
        bf16x8 Bf[16];
#pragma unroll
        for (int sl = 0; sl < 16; ++sl) Bf[sl] = *(PG8_LAS const bf16x8*)(Ub + bbase + 64 * (S0 + sl));
        PG8_LAS const unsigned char* ap = KRb + (abase - 32 * (T0 - 2 * S0) - 480);
#pragma unroll
        for (int dl = -30; dl <= 15; ++dl) {
            const bf16x8 a = *(PG8_LAS const bf16x8*)(ap + 32 * (15 - dl));
#pragma unroll
            for (int sl = 0; sl < 16; ++sl) { const int t = dl + 2 * sl; if (t >= 0 && t < 16) acc[t] = __builtin_amdgcn_mfma_f32_16x16x32_bf16(a, Bf[sl], acc[t], 0, 0, 0); }
        }
    }
}
__device__ __forceinline__ void hy_epilogue(const f32x4 (&acc)[16], const u16* X, u16* U, float skip, int wid, int lane) {
    const int b = lane & 15, q = lane >> 4;
#pragma unroll
    for (int tl = 0; tl < 16; ++tl) { const int t = 16 * (wid * 16 + tl) + 4 * q;
        const uint2 xv = *(const uint2*)(X + b * UP + t), uv = *(const uint2*)(U + b * UP + t); uint2 r;
        r.x = pk2(bflo(xv.x) * (acc[tl][0] + bflo(uv.x) * skip), bfhi(xv.x) * (acc[tl][1] + bfhi(uv.x) * skip));
        r.y = pk2(bflo(xv.y) * (acc[tl][2] + bflo(uv.y) * skip), bfhi(xv.y) * (acc[tl][3] + bfhi(uv.y) * skip));
        *(uint2*)(U + b * UP + t) = r; }
}
__device__ __forceinline__ unsigned touch64k(const u16* blk, int tid) { return *(const unsigned*)(blk + tid * 64); }
__device__ void hyena_mfma(const Frame& F, unsigned char* lds, bool do_store = true) {
    int tid = threadIdx.x; asm volatile("" : "+v"(tid));
    const int lane = tid & 63, wid = __builtin_amdgcn_readfirstlane(tid >> 6);
    u16* KR = (u16*)lds; u16* U = (u16*)(lds + 8 * KRP * 2);
    PG8_LAS const unsigned char* KRb = (PG8_LAS const unsigned char*)lds; PG8_LAS const unsigned char* Ub = KRb + 8 * KRP * 2;
    const u16* KB = (const u16*)(F.dob + DO_HF);
    u16* HYT = (u16*)(F.ws + WS_HYT);
    for (int c = blockIdx.x; c < HYW; c += gridDim.x) {
        const float wv0 = F.conv_w[c], wv1 = F.conv_w[NHY + c], wv2 = F.conv_w[2 * NHY + c], cbv = F.conv_b[c];
        const float wa0 = F.conv_w[HYW + c], wa1 = F.conv_w[NHY + HYW + c], wa2 = F.conv_w[2 * NHY + HYW + c], cba = F.conv_b[HYW + c];
        const float wb0 = F.conv_w[2 * HYW + c], wb1 = F.conv_w[NHY + 2 * HYW + c], wb2 = F.conv_w[2 * NHY + 2 * HYW + c], cbb = F.conv_b[2 * HYW + c];
        const float skip0 = F.skip[c], skip1 = F.skip[HYW + c];
        f32x4 acc[16];
        __syncthreads();
        load_conv(HYT + (size_t)c * MTOK, wv0, wv1, wv2, cbv, U, tid);
        build_kr(KB + (size_t)(0 * HYW + c) * KBL, KR, tid);
        unsigned tc0 = touch64k(HYT + (size_t)(HYW + c) * MTOK, tid), tc1 = tid < 65 ? touch64k(KB + (size_t)(HYW + c) * KBL, tid) : 0u;
        __syncthreads();
        conv_mfma(KRb, Ub, wid, lane, acc);
        asm volatile("" :: "v"(tc0), "v"(tc1));
        __syncthreads();
        load_conv(HYT + (size_t)(HYW + c) * MTOK, wa0, wa1, wa2, cba, KR, tid);
        __syncthreads();
        hy_epilogue(acc, KR, U, skip0, wid, lane);
        __syncthreads();
        build_kr(KB + (size_t)(1 * HYW + c) * KBL, KR, tid);
        { const int cn = c + (int)gridDim.x < HYW ? c + (int)gridDim.x : c;
          tc0 = touch64k(HYT + (size_t)(2 * HYW + c) * MTOK, tid); tc1 = touch64k(HYT + (size_t)cn * MTOK, tid); }
        __syncthreads();
        conv_mfma(KRb, Ub, wid, lane, acc);
        asm volatile("" :: "v"(tc0), "v"(tc1));
        __syncthreads();
        load_conv(HYT + (size_t)(2 * HYW + c) * MTOK, wb0, wb1, wb2, cbb, KR, tid);
        __syncthreads();
        hy_epilogue(acc, KR, U, skip1, wid, lane);
        __syncthreads();
        if (do_store)
#pragma unroll 2
        for (int k = 0; k < 8; ++k) { const int chunk = tid + 512 * k, b = chunk >> 8, t8 = (chunk & 255) * 8;
            __builtin_nontemporal_store(*(const u32x4*)(U + b * UP + t8), (u32x4*)(HYT + (size_t)c * MTOK + b * SEQ + t8)); }
    }
    __syncthreads();
}

constexpr size_t DO_LG = 111 * MiB;
__device__ __forceinline__ uint4 pk8(const float (&v)[8]) { uint4 r; r.x = pk2(v[0], v[1]); r.y = pk2(v[2], v[3]); r.z = pk2(v[4], v[5]); r.w = pk2(v[6], v[7]); return r; }
__device__ __forceinline__ void up8(const uint4 w, float (&v)[8]) { v[0] = bflo(w.x); v[1] = bfhi(w.x); v[2] = bflo(w.y); v[3] = bfhi(w.y); v[4] = bflo(w.z); v[5] = bfhi(w.z); v[6] = bflo(w.w); v[7] = bfhi(w.w); }
__device__ __forceinline__ bf16x8 as_frag(const uint4 w) { union { uint4 u; bf16x8 f; } c; c.u = w; return c.f; }
struct AChunk { uint4 k[2][2]; uint4 v[4]; };
typedef short s16x4 __attribute__((ext_vector_type(4)));
__device__ void attn_mfma(const Frame& F, unsigned char* lds, bool do_store = true) {
    int tid = threadIdx.x; asm volatile("" : "+v"(tid));
    const int lane = tid & 63, wid = __builtin_amdgcn_readfirstlane(tid >> 6), c16 = lane & 15, q = lane >> 4;
    u16* QKV = (u16*)(F.ws + WS_QKV); float* LG = (float*)(F.dob + DO_LG);
    unsigned char* Vs = lds + wid * 5120;
    PG8_LAS const unsigned char* Vs3 = (PG8_LAS const unsigned char*)Vs;
    const int krow_off = 8 * (c16 >> 2) + (c16 & 3);
    const int tr_off = (8 * q + (c16 >> 2)) * 144 + 8 * (lane & 3);
    const float LOG2E = 1.4426950408889634f;
    float gm = fabsf(F.qg[lane] * F.kg[lane]);
#pragma unroll
    for (int o = 32; o >= 1; o >>= 1) gm = fmaxf(gm, __shfl_xor(gm, o));
    const float cmax2 = 8.0f * gm * LOG2E;
    volatile PG8_LAS float* gqt = (volatile PG8_LAS float*)((PG8_LAS unsigned char*)lds + 8 * 5120);
    __syncthreads();
    if (tid < 64) gqt[tid] = F.qg[tid] * F.kg[tid] * (0.125f * LOG2E);
    __syncthreads();
    for (int item = blockIdx.x * 8 + wid; item < NB * 8 * 3 * 32; item += gridDim.x * 8) {
        const int blk = item & 31, rest = item >> 5, g = rest % 3, bh = rest / 3, h = bh & 7, b = bh >> 3;
        const int dsh = 2 * g, n = SEQ >> dsh, nbn = 32 >> dsh, r = blk >> (5 - dsh), nb = blk & (nbn - 1);
        const float ca2 = exp2f(-(float)(h + 1)) * (float)(1 << dsh) * LOG2E;
        const size_t colq = (size_t)g * 512 + h * 64;
        const u16* base = QKV + (size_t)b * SEQ * NQKV;
        const int kc_lo = nb == 0 ? 2 : 0, kc_hi = nb == nbn - 1 ? 4 : 6;
        auto load_chunk = [&](AChunk& c, int j0c) {
#pragma unroll
            for (int kt = 0; kt < 2; ++kt) { int jk = j0c + 4 * kt + krow_off; jk = jk < 0 ? 0 : (jk > n - 1 ? n - 1 : jk);
                const u16* krow = base + (size_t)((jk << dsh) + r) * NQKV + 1536 + colq;
                c.k[kt][0] = *(const uint4*)(krow + 8 * q); c.k[kt][1] = *(const uint4*)(krow + 32 + 8 * q); }
            int jv = j0c + (lane >> 1); jv = jv < 0 ? 0 : (jv > n - 1 ? n - 1 : jv);
            const u16* vrow = base + (size_t)((jv << dsh) + r) * NQKV + 3072 + colq + 32 * (lane & 1);
#pragma unroll
            for (int v4 = 0; v4 < 4; ++v4) c.v[v4] = *(const uint4*)(vrow + 8 * v4);
        };
        AChunk cur;
        bf16x8 Qf[4][2];
#pragma unroll
        for (int qt = 0; qt < 4; ++qt) { const int i = 64 * nb + 16 * qt + c16; const u16* qrow = base + (size_t)((i << dsh) + r) * NQKV + colq;
            float v0[8], v1[8]; up8(*(const uint4*)(qrow + 8 * q), v0); up8(*(const uint4*)(qrow + 32 + 8 * q), v1);
            float ss = 0.f;
#pragma unroll
            for (int e = 0; e < 8; ++e) ss += v0[e] * v0[e] + v1[e] * v1[e];
            ss += __shfl_xor(ss, 16); ss += __shfl_xor(ss, 32);
            const float rq = rsqrtf(ss * (1.0f / 64.0f) + 1e-6f);
#pragma unroll
            for (int e = 0; e < 8; ++e) { v0[e] *= rq * gqt[8 * q + e]; v1[e] *= rq * gqt[32 + 8 * q + e]; }
            Qf[qt][0] = as_frag(pk8(v0)); Qf[qt][1] = as_frag(pk8(v1)); }
        f32x4 Oacc[4][4]; f32x4 Lacc[4];
#pragma unroll
        for (int dt = 0; dt < 4; ++dt)
#pragma unroll
            for (int qt = 0; qt < 4; ++qt) Oacc[dt][qt] = (f32x4){0.f, 0.f, 0.f, 0.f};
#pragma unroll
        for (int qt = 0; qt < 4; ++qt) Lacc[qt] = (f32x4){0.f, 0.f, 0.f, 0.f};
#pragma unroll 1
        for (int kc = kc_lo; kc < kc_hi; ++kc) {
            const int j0c = 64 * (nb - 1) + 32 * kc;
            load_chunk(cur, j0c);
            unsigned tch0 = 0, tch1 = 0;
            if (kc + 1 < kc_hi) {
                int jk = j0c + 32 + (lane >> 1); jk = jk < 0 ? 0 : (jk > n - 1 ? n - 1 : jk);
                const u16* rowp = base + (size_t)((jk << dsh) + r) * NQKV + colq + ((lane & 1) ? 3072 : 1536);
                tch0 = *(const unsigned*)rowp; }
            { unsigned char* dst = Vs + (lane >> 1) * 144 + (lane & 1) * 64;
#pragma unroll
              for (int v4 = 0; v4 < 4; ++v4) *(uint4*)(dst + 16 * v4) = cur.v[v4]; }
            bf16x8 kf[2][2];
#pragma unroll
            for (int kt = 0; kt < 2; ++kt) {
                float v0[8], v1[8]; up8(cur.k[kt][0], v0); up8(cur.k[kt][1], v1);
                float ss = 0.f;
#pragma unroll
                for (int e = 0; e < 8; ++e) ss += v0[e] * v0[e] + v1[e] * v1[e];
                ss += __shfl_xor(ss, 16); ss += __shfl_xor(ss, 32);
                const float rk = rsqrtf(ss * (1.0f / 64.0f) + 1e-6f);
#pragma unroll
                for (int e = 0; e < 8; ++e) { v0[e] *= rk; v1[e] *= rk; }
                kf[kt][0] = as_frag(pk8(v0)); kf[kt][1] = as_frag(pk8(v1)); }
            bf16x8 Pf[4];
            int rel0 = 64 + c16 - 8 * q - 32 * kc;
            asm volatile("" : "+v"(rel0));
            const float relf0 = (float)rel0;
            const bool edge = (kc < 2) || (kc > 3);
#pragma unroll
            for (int qt = 0; qt < 4; ++qt) { float p[8];
#pragma unroll
                for (int kt = 0; kt < 2; ++kt) { f32x4 z = (f32x4){-cmax2, -cmax2, -cmax2, -cmax2};
                    z = __builtin_amdgcn_mfma_f32_16x16x32_bf16(kf[kt][0], Qf[qt][0], z, 0, 0, 0);
                    z = __builtin_amdgcn_mfma_f32_16x16x32_bf16(kf[kt][1], Qf[qt][1], z, 0, 0, 0);
#pragma unroll
                    for (int j = 0; j < 4; ++j) { const float dist = fabsf(relf0 + (float)(16 * qt - 4 * kt - j));
                        const float pv = __builtin_amdgcn_exp2f(z[j] - ca2 * dist);
                        p[4 * kt + j] = (edge && dist > 64.0f) ? 0.f : pv; } }
                Pf[qt] = as_frag(pk8(p)); }
            asm volatile("" ::: "memory");
#pragma unroll
            for (int dt = 0; dt < 4; ++dt) {
                const s16x4 a0 = __builtin_amdgcn_ds_read_tr16_b64_v4i16((PG8_LAS s16x4*)(Vs3 + tr_off + 32 * dt));
                const s16x4 a1 = __builtin_amdgcn_ds_read_tr16_b64_v4i16((PG8_LAS s16x4*)(Vs3 + tr_off + 4 * 144 + 32 * dt));
                const bf16x8 vf = __builtin_shufflevector(a0, a1, 0, 1, 2, 3, 4, 5, 6, 7);
#pragma unroll
                for (int qt = 0; qt < 4; ++qt) Oacc[dt][qt] = __builtin_amdgcn_mfma_f32_16x16x32_bf16(vf, Pf[qt], Oacc[dt][qt], 0, 0, 0); }
            { const bf16x8 ones = (bf16x8){0x3F80, 0x3F80, 0x3F80, 0x3F80, 0x3F80, 0x3F80, 0x3F80, 0x3F80};
#pragma unroll
              for (int qt = 0; qt < 4; ++qt) Lacc[qt] = __builtin_amdgcn_mfma_f32_16x16x32_bf16(ones, Pf[qt], Lacc[qt], 0, 0, 0); }
            asm volatile("" :: "v"(tch0), "v"(tch1) : "memory");
        }
        if (do_store)
#pragma unroll
        for (int qt = 0; qt < 4; ++qt) { const int i = 64 * nb + 16 * qt + c16, tok = (i << dsh) + r;
            const float lt = Lacc[qt][0];
            u16* orow = QKV + (size_t)(b * SEQ + tok) * NQKV + colq + 4 * q;
#pragma unroll
            for (int dt = 0; dt < 4; ++dt) { uint2 w; w.x = pk2(Oacc[dt][qt][0], Oacc[dt][qt][1]); w.y = pk2(Oacc[dt][qt][2], Oacc[dt][qt][3]); *(uint2*)(orow + 16 * dt) = w; }
            if (q == 0) LG[((size_t)g * MTOK + b * SEQ + tok) * 8 + h] = lt; }
    }
    __syncthreads();
}
__device__ void attn_combine(const Frame& F) {
    const u16* QKV = (const u16*)(F.ws + WS_QKV); const float* LG = (const float*)(F.dob + DO_LG); u16* ATG = (u16*)(F.ws + WS_ATG);
    for (int idx = blockIdx.x * 512 + F.tid; idx < MTOK * 64; idx += gridDim.x * 512) {
        const int m = idx >> 6, cc = (idx & 63) * 8, h = cc >> 6;
        const float lt = LG[(size_t)m * 8 + h] + LG[((size_t)MTOK + m) * 8 + h] + LG[((size_t)2 * MTOK + m) * 8 + h];
        const u16* qrow = QKV + (size_t)m * NQKV + cc;
        float o0[8], o1[8], o2[8], gt[8]; up8(*(const uint4*)qrow, o0); up8(*(const uint4*)(qrow + 512), o1); up8(*(const uint4*)(qrow + 1024), o2);
        uint4* gp = (uint4*)(ATG + (size_t)m * ATW + cc); up8(*gp, gt);
        const float il = 1.0f / lt;
#pragma unroll
        for (int e = 0; e < 8; ++e) o0[e] = (o0[e] + o1[e] + o2[e]) * il * gt[e];
        *gp = pk8(o0);
    }
}

__device__ void p2b_transpose(const Frame& F, unsigned char* lds) {
    const int tid = F.tid; u16* tl = (u16*)lds;
    const u16* HYT = (const u16*)(F.ws + WS_HYT); const u16* HYG = (const u16*)(F.ws + WS_HYG); u16* YH = (u16*)(F.ws + WS_YH);
    for (int tile = blockIdx.x; tile < 12 * 512; tile += gridDim.x) {
        const int c0 = (tile % 12) * 64, m0 = (tile / 12) * 64;
        const int cl = tid >> 3, mc = (tid & 7) * 8;
        const u32x4 wq = __builtin_nontemporal_load((const u32x4*)(HYT + (size_t)(c0 + cl) * MTOK + m0 + mc)); const uint4 w = (uint4){wq.x, wq.y, wq.z, wq.w};
        tl[(mc + 0) * 72 + cl] = (u16)(w.x & 0xffff); tl[(mc + 1) * 72 + cl] = (u16)(w.x >> 16); tl[(mc + 2) * 72 + cl] = (u16)(w.y & 0xffff); tl[(mc + 3) * 72 + cl] = (u16)(w.y >> 16);
        tl[(mc + 4) * 72 + cl] = (u16)(w.z & 0xffff); tl[(mc + 5) * 72 + cl] = (u16)(w.z >> 16); tl[(mc + 6) * 72 + cl] = (u16)(w.w & 0xffff); tl[(mc + 7) * 72 + cl] = (u16)(w.w >> 16);
        __syncthreads();
        const int ml = tid >> 3, cc = (tid & 7) * 8;
        const uint4 y = *(const uint4*)&tl[ml * 72 + cc]; const uint4 g = *(const uint4*)(HYG + (size_t)(m0 + ml) * HYW + c0 + cc);
        uint4 r; r.x = pk2(bflo(y.x) * bflo(g.x), bfhi(y.x) * bfhi(g.x)); r.y = pk2(bflo(y.y) * bflo(g.y), bfhi(y.y) * bfhi(g.y));
        r.z = pk2(bflo(y.z) * bflo(g.z), bfhi(y.z) * bfhi(g.z)); r.w = pk2(bflo(y.w) * bflo(g.w), bfhi(y.w) * bfhi(g.w));
        __builtin_nontemporal_store((u32x4){r.x, r.y, r.z, r.w}, (u32x4*)(YH + (size_t)(m0 + ml) * HYW + c0 + cc));
        __syncthreads();
    }
    transpose_weight(F.w_out, DM, DM, (u16*)(F.ws + WS_WOUT), tl, tid);
}


__device__ unsigned g_bar[8 * 64 + 64 + 8 * 64];
__device__ __forceinline__ unsigned gb_ld(unsigned* p) { return __hip_atomic_load(p, __ATOMIC_RELAXED, __HIP_MEMORY_SCOPE_AGENT); }
__device__ __forceinline__ unsigned gb_add(unsigned* p) { return __hip_atomic_fetch_add(p, 1u, __ATOMIC_RELAXED, __HIP_MEMORY_SCOPE_AGENT); }
__device__ __forceinline__ void grid_bar() {
    asm volatile("s_waitcnt vmcnt(0) lgkmcnt(0)" ::: "memory");
    __syncthreads();
    if (threadIdx.x == 0) {
        __builtin_amdgcn_fence(__ATOMIC_RELEASE, "agent");
        asm volatile("s_waitcnt vmcnt(0)" ::: "memory");
        const unsigned G = gridDim.x, ng = (G % 8u == 0u) ? 8u : 1u, n = G / ng, g = blockIdx.x % ng;
        const unsigned old = gb_add(&g_bar[g * 64]), gen = old / n;
        if (old % n == n - 1u) {
            const unsigned t = gb_add(&g_bar[512]), want = (t / ng + 1u) * ng;
            while ((int)(gb_ld(&g_bar[512]) - want) < 0) __builtin_amdgcn_s_sleep(10);
            gb_add(&g_bar[576 + g * 64]);
        } else {
            while ((int)(gb_ld(&g_bar[576 + g * 64]) - (gen + 1u)) < 0) __builtin_amdgcn_s_sleep(40);
        }
        __builtin_amdgcn_fence(__ATOMIC_ACQUIRE, "agent");
        asm volatile("s_waitcnt vmcnt(0)" ::: "memory");
    }
    __syncthreads();
}

__global__ void __launch_bounds__(512) mk_fwd(Args args) {
    extern __shared__ __attribute__((aligned(16))) unsigned char lds[];
    cg::grid_group grid = cg::this_grid();
    Frame F;
    F.x = args.in[0]; F.norm_g = args.in[1]; F.w_in = args.in[2]; F.b_in = args.in[3]; F.conv_w = args.in[4]; F.conv_b = args.in[5];
    F.w1 = args.in[6]; F.b1 = args.in[7]; F.w2 = args.in[8]; F.b2 = args.in[9]; F.w3 = args.in[10]; F.b3 = args.in[11]; F.w4 = args.in[12]; F.freq = args.in[13];
    F.skip = args.in[14]; F.qg = args.in[15]; F.kg = args.in[16]; F.w_hy = args.in[17]; F.w_at = args.in[18]; F.w_out = args.in[19];
    F.out = args.out; F.ws = args.ws; F.dob = (unsigned char*)args.out;
    F.tid = threadIdx.x; F.lane = F.tid & 63; F.wid = __builtin_amdgcn_readfirstlane(F.tid >> 6);
    const int lo = args.ph_lo, hi = args.ph_hi;
    PG8_LAS unsigned char* ldsa = (PG8_LAS unsigned char*)lds;
    const int G = gridDim.x, c = blockIdx.x;
#ifdef ONLY
#define IN(k) ((k) == ONLY && lo <= (k) && (k) < hi)
#elif defined(SKIP)
#define IN(k) ((k) != SKIP && lo <= (k) && (k) < hi)
#else
#define IN(k) (lo <= (k) && (k) < hi)
#endif
#define SEAM(k) do { if (IN(k) && IN((k) + 1)) { if (hi > 100) grid.sync(); else grid_bar(); } } while (0)
#ifdef REPEAT
#define NREP(k) ((k) == REPEAT ? 2 : 1)
#else
#define NREP(k) 1
#endif
    if (IN(0)) for (int rep = 0; rep < NREP(0); ++rep) p0_prologue(F, lds);
    SEAM(0);
    if (IN(1)) for (int rep = 0; rep < NREP(1); ++rep) {
        pg8::Gemm g{(const u16*)(F.dob + DO_XN), (const u16*)(F.dob + DO_WIN), MTOK, 8192, DM}; pg8::StaticOrder S; S.init(MTOK, 8192, G, c);
        Epi1 E{(u16*)(F.ws + WS_HYT), (u16*)(F.ws + WS_QKV), (u16*)(F.ws + WS_HYG), (u16*)(F.ws + WS_ATG), F.b_in, ldsa + 131072};
        pg8::gemm_phase<Epi1, pg8::StaticOrder>(ldsa, g, S, E, nullptr);
    }
    SEAM(1);
    if (IN(2)) {
#if defined(REPEAT) && REPEAT == 2
        hyena_mfma(F, lds, hi > 100);
#endif
        hyena_mfma(F, lds);
#if defined(REPEAT) && REPEAT == 6
        attn_mfma(F, lds, hi > 100);
#endif
        attn_mfma(F, lds);
#if defined(REPEAT) && REPEAT == 7
        for (int k = 0; k < 5; ++k) grid.sync();
#endif
    }
    SEAM(2);
    if (IN(3)) { for (int rep = 0; rep < NREP(3); ++rep) p2b_transpose(F, lds); attn_combine(F); }
    SEAM(3);
    if (IN(4)) for (int rep = 0; rep < NREP(4); ++rep) {
        pg8::StaticOrder S; S.init(MTOK, DM, G, c);
        { pg8::Gemm g{(const u16*)(F.dob + DO_XN), (const u16*)(F.dob + DO_WIN) + (size_t)8192 * DM, MTOK, DM, DM}; EpiSig E{(u16*)(F.ws + WS_SG), F.b_in + 8192};
          pg8::gemm_phase<EpiSig, pg8::StaticOrder>(ldsa, g, S, E, nullptr); }
        { pg8::Gemm g{(const u16*)(F.ws + WS_YH), (const u16*)(F.dob + DO_WHY), MTOK, DM, HYW}; EpiGate<0> E{(const u16*)(F.ws + WS_SG), (u16*)(F.ws + WS_TMP), nullptr};
          pg8::gemm_phase<EpiGate<0>, pg8::StaticOrder>(ldsa, g, S, E, nullptr); }
        { pg8::Gemm g{(const u16*)(F.dob + DO_XN), (const u16*)(F.dob + DO_WIN) + (size_t)9216 * DM, MTOK, DM, DM}; EpiSig E{(u16*)(F.ws + WS_SG), F.b_in + 9216};
          pg8::gemm_phase<EpiSig, pg8::StaticOrder>(ldsa, g, S, E, nullptr); }
        { pg8::Gemm g{(const u16*)(F.ws + WS_ATG), (const u16*)(F.dob + DO_WAT), MTOK, DM, ATW}; EpiGate<1> E{(const u16*)(F.ws + WS_SG), (u16*)(F.ws + WS_TMP), (u16*)(F.ws + WS_MRG)};
          pg8::gemm_phase<EpiGate<1>, pg8::StaticOrder>(ldsa, g, S, E, nullptr); }
    }
    SEAM(4);
    if (IN(5)) for (int rep = 0; rep < NREP(5); ++rep) {
        pg8::Gemm g{(const u16*)(F.ws + WS_MRG), (const u16*)(F.ws + WS_WOUT), MTOK, DM, DM}; pg8::StaticOrder S; S.init(MTOK, DM, G, c);
        EpiOut E{F.x, F.out};
        pg8::gemm_phase<EpiOut, pg8::StaticOrder>(ldsa, g, S, E, nullptr);
    }
#undef IN
#undef SEAM
}

extern "C" void kernel_launch(void* const* d_in, const int* in_sizes, int n_in, void* d_out, int out_size, void* d_ws, size_t ws_size, hipStream_t stream) {
    static int grid = 0;
    if (grid == 0) {
        if (n_in != 20 || out_size != MTOK * DM || ws_size < WS_END) { fprintf(stderr, "kernel_launch: unexpected shapes (n_in %d out %d ws %zu)\n", n_in, out_size, ws_size); grid = -1; return; }
        int dev = 0, cus = 0, per_cu = 0;
        hipGetDevice(&dev); hipDeviceGetAttribute(&cus, hipDeviceAttributeMultiprocessorCount, dev);
        if (hipFuncSetAttribute((const void*)mk_fwd, hipFuncAttributeMaxDynamicSharedMemorySize, LDS_BYTES) != hipSuccess) { fprintf(stderr, "kernel_launch: hipFuncSetAttribute failed\n"); grid = -1; return; }
        if (hipOccupancyMaxActiveBlocksPerMultiprocessor(&per_cu, (const void*)mk_fwd, 512, LDS_BYTES) != hipSuccess || per_cu < 1) { fprintf(stderr, "kernel_launch: occupancy query failed (%d)\n", per_cu); per_cu = 1; }
        (void)hipGetLastError();
        grid = cus;
        if (grid != 256) fprintf(stderr, "kernel_launch: note: %d CUs\n", grid);
    }
    if (grid < 0) return;
    Args a{};
    for (int i = 0; i < 20; ++i) a.in[i] = (const float*)d_in[i];
    a.out = (float*)d_out; a.ws = (unsigned char*)d_ws;
#if ONE_LAUNCH
    a.ph_lo = 0; a.ph_hi = 6;
    void* kargs[] = {&a};
    hipError_t e = hipLaunchCooperativeKernel((const void*)mk_fwd, dim3(grid), dim3(512), kargs, LDS_BYTES, stream);
    if (e != hipSuccess) fprintf(stderr, "cooperative launch failed: %s (grid %d)\n", hipGetErrorString(e), grid);
#else
    for (int ph = 0; ph < 6; ++ph) { a.ph_lo = ph; a.ph_hi = ph + 1; hipLaunchKernelGGL(mk_fwd, dim3(grid), dim3(512), LDS_BYTES, stream, a); }
#endif
}
```

```cpp
#include <hip/hip_runtime.h>
#include <hip/hip_cooperative_groups.h>
#include <cstdio>
namespace cg = cooperative_groups;
namespace pg8 {
#define PG8_LAS __attribute__((address_space(3)))
typedef unsigned short bf16_t;
typedef short bf16x8 __attribute__((ext_vector_type(8)));
typedef float f32x4 __attribute__((ext_vector_type(4)));
typedef unsigned u32x4 __attribute__((ext_vector_type(4)));
constexpr int BM = 256, BK = 64, HALF = 128, HTB = HALF * BK * 2  , STAGE_BYTES = 8 * HTB, NXCD = 8, WGM = 8;

__host__ __device__ __forceinline__ int lds_byte(int r, int c) { const int st = (r >> 4) * 2 + (c >> 5), rr = r & 15, cc = c & 31, ob = rr * 64 + cc * 2; return st * 1024 + (ob ^ (((ob >> 9) & 1) << 5)); }
__host__ __device__ __forceinline__ void stage_rc(int b, int& R, int& C) { const int st = b / 1024, sb = b % 1024, swz = sb ^ (((sb >> 9) & 1) << 5); R = (st >> 1) * 16 + swz / 64; C = (st & 1) * 32 + (swz % 64) / 2; }
__host__ __device__ __forceinline__ int perm32(int rho) { const int n = rho >> 4, i = rho & 15; return 8 * (i >> 2) + 4 * n + (i & 3); }

struct Unit { int pm, pn; };
struct Gemm { const bf16_t* A; const bf16_t* Bt; int M, N, K; };

struct StaticOrder {
    int nM, nN, nwg, G, c;
    __host__ __device__ void init(int M, int N, int G_, int c_) { nM = M / BM; nN = N / BM; nwg = nM * nN; G = G_; c = c_; }
    __host__ __device__ bool next(int i, Unit& u) const {
        const long L = (long)i * G + c; if (L >= nwg) return false;
        int wgid = (int)L; { const int q = nwg / NXCD, r = nwg % NXCD, xcd = wgid % NXCD, off = wgid / NXCD; wgid = (xcd < r ? xcd * (q + 1) : r * (q + 1) + (xcd - r) * q) + off; }
        const int nig = WGM * nN, gid = wgid / nig, fm = gid * WGM, gsz = (nM - fm) < WGM ? (nM - fm) : WGM;
        u.pm = fm + ((wgid % nig) % gsz); u.pn = (wgid % nig) / gsz; return true;
    }
    __device__ __forceinline__ void a_ready(const Unit&) const {}
    __device__ __forceinline__ void done(const Unit&) const {}
};
__device__ __forceinline__ unsigned cvt_pk_bf16(float lo, float hi) { unsigned r; asm volatile("v_cvt_pk_bf16_f32 %0, %1, %2" : "=v"(r) : "v"(lo), "v"(hi)); return r; }
typedef float f32x2 __attribute__((ext_vector_type(2)));
template <class Epi, class Sched, bool STAMP = false>
__device__ __forceinline__ void gemm_phase(PG8_LAS unsigned char* lds, const Gemm g, const Sched& S, const Epi& E, unsigned long long* stamps) {
    int tid_ = threadIdx.x; asm volatile("" : "+v"(tid_));
    const int tid = tid_, wid = __builtin_amdgcn_readfirstlane(tid >> 6), lane = tid & 63, wr = wid >> 2, wc = wid & 3, fr = lane & 15, fq = lane >> 4;
    const int K = g.K, nt = K / BK;
    int ts_lo = 0, ts_hi = 0, nts = 0; const unsigned long long rt_entry = STAMP ? (unsigned long long)wall_clock64() : 0ull;
#define PG8_STAMP() do { if (STAMP && wid == 0 && nts < 64) { const unsigned long long _c = (unsigned long long)clock64(); \
        ts_lo = (lane == nts) ? (int)(unsigned)_c : ts_lo; ts_hi = (lane == nts) ? (int)(unsigned)(_c >> 32) : ts_hi; ++nts; } } while (0)
    PG8_STAMP();
    unsigned voffA[2], voffB[2];
#pragma unroll
    for (int i = 0; i < 2; ++i) { int R, C; stage_rc(tid * 16 + i * 8192, R, C); const int Rb = Epi::PERM ? ((R & ~31) + perm32(R & 31)) : R;
        voffA[i] = (unsigned)(R * K + C) * 2u; voffB[i] = (unsigned)(Rb * K + C) * 2u; }
    const size_t kstep = (size_t)(BK * 2);
    const size_t hstep = (size_t)HALF * K * 2;
    const size_t tstep = 2 * hstep;
    const unsigned ldsw = (unsigned)wid * 1024u;
    const int aoff = lds_byte(wr * 64 + fr, fq * 8), boff = lds_byte(wc * 32 + fr, fq * 8);
#define PG8_SA(b, h) (((b) * 2 + (h)) * HTB)
#define PG8_SB(b, h) ((4 + (b) * 2 + (h)) * HTB)
#define PG8_STAGE(bufoff, gbase, voff) do { _Pragma("unroll") for (int _i = 0; _i < 2; ++_i) \
        __builtin_amdgcn_global_load_lds((const unsigned*)((const char*)(gbase) + (voff)[_i]), (PG8_LAS unsigned*)(lds + (bufoff) + ldsw + _i * 8192), 16, 0, 0); } while (0)
#define PG8_LDA(dst, b, h) do { _Pragma("unroll") for (int m = 0; m < 4; ++m) _Pragma("unroll") for (int k = 0; k < 2; ++k) dst[m][k] = *(const PG8_LAS bf16x8*)(lds + PG8_SA(b, h) + aoff + m * 2048 + k * 1024); } while (0)
#define PG8_LDB(dst, b, h) do { _Pragma("unroll") for (int n = 0; n < 2; ++n) _Pragma("unroll") for (int k = 0; k < 2; ++k) dst[n][k] = *(const PG8_LAS bf16x8*)(lds + PG8_SB(b, h) + boff + n * 2048 + k * 1024); } while (0)
#define PG8_MMA(ai, bj, At, Bt) do { __builtin_amdgcn_s_setprio(1); _Pragma("unroll") for (int m = 0; m < 4; ++m) _Pragma("unroll") for (int n = 0; n < 2; ++n) _Pragma("unroll") for (int k = 0; k < 2; ++k) \
        acc[ai][bj][m][n] = __builtin_amdgcn_mfma_f32_16x16x32_bf16(Bt[n][k], At[m][k], acc[ai][bj][m][n], 0, 0, 0); __builtin_amdgcn_s_setprio(0); } while (0)
#define PG8_WAIT_V(n) asm volatile("s_waitcnt vmcnt(" #n ")" ::: "memory")
#define PG8_WAIT_L(n) asm volatile("s_waitcnt lgkmcnt(" #n ")" ::: "memory")
#define PG8_BAR __builtin_amdgcn_s_barrier()
#define PG8_SCHED __builtin_amdgcn_sched_barrier(0)
    Unit cur, nxt; int ui = 0;
    if (!S.next(0, cur)) return;
    f32x4 acc[2][2][4][2];
#pragma unroll
    for (int a = 0; a < 2; ++a)
#pragma unroll
        for (int b = 0; b < 2; ++b)
#pragma unroll
            for (int m = 0; m < 4; ++m)
#pragma unroll
                for (int n = 0; n < 2; ++n) acc[a][b][m][n] = (f32x4){0.f, 0.f, 0.f, 0.f};
    bf16x8 At[4][2], B0[2][2], B1[2][2];
    const char* cA = (const char*)g.A + (size_t)cur.pm * tstep; const char* cB = (const char*)g.Bt + (size_t)cur.pn * tstep;
    S.a_ready(cur);
    PG8_STAGE(PG8_SB(0, 0), cB, voffB); PG8_STAGE(PG8_SA(0, 0), cA, voffA); PG8_STAGE(PG8_SB(0, 1), cB + hstep, voffB); PG8_STAGE(PG8_SA(0, 1), cA + hstep, voffA);
    if (wr == 1) PG8_BAR;
    PG8_WAIT_V(4); PG8_BAR;
    PG8_STAGE(PG8_SB(1, 0), cB + kstep, voffB); PG8_STAGE(PG8_SA(1, 0), cA + kstep, voffA); PG8_STAGE(PG8_SB(1, 1), cB + hstep + kstep, voffB);
    PG8_WAIT_V(6); PG8_BAR;
    PG8_STAMP();
    for (;;) {
        const bool has_next = S.next(ui + 1, nxt);
        const char* nA = has_next ? (const char*)g.A + (size_t)nxt.pm * tstep : cA; const char* nB = has_next ? (const char*)g.Bt + (size_t)nxt.pn * tstep : cB;
        for (int t = 0; t < nt; t += 2) {
            const bool last = (t == nt - 2);
            const char* a1 = cA + (size_t)(t + 1) * kstep;
            const char* a2 = last ? nA : cA + (size_t)(t + 2) * kstep; const char* b2 = last ? nB : cB + (size_t)(t + 2) * kstep;
            const char* a3 = a2 + kstep; const char* b3 = b2 + kstep;
            if (last && has_next) S.a_ready(nxt);
            PG8_LDB(B0, 0, 0); PG8_SCHED; PG8_LDA(At, 0, 0); PG8_STAGE(PG8_SA(1, 1), a1 + hstep, voffA);
            PG8_WAIT_L(8); PG8_BAR; PG8_WAIT_L(0); PG8_MMA(0, 0, At, B0); PG8_BAR; PG8_SCHED;
            PG8_LDB(B1, 0, 1); PG8_STAGE(PG8_SB(0, 0), b2, voffB);
            PG8_BAR; PG8_WAIT_L(0); PG8_MMA(0, 1, At, B1); PG8_BAR;
            PG8_LDA(At, 0, 1); PG8_STAGE(PG8_SA(0, 0), a2, voffA);
            PG8_BAR; PG8_WAIT_L(0); PG8_MMA(1, 0, At, B0); PG8_BAR; PG8_SCHED;
            PG8_STAGE(PG8_SB(0, 1), b2 + hstep, voffB);
            PG8_WAIT_V(6); PG8_BAR; PG8_MMA(1, 1, At, B1); PG8_BAR;
            PG8_LDB(B0, 1, 0); PG8_SCHED; PG8_LDA(At, 1, 0); PG8_STAGE(PG8_SA(0, 1), a2 + hstep, voffA);
            PG8_WAIT_L(8); PG8_BAR; PG8_WAIT_L(0); PG8_MMA(0, 0, At, B0); PG8_BAR; PG8_SCHED;
            PG8_LDB(B1, 1, 1); PG8_STAGE(PG8_SB(1, 0), b3, voffB);
            PG8_BAR; PG8_WAIT_L(0); PG8_MMA(0, 1, At, B1); PG8_BAR;
            PG8_LDA(At, 1, 1); PG8_STAGE(PG8_SA(1, 0), a3, voffA);
            PG8_BAR; PG8_WAIT_L(0); PG8_MMA(1, 0, At, B0); PG8_BAR; PG8_SCHED;
            PG8_STAGE(PG8_SB(1, 1), b3 + hstep, voffB);
            PG8_WAIT_V(6); PG8_BAR; PG8_MMA(1, 1, At, B1); PG8_BAR;
        }
        PG8_STAMP();
        if constexpr (!Epi::AFTER_DRAIN) { E(acc, cur, wr, wc, fr, fq); S.done(cur); }
        PG8_STAMP();
        if (!has_next) break;
#pragma unroll
        for (int a = 0; a < 2; ++a)
#pragma unroll
            for (int b = 0; b < 2; ++b)
#pragma unroll
                for (int m = 0; m < 4; ++m)
#pragma unroll
                    for (int n = 0; n < 2; ++n) acc[a][b][m][n] = (f32x4){0.f, 0.f, 0.f, 0.f};
        cur = nxt; cA = nA; cB = nB; ++ui;
    }
    PG8_WAIT_V(0);
    if (wr == 0) PG8_BAR;
    PG8_BAR;
    if constexpr (Epi::AFTER_DRAIN) { E.fused(acc, cur, wr, wc, fr, fq, lds, wid, lane); S.done(cur); }
    PG8_STAMP();
    if (STAMP && wid == 0) { stamps[lane] = lane < nts ? (((unsigned long long)(unsigned)ts_hi << 32) | (unsigned)ts_lo) : 0ull;
        if (lane == 62) stamps[62] = rt_entry; if (lane == 63) stamps[63] = (unsigned long long)wall_clock64(); }
#undef PG8_STAMP
#undef PG8_SA
#undef PG8_SB
#undef PG8_STAGE
#undef PG8_LDA
#undef PG8_LDB
#undef PG8_MMA
#undef PG8_WAIT_V
#undef PG8_WAIT_L
#undef PG8_BAR
#undef PG8_SCHED
}
}

#ifndef ONE_LAUNCH
#define ONE_LAUNCH 1
#endif
typedef unsigned short u16;
typedef pg8::f32x4 f32x4;
typedef pg8::u32x4 u32x4;
constexpr int MTOK = 32768, DM = 1024, SEQ = 2048, NB = 16, HYW = 768, NHY = 2304, NQKV = 4608, ATW = 512;
constexpr size_t MiB = 1024 * 1024;
constexpr size_t WS_HYT = 0;
constexpr size_t WS_QKV = 144 * MiB;
constexpr size_t WS_HYG = 432 * MiB;
constexpr size_t WS_ATG = 480 * MiB;
constexpr size_t WS_END = 512 * MiB;
constexpr size_t WS_YH = WS_HYT + 48 * MiB, WS_WOUT = WS_HYT + 96 * MiB;
constexpr size_t WS_SG = WS_QKV, WS_TMP = WS_QKV + 64 * MiB, WS_MRG = WS_QKV + 192 * MiB;
constexpr size_t DO_XN = 0, DO_WIN = 64 * MiB, DO_WHY = 84 * MiB, DO_WAT = DO_WHY + 1536 * 1024, DO_HF = 87 * MiB;
constexpr int LDS_BYTES = 144 * 1024;
constexpr int KBL = 4104;
constexpr int KRP = 4112;
constexpr int UP = 2056;

struct Args { const float* in[20]; float* out; unsigned char* ws; int ph_lo, ph_hi; };
struct Frame {
    const float *x, *norm_g, *w_in, *b_in, *conv_w, *conv_b, *w1, *b1, *w2, *b2, *w3, *b3, *w4, *freq, *skip, *qg, *kg, *w_hy, *w_at, *w_out;
    float* out; unsigned char* ws; unsigned char* dob;
    int tid, lane, wid;
};

__device__ __forceinline__ u16 f2bf(float f) { unsigned u = __float_as_uint(f); u += 0x7FFFu + ((u >> 16) & 1u); return (u16)(u >> 16); }
__device__ __forceinline__ float bf2f(u16 b) { return __uint_as_float(((unsigned)b) << 16); }
__device__ __forceinline__ float bflo(unsigned w) { return __uint_as_float(w << 16); }
__device__ __forceinline__ float bfhi(unsigned w) { return __uint_as_float(w & 0xffff0000u); }
typedef float f32x2v __attribute__((ext_vector_type(2)));
typedef __bf16 bf16x2v __attribute__((ext_vector_type(2)));
__device__ __forceinline__ unsigned pk2(float lo, float hi) { const f32x2v v = {lo, hi}; return __builtin_bit_cast(unsigned, __builtin_convertvector(v, bf16x2v)); }
__device__ __forceinline__ float sigmoidf_(float v) { return __builtin_amdgcn_rcpf(1.0f + __builtin_amdgcn_exp2f(-1.4426950408889634f * v)); }
__device__ __forceinline__ float siluf_(float v) { return v * __builtin_amdgcn_rcpf(1.0f + __builtin_amdgcn_exp2f(-1.4426950408889634f * v)); }

typedef unsigned u32x4u __attribute__((ext_vector_type(4), aligned(2)));
__device__ __forceinline__ void transpose_tile_f32(const float* src, int K, int N, u16* dst, int k0, int n0, u16* tile, int tid) {
    const int kl = tid >> 3, nc = (tid & 7) * 8;
    const float4* p = (const float4*)(src + (size_t)(k0 + kl) * N + n0 + nc);
    const float4* p2 = (const float4*)(src + (size_t)(k0 + 64 + kl) * N + n0 + nc);
    const float4 a = p[0], b = p[1], c = p2[0], d = p2[1];
    tile[(nc + 0) * 136 + kl] = f2bf(a.x); tile[(nc + 1) * 136 + kl] = f2bf(a.y); tile[(nc + 2) * 136 + kl] = f2bf(a.z); tile[(nc + 3) * 136 + kl] = f2bf(a.w);
    tile[(nc + 4) * 136 + kl] = f2bf(b.x); tile[(nc + 5) * 136 + kl] = f2bf(b.y); tile[(nc + 6) * 136 + kl] = f2bf(b.z); tile[(nc + 7) * 136 + kl] = f2bf(b.w);
    tile[(nc + 0) * 136 + 64 + kl] = f2bf(c.x); tile[(nc + 1) * 136 + 64 + kl] = f2bf(c.y); tile[(nc + 2) * 136 + 64 + kl] = f2bf(c.z); tile[(nc + 3) * 136 + 64 + kl] = f2bf(c.w);
    tile[(nc + 4) * 136 + 64 + kl] = f2bf(d.x); tile[(nc + 5) * 136 + 64 + kl] = f2bf(d.y); tile[(nc + 6) * 136 + 64 + kl] = f2bf(d.z); tile[(nc + 7) * 136 + 64 + kl] = f2bf(d.w);
    __syncthreads();
    const int nl = tid >> 3, kc = (tid & 7) * 16;
    const uint4 w0 = *(const uint4*)&tile[nl * 136 + kc], w1 = *(const uint4*)&tile[nl * 136 + kc + 8];
    uint4* dp = (uint4*)(dst + (size_t)(n0 + nl) * K + k0 + kc); dp[0] = w0; dp[1] = w1;
    __syncthreads();
}
__device__ void transpose_weight(const float* src, int K, int N, u16* dst, u16* tile, int tid) {
    const int nkt = K / 128, nnt = N / 64;
    for (int t = blockIdx.x; t < nkt * nnt; t += gridDim.x) transpose_tile_f32(src, K, N, dst, (t % nkt) * 128, (t / nkt) * 64, tile, tid);
}

__device__ __forceinline__ void bar4(PG8_LAS unsigned* cnt, unsigned& target, int lane) {
    asm volatile("s_waitcnt lgkmcnt(0)" ::: "memory");
    target += 4u;
    if (lane == 0) {
        __hip_atomic_fetch_add(cnt, 1u, __ATOMIC_RELAXED, __HIP_MEMORY_SCOPE_WORKGROUP);
        while (__hip_atomic_load(cnt, __ATOMIC_RELAXED, __HIP_MEMORY_SCOPE_WORKGROUP) < target) __builtin_amdgcn_s_sleep(1);
    }
    asm volatile("" ::: "memory");
}
__device__ void p0_prologue(const Frame& F, unsigned char* lds) {
    const int tid = F.tid, lane = F.lane, wid = F.wid;
    u16* tile = (u16*)lds;
    transpose_weight(F.w_in, DM, 10240, (u16*)(F.dob + DO_WIN), tile, tid);
    transpose_weight(F.w_hy, HYW, DM, (u16*)(F.dob + DO_WHY), tile, tid);
    transpose_weight(F.w_at, ATW, DM, (u16*)(F.dob + DO_WAT), tile, tid);
    PG8_LAS unsigned* cnt = (PG8_LAS unsigned*)((PG8_LAS unsigned char*)lds + 65536);
    __syncthreads();
    if (tid == 0) *(volatile PG8_LAS unsigned*)cnt = 0u;
    __syncthreads();
    if (wid >= 4) {
        u16* XN = (u16*)(F.dob + DO_XN);
        for (int row = (blockIdx.x * 4 + (wid - 4)) * 2; row < MTOK; row += gridDim.x * 8) {
            const float4* xr = (const float4*)(F.x + (size_t)row * DM);
            float4 v[8]; float s0 = 0.f, s1 = 0.f;
#pragma unroll
            for (int i = 0; i < 8; ++i) { const f32x4 t = __builtin_nontemporal_load((const f32x4*)xr + lane + 64 * i); v[i] = make_float4(t.x, t.y, t.z, t.w); }
#pragma unroll
            for (int i = 0; i < 4; ++i) { s0 += v[i].x * v[i].x + v[i].y * v[i].y + v[i].z * v[i].z + v[i].w * v[i].w;
                s1 += v[i + 4].x * v[i + 4].x + v[i + 4].y * v[i + 4].y + v[i + 4].z * v[i + 4].z + v[i + 4].w * v[i + 4].w; }
#pragma unroll
            for (int o = 32; o >= 1; o >>= 1) { s0 += __shfl_xor(s0, o); s1 += __shfl_xor(s1, o); }
            const float r0 = rsqrtf(s0 * (1.0f / DM) + 1e-6f), r1 = rsqrtf(s1 * (1.0f / DM) + 1e-6f);
#pragma unroll
            for (int i = 0; i < 4; ++i) { const float4 g = ((const float4*)F.norm_g)[lane + 64 * i];
                uint2 w; w.x = pk2(v[i].x * r0 * g.x, v[i].y * r0 * g.y); w.y = pk2(v[i].z * r0 * g.z, v[i].w * r0 * g.w);
                *(uint2*)(XN + (size_t)row * DM + 4 * (lane + 64 * i)) = w;
                uint2 w2; w2.x = pk2(v[i + 4].x * r1 * g.x, v[i + 4].y * r1 * g.y); w2.y = pk2(v[i + 4].z * r1 * g.z, v[i + 4].w * r1 * g.w);
                *(uint2*)(XN + (size_t)(row + 1) * DM + 4 * (lane + 64 * i)) = w2; }
        }
    } else {
        unsigned target = 0u;
        u16* KB = (u16*)(F.dob + DO_HF);
        float* zs = (float*)lds;
        float* ha = zs + 8 * 40;
        float* hb = ha + 8 * 64;
        float* ws1 = hb + 8 * 64;
        float* ws2 = ws1 + 33 * 64;
        float* ws3 = ws2 + 64 * 64;
        for (int e = tid; e < 33 * 16; e += 256) ((float4*)ws1)[e] = ((const float4*)F.w1)[e];
        for (int e = tid; e < 64 * 16; e += 256) { ((float4*)ws2)[e] = ((const float4*)F.w2)[e]; ((float4*)ws3)[e] = ((const float4*)F.w3)[e]; }
        for (int blk = blockIdx.x; blk < SEQ / 8; blk += gridDim.x) {
            const int t0 = blk * 8;
            bar4(cnt, target, lane);
            for (int e = tid; e < 8 * 33; e += 256) { const int p = e / 33, i = e % 33; const float tt = (float)(t0 + p);
                float val;
                if (i == 0) val = tt * (1.0f / 2047.0f);
                else { const int j = (i - 1) & 15; const float f = 1e-4f + (float)j * ((15.0f - 1e-4f) / 15.0f); const float w = 6.283185307179586f * tt * (1.0f / 2048.0f); const float a = f * w;
                    val = (i <= 16) ? cosf(a) : -sinf(a); }
                zs[p * 40 + i] = val; }
            bar4(cnt, target, lane);
            const int p0 = tid >> 6, j = tid & 63; const float fr = F.freq[j];
#pragma unroll 1
            for (int pp = p0; pp < 8; pp += 4) { float a = F.b1[j];
#pragma unroll 3
                for (int i = 0; i < 33; ++i) a += zs[pp * 40 + i] * ws1[i * 64 + j]; ha[pp * 64 + j] = sinf(fr * a); }
            bar4(cnt, target, lane);
#pragma unroll 1
            for (int pp = p0; pp < 8; pp += 4) { float a = F.b2[j];
#pragma unroll 4
                for (int i = 0; i < 64; ++i) a += ha[pp * 64 + i] * ws2[i * 64 + j]; hb[pp * 64 + j] = sinf(fr * a); }
            bar4(cnt, target, lane);
#pragma unroll 1
            for (int pp = p0; pp < 8; pp += 4) { float a = F.b3[j];
#pragma unroll 4
                for (int i = 0; i < 64; ++i) a += hb[pp * 64 + i] * ws3[i * 64 + j]; ha[pp * 64 + j] = sinf(fr * a); }
            bar4(cnt, target, lane);
#pragma unroll 1
            for (int col = tid; col < 3072; col += 256) {
                float acc[8];
#pragma unroll
                for (int q = 0; q < 8; ++q) acc[q] = 0.f;
                float wv[64];
#pragma unroll
                for (int k = 0; k < 64; ++k) wv[k] = F.w4[k * 3072 + col];
                int hoff = 0; asm volatile("" : "+v"(hoff));
#pragma unroll
                for (int k4 = 0; k4 < 16; ++k4)
#pragma unroll
                    for (int q = 0; q < 8; ++q) { const float4 h = *(const float4*)&ha[hoff + q * 64 + 4 * k4];
                        acc[q] += h.x * wv[4 * k4] + h.y * wv[4 * k4 + 1] + h.z * wv[4 * k4 + 2] + h.w * wv[4 * k4 + 3]; }
                const int o = col / 1536, d = (col % 1536) / 768, c = col % 768;
                const float dmin = 3.0701134573253944f, dmax = 15.350567286626972f;
                const float ad = dmin + (float)c * ((dmax - dmin) / 767.0f);
#pragma unroll
                for (int q = 0; q < 8; ++q) acc[q] *= expf(-((float)(t0 + q) * (1.0f / 2047.0f)) * ad);
                u16* kb = KB + (size_t)(o * HYW + c) * KBL;
                if (d == 0) { u32x4u w; w.x = pk2(acc[7], acc[6]); w.y = pk2(acc[5], acc[4]); w.z = pk2(acc[3], acc[2]); w.w = pk2(acc[1], acc[0]);
                    *(u32x4u*)(kb + 2041 - t0) = w;
                    if (t0 == 0) { kb[0] = 0;
#pragma unroll
                        for (int q = 0; q < 8; ++q) kb[4096 + q] = 0; } }
                else if (t0 > 0) { u32x4u w; w.x = pk2(acc[0], acc[1]); w.y = pk2(acc[2], acc[3]); w.z = pk2(acc[4], acc[5]); w.w = pk2(acc[6], acc[7]); *(u32x4u*)(kb + 2048 + t0) = w; }
                else {
#pragma unroll
                    for (int q = 1; q < 8; ++q) kb[2048 + q] = f2bf(acc[q]); }
            }
        }
    }
    __syncthreads();
}

template <int ACT> __device__ __forceinline__ void store_rm(const f32x4 (&acc)[2][2][4][2], const f32x4 (&bv)[2][2], u16* base, int ldc, int row0, int col0) {
#pragma unroll
    for (int ai = 0; ai < 2; ++ai)
#pragma unroll
        for (int m = 0; m < 4; ++m) { u16* rowp = base + (size_t)(row0 + ai * 128 + m * 16) * ldc + col0;
#pragma unroll
            for (int bj = 0; bj < 2; ++bj) { f32x4 v0 = acc[ai][bj][m][0] + bv[bj][0], v1 = acc[ai][bj][m][1] + bv[bj][1];
                if (ACT) {
#pragma unroll
                    for (int j = 0; j < 4; ++j) { v0[j] = siluf_(v0[j]); v1[j] = siluf_(v1[j]); } }
                u32x4 w; w.x = pk2(v0[0], v0[1]); w.y = pk2(v0[2], v0[3]); w.z = pk2(v1[0], v1[1]); w.w = pk2(v1[2], v1[3]);
                __builtin_nontemporal_store(w, (u32x4*)(rowp + bj * 128)); } }
}
struct Epi1 {
    static constexpr bool PERM = true, AFTER_DRAIN = false;
    u16 *hyt, *qkv, *hyg, *atg; const float* bias; PG8_LAS unsigned char* tr;
    __device__ __forceinline__ void operator()(const f32x4 (&acc)[2][2][4][2], const pg8::Unit& u, int wr, int wc, int fr, int fq) const {
        const int row0 = u.pm * 256 + wr * 64 + fr, colg = u.pn * 256 + wc * 32 + 8 * fq;
        f32x4 bv[2][2];
#pragma unroll
        for (int bj = 0; bj < 2; ++bj)
#pragma unroll
            for (int n = 0; n < 2; ++n) bv[bj][n] = *(const f32x4*)(bias + colg + bj * 128 + 4 * n);
        if (u.pn < 9) {
            const int lane = fr + 16 * fq;
            PG8_LAS unsigned char* T = tr + (wr * 4 + wc) * 2048;
            const int colw = u.pn * 256 + wc * 32, roww = u.pm * 256 + wr * 64;
#pragma unroll
            for (int ai = 0; ai < 2; ++ai)
#pragma unroll
                for (int mp = 0; mp < 2; ++mp)
#pragma unroll
                    for (int bj = 0; bj < 2; ++bj) {
#pragma unroll
                        for (int mm = 0; mm < 2; ++mm)
#pragma unroll
                            for (int n = 0; n < 2; ++n) { const f32x4 v = acc[ai][bj][2 * mp + mm][n] + bv[bj][n];
#pragma unroll
                                for (int j = 0; j < 4; ++j) *(PG8_LAS u16*)(T + (8 * fq + 4 * n + j) * 64 + (16 * mm + fr) * 2) = f2bf(v[j]); }
                        asm volatile("s_waitcnt lgkmcnt(0)" ::: "memory");
                        const u32x4 w0 = *(PG8_LAS const u32x4*)(T + (lane >> 1) * 64 + (lane & 1) * 32), w1 = *(PG8_LAS const u32x4*)(T + (lane >> 1) * 64 + (lane & 1) * 32 + 16);
                        u16* dst = hyt + (size_t)(colw + bj * 128 + (lane >> 1)) * MTOK + roww + ai * 128 + 32 * mp + 16 * (lane & 1);
                        __builtin_nontemporal_store(w0, (u32x4*)dst); __builtin_nontemporal_store(w1, (u32x4*)(dst + 8));
                        asm volatile("" ::: "memory");
                    }
            return;
        }
        if (u.pn < 12) store_rm<1>(acc, bv, hyg, HYW, row0, colg - 2304);
        else if (u.pn < 30) store_rm<0>(acc, bv, qkv, NQKV, row0, colg - 3072);
        else store_rm<1>(acc, bv, atg, ATW, row0, colg - 7680);
    }
};
struct EpiSig {
    static constexpr bool PERM = true, AFTER_DRAIN = false;
    u16* sg; const float* bias;
    __device__ __forceinline__ void operator()(const f32x4 (&acc)[2][2][4][2], const pg8::Unit& u, int wr, int wc, int fr, int fq) const {
        const int row0 = u.pm * 256 + wr * 64 + fr, col0 = u.pn * 256 + wc * 32 + 8 * fq;
        f32x4 bv[2][2];
#pragma unroll
        for (int bj = 0; bj < 2; ++bj)
#pragma unroll
            for (int n = 0; n < 2; ++n) bv[bj][n] = *(const f32x4*)(bias + col0 + bj * 128 + 4 * n);
#pragma unroll
        for (int ai = 0; ai < 2; ++ai)
#pragma unroll
            for (int m = 0; m < 4; ++m) { u16* rowp = sg + (size_t)(row0 + ai * 128 + m * 16) * DM + col0;
#pragma unroll
                for (int bj = 0; bj < 2; ++bj) { f32x4 v0 = acc[ai][bj][m][0] + bv[bj][0], v1 = acc[ai][bj][m][1] + bv[bj][1];
#pragma unroll
                    for (int j = 0; j < 4; ++j) { v0[j] = sigmoidf_(v0[j]); v1[j] = sigmoidf_(v1[j]); }
                    u32x4 w; w.x = pk2(v0[0], v0[1]); w.y = pk2(v0[2], v0[3]); w.z = pk2(v1[0], v1[1]); w.w = pk2(v1[2], v1[3]);
                    *(u32x4*)(rowp + bj * 128) = w; } }
    }
};
template <int MODE  > struct EpiGate {
    static constexpr bool PERM = true, AFTER_DRAIN = false;
    const u16* sg; u16* tmp; u16* mrg;
    __device__ __forceinline__ void operator()(const f32x4 (&acc)[2][2][4][2], const pg8::Unit& u, int wr, int wc, int fr, int fq) const {
        const int row0 = u.pm * 256 + wr * 64 + fr, col0 = u.pn * 256 + wc * 32 + 8 * fq;
#pragma unroll
        for (int ai = 0; ai < 2; ++ai)
#pragma unroll
            for (int m = 0; m < 4; ++m) { const size_t off = (size_t)(row0 + ai * 128 + m * 16) * DM + col0;
#pragma unroll
                for (int bj = 0; bj < 2; ++bj) { const u32x4 s = *(const u32x4*)(sg + off + bj * 128);
                    f32x4 v0 = acc[ai][bj][m][0], v1 = acc[ai][bj][m][1];
                    v0[0] *= bflo(s.x); v0[1] *= bfhi(s.x); v0[2] *= bflo(s.y); v0[3] *= bfhi(s.y); v1[0] *= bflo(s.z); v1[1] *= bfhi(s.z); v1[2] *= bflo(s.w); v1[3] *= bfhi(s.w);
                    if (MODE == 1) { const u32x4 t = *(const u32x4*)(tmp + off + bj * 128);
                        v0[0] += bflo(t.x); v0[1] += bfhi(t.x); v0[2] += bflo(t.y); v0[3] += bfhi(t.y); v1[0] += bflo(t.z); v1[1] += bfhi(t.z); v1[2] += bflo(t.w); v1[3] += bfhi(t.w); }
                    u32x4 w; w.x = pk2(v0[0], v0[1]); w.y = pk2(v0[2], v0[3]); w.z = pk2(v1[0], v1[1]); w.w = pk2(v1[2], v1[3]);
                    *(u32x4*)((MODE == 0 ? tmp : mrg) + off + bj * 128) = w; } }
    }
};
struct EpiOut {
    static constexpr bool PERM = true, AFTER_DRAIN = false;
    const float* x; float* out;
    __device__ __forceinline__ void operator()(const f32x4 (&acc)[2][2][4][2], const pg8::Unit& u, int wr, int wc, int fr, int fq) const {
        const int row0 = u.pm * 256 + wr * 64 + fr, col0 = u.pn * 256 + wc * 32 + 8 * fq;
#pragma unroll
        for (int ai = 0; ai < 2; ++ai) {
            f32x4 xv[4][2][2];
#pragma unroll
            for (int m = 0; m < 4; ++m) { const size_t off = (size_t)(row0 + ai * 128 + m * 16) * DM + col0;
#pragma unroll
                for (int bj = 0; bj < 2; ++bj) { xv[m][bj][0] = *(const f32x4*)(x + off + bj * 128); xv[m][bj][1] = *(const f32x4*)(x + off + bj * 128 + 4); } }
            __builtin_amdgcn_sched_barrier(0);
#pragma unroll
            for (int m = 0; m < 4; ++m) { const size_t off = (size_t)(row0 + ai * 128 + m * 16) * DM + col0;
#pragma unroll
                for (int bj = 0; bj < 2; ++bj) { *(f32x4*)(out + off + bj * 128) = xv[m][bj][0] + acc[ai][bj][m][0]; *(f32x4*)(out + off + bj * 128 + 4) = xv[m][bj][1] + acc[ai][bj][m][1]; } }
            __builtin_amdgcn_sched_barrier(0);
        }
    }
};

typedef pg8::bf16x8 bf16x8;
__device__ __forceinline__ void load_conv(const u16* grow, float w0, float w1, float w2, float cb, u16* dst, int tid) {
#pragma unroll 2
    for (int k = 0; k < 8; ++k) { const int chunk = tid + 512 * k, b = chunk >> 8, t8 = (chunk & 255) * 8; const u16* p = grow + b * SEQ + t8;
        const u32x4 wq = __builtin_nontemporal_load((const u32x4*)p); const uint4 w = (uint4){wq.x, wq.y, wq.z, wq.w}; const float pm = t8 > 0 ? bf2f(p[-1]) : 0.f, pn = t8 + 8 < SEQ ? bf2f(p[8]) : 0.f;
        const float e0 = bflo(w.x), e1 = bfhi(w.x), e2 = bflo(w.y), e3 = bfhi(w.y), e4 = bflo(w.z), e5 = bfhi(w.z), e6 = bflo(w.w), e7 = bfhi(w.w);
        uint4 r; r.x = pk2(cb + w0 * pm + w1 * e0 + w2 * e1, cb + w0 * e0 + w1 * e1 + w2 * e2); r.y = pk2(cb + w0 * e1 + w1 * e2 + w2 * e3, cb + w0 * e2 + w1 * e3 + w2 * e4);
        r.z = pk2(cb + w0 * e3 + w1 * e4 + w2 * e5, cb + w0 * e4 + w1 * e5 + w2 * e6); r.w = pk2(cb + w0 * e5 + w1 * e6 + w2 * e7, cb + w0 * e6 + w1 * e7 + w2 * pn);
        *(uint4*)(dst + b * UP + t8) = r; }
}
__device__ __forceinline__ void build_kr(const u16* kb, u16* KR, int tid) {
#pragma unroll
    for (int k = 0; k < 8; ++k) { const int ch = tid + 512 * k, sg = ch >> 9, x8 = (ch & 511) * 8;
        u32x4u w = (u32x4u){0u, 0u, 0u, 0u};
        if (x8 != 0) w = *(const u32x4u*)(kb + x8 - sg);
        *(uint4*)(KR + sg * KRP + x8) = (uint4){w.x, w.y, w.z, w.w}; }
}
__device__ __forceinline__ void conv_mfma(PG8_LAS const unsigned char* KRb, PG8_LAS const unsigned char* Ub, int wid, int lane, f32x4 (&acc)[16]) {
    const int i = lane & 15, q = lane >> 4, T0 = wid * 16;
    const int abase = (i & 7) * (KRP * 2) + (8 * (q - (i >> 3)) + 2048) * 2;
    const int bbase = i * (UP * 2) + 16 * q;
#pragma unroll
    for (int t = 0; t < 16; ++t) acc[t] = (f32x4){0.f, 0.f, 0.f, 0.f};
#pragma unroll 1
    for (int sr = 0; sr < 4; ++sr) {
        const int S0 = sr * 16;
        bf16x8 Bf[16];
#pragma unroll
        for (int sl = 0; sl < 16; ++sl) Bf[sl] = *(PG8_LAS const bf16x8*)(Ub + bbase + 64 * (S0 + sl));
        PG8_LAS const unsigned char* ap = KRb + (abase - 32 * (T0 - 2 * S0) - 480);
#pragma unroll
        for (int dl = -30; dl <= 15; ++dl) {
            const bf16x8 a = *(PG8_LAS const bf16x8*)(ap + 32 * (15 - dl));
#pragma unroll
            for (int sl = 0; sl < 16; ++sl) { const int t = dl + 2 * sl; if (t >= 0 && t < 16) acc[t] = __builtin_amdgcn_mfma_f32_16x16x32_bf16(a, Bf[sl], acc[t], 0, 0, 0); }
        }
    }
}
__device__ __forceinline__ void hy_epilogue(const f32x4 (&acc)[16], const u16* X, u16* U, float skip, int wid, int lane) {
    const int b = lane & 15, q = lane >> 4;
#pragma unroll
    for (int tl = 0; tl < 16; ++tl) { const int t = 16 * (wid * 16 + tl) + 4 * q;
        const uint2 xv = *(const uint2*)(X + b * UP + t), uv = *(const uint2*)(U + b * UP + t); uint2 r;
        r.x = pk2(bflo(xv.x) * (acc[tl][0] + bflo(uv.x) * skip), bfhi(xv.x) * (acc[tl][1] + bfhi(uv.x) * skip));
        r.y = pk2(bflo(xv.y) * (acc[tl][2] + bflo(uv.y) * skip), bfhi(xv.y) * (acc[tl][3] + bfhi(uv.y) * skip));
        *(uint2*)(U + b * UP + t) = r; }
}
__device__ __forceinline__ unsigned touch64k(const u16* blk, int tid) { return *(const unsigned*)(blk + tid * 64); }
__device__ void hyena_mfma(const Frame& F, unsigned char* lds, bool do_store = true) {
    int tid = threadIdx.x; asm volatile("" : "+v"(tid));
    const int lane = tid & 63, wid = __builtin_amdgcn_readfirstlane(tid >> 6);
    u16* KR = (u16*)lds; u16* U = (u16*)(lds + 8 * KRP * 2);
    PG8_LAS const unsigned char* KRb = (PG8_LAS const unsigned char*)lds; PG8_LAS const unsigned char* Ub = KRb + 8 * KRP * 2;
    const u16* KB = (const u16*)(F.dob + DO_HF);
    u16* HYT = (u16*)(F.ws + WS_HYT);
    for (int c = blockIdx.x; c < HYW; c += gridDim.x) {
        const float wv0 = F.conv_w[c], wv1 = F.conv_w[NHY + c], wv2 = F.conv_w[2 * NHY + c], cbv = F.conv_b[c];
        const float wa0 = F.conv_w[HYW + c], wa1 = F.conv_w[NHY + HYW + c], wa2 = F.conv_w[2 * NHY + HYW + c], cba = F.conv_b[HYW + c];
        const float wb0 = F.conv_w[2 * HYW + c], wb1 = F.conv_w[NHY + 2 * HYW + c], wb2 = F.conv_w[2 * NHY + 2 * HYW + c], cbb = F.conv_b[2 * HYW + c];
        const float skip0 = F.skip[c], skip1 = F.skip[HYW + c];
        f32x4 acc[16];
        __syncthreads();
        load_conv(HYT + (size_t)c * MTOK, wv0, wv1, wv2, cbv, U, tid);
        build_kr(KB + (size_t)(0 * HYW + c) * KBL, KR, tid);
        unsigned tc0 = touch64k(HYT + (size_t)(HYW + c) * MTOK, tid), tc1 = tid < 65 ? touch64k(KB + (size_t)(HYW + c) * KBL, tid) : 0u;
        __syncthreads();
        conv_mfma(KRb, Ub, wid, lane, acc);
        asm volatile("" :: "v"(tc0), "v"(tc1));
        __syncthreads();
        load_conv(HYT + (size_t)(HYW + c) * MTOK, wa0, wa1, wa2, cba, KR, tid);
        __syncthreads();
        hy_epilogue(acc, KR, U, skip0, wid, lane);
        __syncthreads();
        build_kr(KB + (size_t)(1 * HYW + c) * KBL, KR, tid);
        { const int cn = c + (int)gridDim.x < HYW ? c + (int)gridDim.x : c;
          tc0 = touch64k(HYT + (size_t)(2 * HYW + c) * MTOK, tid); tc1 = touch64k(HYT + (size_t)cn * MTOK, tid); }
        __syncthreads();
        conv_mfma(KRb, Ub, wid, lane, acc);
        asm volatile("" :: "v"(tc0), "v"(tc1));
        __syncthreads();
        load_conv(HYT + (size_t)(2 * HYW + c) * MTOK, wb0, wb1, wb2, cbb, KR, tid);
        __syncthreads();
        hy_epilogue(acc, KR, U, skip1, wid, lane);
        __syncthreads();
        if (do_store)
#pragma unroll 2
        for (int k = 0; k < 8; ++k) { const int chunk = tid + 512 * k, b = chunk >> 8, t8 = (chunk & 255) * 8;
            __builtin_nontemporal_store(*(const u32x4*)(U + b * UP + t8), (u32x4*)(HYT + (size_t)c * MTOK + b * SEQ + t8)); }
    }
    __syncthreads();
}

constexpr size_t DO_LG = 111 * MiB;
__device__ __forceinline__ uint4 pk8(const float (&v)[8]) { uint4 r; r.x = pk2(v[0], v[1]); r.y = pk2(v[2], v[3]); r.z = pk2(v[4], v[5]); r.w = pk2(v[6], v[7]); return r; }
__device__ __forceinline__ void up8(const uint4 w, float (&v)[8]) { v[0] = bflo(w.x); v[1] = bfhi(w.x); v[2] = bflo(w.y); v[3] = bfhi(w.y); v[4] = bflo(w.z); v[5] = bfhi(w.z); v[6] = bflo(w.w); v[7] = bfhi(w.w); }
__device__ __forceinline__ bf16x8 as_frag(const uint4 w) { union { uint4 u; bf16x8 f; } c; c.u = w; return c.f; }
struct AChunk { uint4 k[2][2]; uint4 v[4]; };
typedef short s16x4 __attribute__((ext_vector_type(4)));
__device__ void attn_mfma(const Frame& F, unsigned char* lds, bool do_store = true) {
    int tid = threadIdx.x; asm volatile("" : "+v"(tid));
    const int lane = tid & 63, wid = __builtin_amdgcn_readfirstlane(tid >> 6), c16 = lane & 15, q = lane >> 4;
    u16* QKV = (u16*)(F.ws + WS_QKV); float* LG = (float*)(F.dob + DO_LG);
    unsigned char* Vs = lds + wid * 5120;
    PG8_LAS const unsigned char* Vs3 = (PG8_LAS const unsigned char*)Vs;
    const int krow_off = 8 * (c16 >> 2) + (c16 & 3);
    const int tr_off = (8 * q + (c16 >> 2)) * 144 + 8 * (lane & 3);
    const float LOG2E = 1.4426950408889634f;
    float gm = fabsf(F.qg[lane] * F.kg[lane]);
#pragma unroll
    for (int o = 32; o >= 1; o >>= 1) gm = fmaxf(gm, __shfl_xor(gm, o));
    const float cmax2 = 8.0f * gm * LOG2E;
    volatile PG8_LAS float* gqt = (volatile PG8_LAS float*)((PG8_LAS unsigned char*)lds + 8 * 5120);
    __syncthreads();
    if (tid < 64) gqt[tid] = F.qg[tid] * F.kg[tid] * (0.125f * LOG2E);
    __syncthreads();
    for (int item = blockIdx.x * 8 + wid; item < NB * 8 * 3 * 32; item += gridDim.x * 8) {
        const int blk = item & 31, rest = item >> 5, g = rest % 3, bh = rest / 3, h = bh & 7, b = bh >> 3;
        const int dsh = 2 * g, n = SEQ >> dsh, nbn = 32 >> dsh, r = blk >> (5 - dsh), nb = blk & (nbn - 1);
        const float ca2 = exp2f(-(float)(h + 1)) * (float)(1 << dsh) * LOG2E;
        const size_t colq = (size_t)g * 512 + h * 64;
        const u16* base = QKV + (size_t)b * SEQ * NQKV;
        const int kc_lo = nb == 0 ? 2 : 0, kc_hi = nb == nbn - 1 ? 4 : 6;
        auto load_chunk = [&](AChunk& c, int j0c) {
#pragma unroll
            for (int kt = 0; kt < 2; ++kt) { int jk = j0c + 4 * kt + krow_off; jk = jk < 0 ? 0 : (jk > n - 1 ? n - 1 : jk);
                const u16* krow = base + (size_t)((jk << dsh) + r) * NQKV + 1536 + colq;
                c.k[kt][0] = *(const uint4*)(krow + 8 * q); c.k[kt][1] = *(const uint4*)(krow + 32 + 8 * q); }
            int jv = j0c + (lane >> 1); jv = jv < 0 ? 0 : (jv > n - 1 ? n - 1 : jv);
            const u16* vrow = base + (size_t)((jv << dsh) + r) * NQKV + 3072 + colq + 32 * (lane & 1);
#pragma unroll
            for (int v4 = 0; v4 < 4; ++v4) c.v[v4] = *(const uint4*)(vrow + 8 * v4);
        };
        AChunk cur;
        bf16x8 Qf[4][2];
#pragma unroll
        for (int qt = 0; qt < 4; ++qt) { const int i = 64 * nb + 16 * qt + c16; const u16* qrow = base + (size_t)((i << dsh) + r) * NQKV + colq;
            float v0[8], v1[8]; up8(*(const uint4*)(qrow + 8 * q), v0); up8(*(const uint4*)(qrow + 32 + 8 * q), v1);
            float ss = 0.f;
#pragma unroll
            for (int e = 0; e < 8; ++e) ss += v0[e] * v0[e] + v1[e] * v1[e];
            ss += __shfl_xor(ss, 16); ss += __shfl_xor(ss, 32);
            const float rq = rsqrtf(ss * (1.0f / 64.0f) + 1e-6f);
#pragma unroll
            for (int e = 0; e < 8; ++e) { v0[e] *= rq * gqt[8 * q + e]; v1[e] *= rq * gqt[32 + 8 * q + e]; }
            Qf[qt][0] = as_frag(pk8(v0)); Qf[qt][1] = as_frag(pk8(v1)); }
        f32x4 Oacc[4][4]; f32x4 Lacc[4];
#pragma unroll
        for (int dt = 0; dt < 4; ++dt)
#pragma unroll
            for (int qt = 0; qt < 4; ++qt) Oacc[dt][qt] = (f32x4){0.f, 0.f, 0.f, 0.f};
#pragma unroll
        for (int qt = 0; qt < 4; ++qt) Lacc[qt] = (f32x4){0.f, 0.f, 0.f, 0.f};
#pragma unroll 1
        for (int kc = kc_lo; kc < kc_hi; ++kc) {
            const int j0c = 64 * (nb - 1) + 32 * kc;
            load_chunk(cur, j0c);
            unsigned tch0 = 0, tch1 = 0;
            if (kc + 1 < kc_hi) {
                int jk = j0c + 32 + (lane >> 1); jk = jk < 0 ? 0 : (jk > n - 1 ? n - 1 : jk);
                const u16* rowp = base + (size_t)((jk << dsh) + r) * NQKV + colq + ((lane & 1) ? 3072 : 1536);
                tch0 = *(const unsigned*)rowp; }
            { unsigned char* dst = Vs + (lane >> 1) * 144 + (lane & 1) * 64;
#pragma unroll
              for (int v4 = 0; v4 < 4; ++v4) *(uint4*)(dst + 16 * v4) = cur.v[v4]; }
            bf16x8 kf[2][2];
#pragma unroll
            for (int kt = 0; kt < 2; ++kt) {
                float v0[8], v1[8]; up8(cur.k[kt][0], v0); up8(cur.k[kt][1], v1);
                float ss = 0.f;
#pragma unroll
                for (int e = 0; e < 8; ++e) ss += v0[e] * v0[e] + v1[e] * v1[e];
                ss += __shfl_xor(ss, 16); ss += __shfl_xor(ss, 32);
                const float rk = rsqrtf(ss * (1.0f / 64.0f) + 1e-6f);
#pragma unroll
                for (int e = 0; e < 8; ++e) { v0[e] *= rk; v1[e] *= rk; }
                kf[kt][0] = as_frag(pk8(v0)); kf[kt][1] = as_frag(pk8(v1)); }
            bf16x8 Pf[4];
            int rel0 = 64 + c16 - 8 * q - 32 * kc;
            asm volatile("" : "+v"(rel0));
            const float relf0 = (float)rel0;
            const bool edge = (kc < 2) || (kc > 3);
#pragma unroll
            for (int qt = 0; qt < 4; ++qt) { float p[8];
#pragma unroll
                for (int kt = 0; kt < 2; ++kt) { f32x4 z = (f32x4){-cmax2, -cmax2, -cmax2, -cmax2};
                    z = __builtin_amdgcn_mfma_f32_16x16x32_bf16(kf[kt][0], Qf[qt][0], z, 0, 0, 0);
                    z = __builtin_amdgcn_mfma_f32_16x16x32_bf16(kf[kt][1], Qf[qt][1], z, 0, 0, 0);
#pragma unroll
                    for (int j = 0; j < 4; ++j) { const float dist = fabsf(relf0 + (float)(16 * qt - 4 * kt - j));
                        const float pv = __builtin_amdgcn_exp2f(z[j] - ca2 * dist);
                        p[4 * kt + j] = (edge && dist > 64.0f) ? 0.f : pv; } }
                Pf[qt] = as_frag(pk8(p)); }
            asm volatile("" ::: "memory");
#pragma unroll
            for (int dt = 0; dt < 4; ++dt) {
                const s16x4 a0 = __builtin_amdgcn_ds_read_tr16_b64_v4i16((PG8_LAS s16x4*)(Vs3 + tr_off + 32 * dt));
                const s16x4 a1 = __builtin_amdgcn_ds_read_tr16_b64_v4i16((PG8_LAS s16x4*)(Vs3 + tr_off + 4 * 144 + 32 * dt));
                const bf16x8 vf = __builtin_shufflevector(a0, a1, 0, 1, 2, 3, 4, 5, 6, 7);
#pragma unroll
                for (int qt = 0; qt < 4; ++qt) Oacc[dt][qt] = __builtin_amdgcn_mfma_f32_16x16x32_bf16(vf, Pf[qt], Oacc[dt][qt], 0, 0, 0); }
            { const bf16x8 ones = (bf16x8){0x3F80, 0x3F80, 0x3F80, 0x3F80, 0x3F80, 0x3F80, 0x3F80, 0x3F80};
#pragma unroll
              for (int qt = 0; qt < 4; ++qt) Lacc[qt] = __builtin_amdgcn_mfma_f32_16x16x32_bf16(ones, Pf[qt], Lacc[qt], 0, 0, 0); }
            asm volatile("" :: "v"(tch0), "v"(tch1) : "memory");
        }
        if (do_store)
#pragma unroll
        for (int qt = 0; qt < 4; ++qt) { const int i = 64 * nb + 16 * qt + c16, tok = (i << dsh) + r;
            const float lt = Lacc[qt][0];
            u16* orow = QKV + (size_t)(b * SEQ + tok) * NQKV + colq + 4 * q;
#pragma unroll
            for (int dt = 0; dt < 4; ++dt) { uint2 w; w.x = pk2(Oacc[dt][qt][0], Oacc[dt][qt][1]); w.y = pk2(Oacc[dt][qt][2], Oacc[dt][qt][3]); *(uint2*)(orow + 16 * dt) = w; }
            if (q == 0) LG[((size_t)g * MTOK + b * SEQ + tok) * 8 + h] = lt; }
    }
    __syncthreads();
}
__device__ void attn_combine(const Frame& F) {
    const u16* QKV = (const u16*)(F.ws + WS_QKV); const float* LG = (const float*)(F.dob + DO_LG); u16* ATG = (u16*)(F.ws + WS_ATG);
    for (int idx = blockIdx.x * 512 + F.tid; idx < MTOK * 64; idx += gridDim.x * 512) {
        const int m = idx >> 6, cc = (idx & 63) * 8, h = cc >> 6;
        const float lt = LG[(size_t)m * 8 + h] + LG[((size_t)MTOK + m) * 8 + h] + LG[((size_t)2 * MTOK + m) * 8 + h];
        const u16* qrow = QKV + (size_t)m * NQKV + cc;
        float o0[8], o1[8], o2[8], gt[8]; up8(*(const uint4*)qrow, o0); up8(*(const uint4*)(qrow + 512), o1); up8(*(const uint4*)(qrow + 1024), o2);
        uint4* gp = (uint4*)(ATG + (size_t)m * ATW + cc); up8(*gp, gt);
        const float il = 1.0f / lt;
#pragma unroll
        for (int e = 0; e < 8; ++e) o0[e] = (o0[e] + o1[e] + o2[e]) * il * gt[e];
        *gp = pk8(o0);
    }
}

__device__ void p2b_transpose(const Frame& F, unsigned char* lds) {
    const int tid = F.tid; u16* tl = (u16*)lds;
    const u16* HYT = (const u16*)(F.ws + WS_HYT); const u16* HYG = (const u16*)(F.ws + WS_HYG); u16* YH = (u16*)(F.ws + WS_YH);
    for (int tile = blockIdx.x; tile < 12 * 512; tile += gridDim.x) {
        const int c0 = (tile % 12) * 64, m0 = (tile / 12) * 64;
        const int cl = tid >> 3, mc = (tid & 7) * 8;
        const u32x4 wq = __builtin_nontemporal_load((const u32x4*)(HYT + (size_t)(c0 + cl) * MTOK + m0 + mc)); const uint4 w = (uint4){wq.x, wq.y, wq.z, wq.w};
        tl[(mc + 0) * 72 + cl] = (u16)(w.x & 0xffff); tl[(mc + 1) * 72 + cl] = (u16)(w.x >> 16); tl[(mc + 2) * 72 + cl] = (u16)(w.y & 0xffff); tl[(mc + 3) * 72 + cl] = (u16)(w.y >> 16);
        tl[(mc + 4) * 72 + cl] = (u16)(w.z & 0xffff); tl[(mc + 5) * 72 + cl] = (u16)(w.z >> 16); tl[(mc + 6) * 72 + cl] = (u16)(w.w & 0xffff); tl[(mc + 7) * 72 + cl] = (u16)(w.w >> 16);
        __syncthreads();
        const int ml = tid >> 3, cc = (tid & 7) * 8;
        const uint4 y = *(const uint4*)&tl[ml * 72 + cc]; const uint4 g = *(const uint4*)(HYG + (size_t)(m0 + ml) * HYW + c0 + cc);
        uint4 r; r.x = pk2(bflo(y.x) * bflo(g.x), bfhi(y.x) * bfhi(g.x)); r.y = pk2(bflo(y.y) * bflo(g.y), bfhi(y.y) * bfhi(g.y));
        r.z = pk2(bflo(y.z) * bflo(g.z), bfhi(y.z) * bfhi(g.z)); r.w = pk2(bflo(y.w) * bflo(g.w), bfhi(y.w) * bfhi(g.w));
        __builtin_nontemporal_store((u32x4){r.x, r.y, r.z, r.w}, (u32x4*)(YH + (size_t)(m0 + ml) * HYW + c0 + cc));
        __syncthreads();
    }
    transpose_weight(F.w_out, DM, DM, (u16*)(F.ws + WS_WOUT), tl, tid);
}


__device__ unsigned g_bar[8 * 64 + 64 + 8 * 64];
__device__ __forceinline__ unsigned gb_ld(unsigned* p) { return __hip_atomic_load(p, __ATOMIC_RELAXED, __HIP_MEMORY_SCOPE_AGENT); }
__device__ __forceinline__ unsigned gb_add(unsigned* p) { return __hip_atomic_fetch_add(p, 1u, __ATOMIC_RELAXED, __HIP_MEMORY_SCOPE_AGENT); }
__device__ __forceinline__ void grid_bar() {
    asm volatile("s_waitcnt vmcnt(0) lgkmcnt(0)" ::: "memory");
    __syncthreads();
    if (threadIdx.x == 0) {
        __builtin_amdgcn_fence(__ATOMIC_RELEASE, "agent");
        asm volatile("s_waitcnt vmcnt(0)" ::: "memory");
        const unsigned G = gridDim.x, ng = (G % 8u == 0u) ? 8u : 1u, n = G / ng, g = blockIdx.x % ng;
        const unsigned old = gb_add(&g_bar[g * 64]), gen = old / n;
        if (old % n == n - 1u) {
            const unsigned t = gb_add(&g_bar[512]), want = (t / ng + 1u) * ng;
            while ((int)(gb_ld(&g_bar[512]) - want) < 0) __builtin_amdgcn_s_sleep(10);
            gb_add(&g_bar[576 + g * 64]);
        } else {
            while ((int)(gb_ld(&g_bar[576 + g * 64]) - (gen + 1u)) < 0) __builtin_amdgcn_s_sleep(40);
        }
        __builtin_amdgcn_fence(__ATOMIC_ACQUIRE, "agent");
        asm volatile("s_waitcnt vmcnt(0)" ::: "memory");
    }
    __syncthreads();
}

__global__ void __launch_bounds__(512) mk_fwd(Args args) {
    extern __shared__ __attribute__((aligned(16))) unsigned char lds[];
    cg::grid_group grid = cg::this_grid();
    Frame F;
    F.x = args.in[0]; F.norm_g = args.in[1]; F.w_in = args.in[2]; F.b_in = args.in[3]; F.conv_w = args.in[4]; F.conv_b = args.in[5];
    F.w1 = args.in[6]; F.b1 = args.in[7]; F.w2 = args.in[8]; F.b2 = args.in[9]; F.w3 = args.in[10]; F.b3 = args.in[11]; F.w4 = args.in[12]; F.freq = args.in[13];
    F.skip = args.in[14]; F.qg = args.in[15]; F.kg = args.in[16]; F.w_hy = args.in[17]; F.w_at = args.in[18]; F.w_out = args.in[19];
    F.out = args.out; F.ws = args.ws; F.dob = (unsigned char*)args.out;
    F.tid = threadIdx.x; F.lane = F.tid & 63; F.wid = __builtin_amdgcn_readfirstlane(F.tid >> 6);
    const int lo = args.ph_lo, hi = args.ph_hi;
    PG8_LAS unsigned char* ldsa = (PG8_LAS unsigned char*)lds;
    const int G = gridDim.x, c = blockIdx.x;
#ifdef ONLY
#define IN(k) ((k) == ONLY && lo <= (k) && (k) < hi)
#elif defined(SKIP)
#define IN(k) ((k) != SKIP && lo <= (k) && (k) < hi)
#else
#define IN(k) (lo <= (k) && (k) < hi)
#endif
#define SEAM(k) do { if (IN(k) && IN((k) + 1)) { if (hi > 100) grid.sync(); else grid_bar(); } } while (0)
#ifdef REPEAT
#define NREP(k) ((k) == REPEAT ? 2 : 1)
#else
#define NREP(k) 1
#endif
    if (IN(0)) for (int rep = 0; rep < NREP(0); ++rep) p0_prologue(F, lds);
    SEAM(0);
    if (IN(1)) for (int rep = 0; rep < NREP(1); ++rep) {
        pg8::Gemm g{(const u16*)(F.dob + DO_XN), (const u16*)(F.dob + DO_WIN), MTOK, 8192, DM}; pg8::StaticOrder S; S.init(MTOK, 8192, G, c);
        Epi1 E{(u16*)(F.ws + WS_HYT), (u16*)(F.ws + WS_QKV), (u16*)(F.ws + WS_HYG), (u16*)(F.ws + WS_ATG), F.b_in, ldsa + 131072};
        pg8::gemm_phase<Epi1, pg8::StaticOrder>(ldsa, g, S, E, nullptr);
    }
    SEAM(1);
    if (IN(2)) {
#if defined(REPEAT) && REPEAT == 2
        hyena_mfma(F, lds, hi > 100);
#endif
        hyena_mfma(F, lds);
#if defined(REPEAT) && REPEAT == 6
        attn_mfma(F, lds, hi > 100);
#endif
        attn_mfma(F, lds);
#if defined(REPEAT) && REPEAT == 7
        for (int k = 0; k < 5; ++k) grid.sync();
#endif
    }
    SEAM(2);
    if (IN(3)) { for (int rep = 0; rep < NREP(3); ++rep) p2b_transpose(F, lds); attn_combine(F); }
    SEAM(3);
    if (IN(4)) for (int rep = 0; rep < NREP(4); ++rep) {
        pg8::StaticOrder S; S.init(MTOK, DM, G, c);
        { pg8::Gemm g{(const u16*)(F.dob + DO_XN), (const u16*)(F.dob + DO_WIN) + (size_t)8192 * DM, MTOK, DM, DM}; EpiSig E{(u16*)(F.ws + WS_SG), F.b_in + 8192};
          pg8::gemm_phase<EpiSig, pg8::StaticOrder>(ldsa, g, S, E, nullptr); }
        { pg8::Gemm g{(const u16*)(F.ws + WS_YH), (const u16*)(F.dob + DO_WHY), MTOK, DM, HYW}; EpiGate<0> E{(const u16*)(F.ws + WS_SG), (u16*)(F.ws + WS_TMP), nullptr};
          pg8::gemm_phase<EpiGate<0>, pg8::StaticOrder>(ldsa, g, S, E, nullptr); }
        { pg8::Gemm g{(const u16*)(F.dob + DO_XN), (const u16*)(F.dob + DO_WIN) + (size_t)9216 * DM, MTOK, DM, DM}; EpiSig E{(u16*)(F.ws + WS_SG), F.b_in + 9216};
          pg8::gemm_phase<EpiSig, pg8::StaticOrder>(ldsa, g, S, E, nullptr); }
        { pg8::Gemm g{(const u16*)(F.ws + WS_ATG), (const u16*)(F.dob + DO_WAT), MTOK, DM, ATW}; EpiGate<1> E{(const u16*)(F.ws + WS_SG), (u16*)(F.ws + WS_TMP), (u16*)(F.ws + WS_MRG)};
          pg8::gemm_phase<EpiGate<1>, pg8::StaticOrder>(ldsa, g, S, E, nullptr); }
    }
    SEAM(4);
    if (IN(5)) for (int rep = 0; rep < NREP(5); ++rep) {
        pg8::Gemm g{(const u16*)(F.ws + WS_MRG), (const u16*)(F.ws + WS_WOUT), MTOK, DM, DM}; pg8::StaticOrder S; S.init(MTOK, DM, G, c);
        EpiOut E{F.x, F.out};
        pg8::gemm_phase<EpiOut, pg8::StaticOrder>(ldsa, g, S, E, nullptr);
    }
#undef IN
#undef SEAM
}

extern "C" void kernel_launch(void* const* d_in, const int* in_sizes, int n_in, void* d_out, int out_size, void* d_ws, size_t ws_size, hipStream_t stream) {
    static int grid = 0;
    if (grid == 0) {
        if (n_in != 20 || out_size != MTOK * DM || ws_size < WS_END) { fprintf(stderr, "kernel_launch: unexpected shapes (n_in %d out %d ws %zu)\n", n_in, out_size, ws_size); grid = -1; return; }
        int dev = 0, cus = 0, per_cu = 0;
        hipGetDevice(&dev); hipDeviceGetAttribute(&cus, hipDeviceAttributeMultiprocessorCount, dev);
        if (hipFuncSetAttribute((const void*)mk_fwd, hipFuncAttributeMaxDynamicSharedMemorySize, LDS_BYTES) != hipSuccess) { fprintf(stderr, "kernel_launch: hipFuncSetAttribute failed\n"); grid = -1; return; }
        if (hipOccupancyMaxActiveBlocksPerMultiprocessor(&per_cu, (const void*)mk_fwd, 512, LDS_BYTES) != hipSuccess || per_cu < 1) { fprintf(stderr, "kernel_launch: occupancy query failed (%d)\n", per_cu); per_cu = 1; }
        (void)hipGetLastError();
        grid = cus;
        if (grid != 256) fprintf(stderr, "kernel_launch: note: %d CUs\n", grid);
    }
    if (grid < 0) return;
    Args a{};
    for (int i = 0; i < 20; ++i) a.in[i] = (const float*)d_in[i];
    a.out = (float*)d_out; a.ws = (unsigned char*)d_ws;
#if ONE_LAUNCH
    a.ph_lo = 0; a.ph_hi = 6;
    void* kargs[] = {&a};
    hipError_t e = hipLaunchCooperativeKernel((const void*)mk_fwd, dim3(grid), dim3(512), kargs, LDS_BYTES, stream);
    if (e != hipSuccess) fprintf(stderr, "cooperative launch failed: %s (grid %d)\n", hipGetErrorString(e), grid);
#else
    for (int ph = 0; ph < 6; ++ph) { a.ph_lo = ph; a.ph_hi = ph + 1; hipLaunchKernelGGL(mk_fwd, dim3(grid), dim3(512), LDS_BYTES, stream, a); }
#endif
}
```

```cpp
#include <hip/hip_runtime.h>
#include <hip/hip_cooperative_groups.h>
#include <cstdio>
namespace cg = cooperative_groups;
namespace pg8 {
#define PG8_LAS __attribute__((address_space(3)))
typedef unsigned short bf16_t;
typedef short bf16x8 __attribute__((ext_vector_type(8)));
typedef float f32x4 __attribute__((ext_vector_type(4)));
typedef unsigned u32x4 __attribute__((ext_vector_type(4)));
constexpr int BM = 256, BK = 64, HALF = 128, HTB = HALF * BK * 2  , STAGE_BYTES = 8 * HTB, NXCD = 8, WGM = 8;

__host__ __device__ __forceinline__ int lds_byte(int r, int c) { const int st = (r >> 4) * 2 + (c >> 5), rr = r & 15, cc = c & 31, ob = rr * 64 + cc * 2; return st * 1024 + (ob ^ (((ob >> 9) & 1) << 5)); }
__host__ __device__ __forceinline__ void stage_rc(int b, int& R, int& C) { const int st = b / 1024, sb = b % 1024, swz = sb ^ (((sb >> 9) & 1) << 5); R = (st >> 1) * 16 + swz / 64; C = (st & 1) * 32 + (swz % 64) / 2; }
__host__ __device__ __forceinline__ int perm32(int rho) { const int n = rho >> 4, i = rho & 15; return 8 * (i >> 2) + 4 * n + (i & 3); }

struct Unit { int pm, pn; };
struct Gemm { const bf16_t* A; const bf16_t* Bt; int M, N, K; };

struct StaticOrder {
    int nM, nN, nwg, G, c;
    __host__ __device__ void init(int M, int N, int G_, int c_) { nM = M / BM; nN = N / BM; nwg = nM * nN; G = G_; c = c_; }
    __host__ __device__ bool next(int i, Unit& u) const {
        const long L = (long)i * G + c; if (L >= nwg) return false;
        int wgid = (int)L; { const int q = nwg / NXCD, r = nwg % NXCD, xcd = wgid % NXCD, off = wgid / NXCD; wgid = (xcd < r ? xcd * (q + 1) : r * (q + 1) + (xcd - r) * q) + off; }
        const int nig = WGM * nN, gid = wgid / nig, fm = gid * WGM, gsz = (nM - fm) < WGM ? (nM - fm) : WGM;
        u.pm = fm + ((wgid % nig) % gsz); u.pn = (wgid % nig) / gsz; return true;
    }
    __device__ __forceinline__ void a_ready(const Unit&) const {}
    __device__ __forceinline__ void done(const Unit&) const {}
};
__device__ __forceinline__ unsigned cvt_pk_bf16(float lo, float hi) { unsigned r; asm volatile("v_cvt_pk_bf16_f32 %0, %1, %2" : "=v"(r) : "v"(lo), "v"(hi)); return r; }
typedef float f32x2 __attribute__((ext_vector_type(2)));
template <class Epi, class Sched, bool STAMP = false>
__device__ __forceinline__ void gemm_phase(PG8_LAS unsigned char* lds, const Gemm g, const Sched& S, const Epi& E, unsigned long long* stamps) {
    int tid_ = threadIdx.x; asm volatile("" : "+v"(tid_));
    const int tid = tid_, wid = __builtin_amdgcn_readfirstlane(tid >> 6), lane = tid & 63, wr = wid >> 2, wc = wid & 3, fr = lane & 15, fq = lane >> 4;
    const int K = g.K, nt = K / BK;
    int ts_lo = 0, ts_hi = 0, nts = 0; const unsigned long long rt_entry = STAMP ? (unsigned long long)wall_clock64() : 0ull;
#define PG8_STAMP() do { if (STAMP && wid == 0 && nts < 64) { const unsigned long long _c = (unsigned long long)clock64(); \
        ts_lo = (lane == nts) ? (int)(unsigned)_c : ts_lo; ts_hi = (lane == nts) ? (int)(unsigned)(_c >> 32) : ts_hi; ++nts; } } while (0)
    PG8_STAMP();
    unsigned voffA[2], voffB[2];
#pragma unroll
    for (int i = 0; i < 2; ++i) { int R, C; stage_rc(tid * 16 + i * 8192, R, C); const int Rb = Epi::PERM ? ((R & ~31) + perm32(R & 31)) : R;
        voffA[i] = (unsigned)(R * K + C) * 2u; voffB[i] = (unsigned)(Rb * K + C) * 2u; }
    const size_t kstep = (size_t)(BK * 2);
    const size_t hstep = (size_t)HALF * K * 2;
    const size_t tstep = 2 * hstep;
    const unsigned ldsw = (unsigned)wid * 1024u;
    const int aoff = lds_byte(wr * 64 + fr, fq * 8), boff = lds_byte(wc * 32 + fr, fq * 8);
#define PG8_SA(b, h) (((b) * 2 + (h)) * HTB)
#define PG8_SB(b, h) ((4 + (b) * 2 + (h)) * HTB)
#define PG8_STAGE(bufoff, gbase, voff) do { _Pragma("unroll") for (int _i = 0; _i < 2; ++_i) \
        __builtin_amdgcn_global_load_lds((const unsigned*)((const char*)(gbase) + (voff)[_i]), (PG8_LAS unsigned*)(lds + (bufoff) + ldsw + _i * 8192), 16, 0, 0); } while (0)
#define PG8_LDA(dst, b, h) do { _Pragma("unroll") for (int m = 0; m < 4; ++m) _Pragma("unroll") for (int k = 0; k < 2; ++k) dst[m][k] = *(const PG8_LAS bf16x8*)(lds + PG8_SA(b, h) + aoff + m * 2048 + k * 1024); } while (0)
#define PG8_LDB(dst, b, h) do { _Pragma("unroll") for (int n = 0; n < 2; ++n) _Pragma("unroll") for (int k = 0; k < 2; ++k) dst[n][k] = *(const PG8_LAS bf16x8*)(lds + PG8_SB(b, h) + boff + n * 2048 + k * 1024); } while (0)
#define PG8_MMA(ai, bj, At, Bt) do { __builtin_amdgcn_s_setprio(1); _Pragma("unroll") for (int m = 0; m < 4; ++m) _Pragma("unroll") for (int n = 0; n < 2; ++n) _Pragma("unroll") for (int k = 0; k < 2; ++k) \
        acc[ai][bj][m][n] = __builtin_amdgcn_mfma_f32_16x16x32_bf16(Bt[n][k], At[m][k], acc[ai][bj][m][n], 0, 0, 0); __builtin_amdgcn_s_setprio(0); } while (0)
#define PG8_WAIT_V(n) asm volatile("s_waitcnt vmcnt(" #n ")" ::: "memory")
#define PG8_WAIT_L(n) asm volatile("s_waitcnt lgkmcnt(" #n ")" ::: "memory")
#define PG8_BAR __builtin_amdgcn_s_barrier()
#define PG8_SCHED __builtin_amdgcn_sched_barrier(0)
    Unit cur, nxt; int ui = 0;
    if (!S.next(0, cur)) return;
    f32x4 acc[2][2][4][2];
#pragma unroll
    for (int a = 0; a < 2; ++a)
#pragma unroll
        for (int b = 0; b < 2; ++b)
#pragma unroll
            for (int m = 0; m < 4; ++m)
#pragma unroll
                for (int n = 0; n < 2; ++n) acc[a][b][m][n] = (f32x4){0.f, 0.f, 0.f, 0.f};
    bf16x8 At[4][2], B0[2][2], B1[2][2];
    const char* cA = (const char*)g.A + (size_t)cur.pm * tstep; const char* cB = (const char*)g.Bt + (size_t)cur.pn * tstep;
    S.a_ready(cur);
    PG8_STAGE(PG8_SB(0, 0), cB, voffB); PG8_STAGE(PG8_SA(0, 0), cA, voffA); PG8_STAGE(PG8_SB(0, 1), cB + hstep, voffB); PG8_STAGE(PG8_SA(0, 1), cA + hstep, voffA);
    if (wr == 1) PG8_BAR;
    PG8_WAIT_V(4); PG8_BAR;
    PG8_STAGE(PG8_SB(1, 0), cB + kstep, voffB); PG8_STAGE(PG8_SA(1, 0), cA + kstep, voffA); PG8_STAGE(PG8_SB(1, 1), cB + hstep + kstep, voffB);
    PG8_WAIT_V(6); PG8_BAR;
    PG8_STAMP();
    for (;;) {
        const bool has_next = S.next(ui + 1, nxt);
        const char* nA = has_next ? (const char*)g.A + (size_t)nxt.pm * tstep : cA; const char* nB = has_next ? (const char*)g.Bt + (size_t)nxt.pn * tstep : cB;
        for (int t = 0; t < nt; t += 2) {
            const bool last = (t == nt - 2);
            const char* a1 = cA + (size_t)(t + 1) * kstep;
            const char* a2 = last ? nA : cA + (size_t)(t + 2) * kstep; const char* b2 = last ? nB : cB + (size_t)(t + 2) * kstep;
            const char* a3 = a2 + kstep; const char* b3 = b2 + kstep;
            if (last && has_next) S.a_ready(nxt);
            PG8_LDB(B0, 0, 0); PG8_SCHED; PG8_LDA(At, 0, 0); PG8_STAGE(PG8_SA(1, 1), a1 + hstep, voffA);
            PG8_WAIT_L(8); PG8_BAR; PG8_WAIT_L(0); PG8_MMA(0, 0, At, B0); PG8_BAR; PG8_SCHED;
            PG8_LDB(B1, 0, 1); PG8_STAGE(PG8_SB(0, 0), b2, voffB);
            PG8_BAR; PG8_WAIT_L(0); PG8_MMA(0, 1, At, B1); PG8_BAR;
            PG8_LDA(At, 0, 1); PG8_STAGE(PG8_SA(0, 0), a2, voffA);
            PG8_BAR; PG8_WAIT_L(0); PG8_MMA(1, 0, At, B0); PG8_BAR; PG8_SCHED;
            PG8_STAGE(PG8_SB(0, 1), b2 + hstep, voffB);
            PG8_WAIT_V(6); PG8_BAR; PG8_MMA(1, 1, At, B1); PG8_BAR;
            PG8_LDB(B0, 1, 0); PG8_SCHED; PG8_LDA(At, 1, 0); PG8_STAGE(PG8_SA(0, 1), a2 + hstep, voffA);
            PG8_WAIT_L(8); PG8_BAR; PG8_WAIT_L(0); PG8_MMA(0, 0, At, B0); PG8_BAR; PG8_SCHED;
            PG8_LDB(B1, 1, 1); PG8_STAGE(PG8_SB(1, 0), b3, voffB);
            PG8_BAR; PG8_WAIT_L(0); PG8_MMA(0, 1, At, B1); PG8_BAR;
            PG8_LDA(At, 1, 1); PG8_STAGE(PG8_SA(1, 0), a3, voffA);
            PG8_BAR; PG8_WAIT_L(0); PG8_MMA(1, 0, At, B0); PG8_BAR; PG8_SCHED;
            PG8_STAGE(PG8_SB(1, 1), b3 + hstep, voffB);
            PG8_WAIT_V(6); PG8_BAR; PG8_MMA(1, 1, At, B1); PG8_BAR;
        }
        PG8_STAMP();
        if constexpr (!Epi::AFTER_DRAIN) { E(acc, cur, wr, wc, fr, fq); S.done(cur); }
        PG8_STAMP();
        if (!has_next) break;
#pragma unroll
        for (int a = 0; a < 2; ++a)
#pragma unroll
            for (int b = 0; b < 2; ++b)
#pragma unroll
                for (int m = 0; m < 4; ++m)
#pragma unroll
                    for (int n = 0; n < 2; ++n) acc[a][b][m][n] = (f32x4){0.f, 0.f, 0.f, 0.f};
        cur = nxt; cA = nA; cB = nB; ++ui;
    }
    PG8_WAIT_V(0);
    if (wr == 0) PG8_BAR;
    PG8_BAR;
    if constexpr (Epi::AFTER_DRAIN) { E.fused(acc, cur, wr, wc, fr, fq, lds, wid, lane); S.done(cur); }
    PG8_STAMP();
    if (STAMP && wid == 0) { stamps[lane] = lane < nts ? (((unsigned long long)(unsigned)ts_hi << 32) | (unsigned)ts_lo) : 0ull;
        if (lane == 62) stamps[62] = rt_entry; if (lane == 63) stamps[63] = (unsigned long long)wall_clock64(); }
#undef PG8_STAMP
#undef PG8_SA
#undef PG8_SB
#undef PG8_STAGE
#undef PG8_LDA
#undef PG8_LDB
#undef PG8_MMA
#undef PG8_WAIT_V
#undef PG8_WAIT_L
#undef PG8_BAR
#undef PG8_SCHED
}
}

#ifndef ONE_LAUNCH
#define ONE_LAUNCH 1
#endif
typedef unsigned short u16;
typedef pg8::f32x4 f32x4;
typedef pg8::u32x4 u32x4;
constexpr int MTOK = 32768, DM = 1024, SEQ = 2048, NB = 16, HYW = 768, NHY = 2304, NQKV = 4608, ATW = 512;
constexpr size_t MiB = 1024 * 1024;
constexpr size_t WS_HYT = 0;
constexpr size_t WS_QKV = 144 * MiB;
constexpr size_t WS_HYG = 432 * MiB;
constexpr size_t WS_ATG = 480 * MiB;
constexpr size_t WS_END = 512 * MiB;
constexpr size_t WS_YH = WS_HYT + 48 * MiB, WS_WOUT = WS_HYT + 96 * MiB;
constexpr size_t WS_SG = WS_QKV, WS_TMP = WS_QKV + 64 * MiB, WS_MRG = WS_QKV + 192 * MiB;
constexpr size_t DO_XN = 0, DO_WIN = 64 * MiB, DO_WHY = 84 * MiB, DO_WAT = DO_WHY + 1536 * 1024, DO_HF = 87 * MiB;
constexpr int LDS_BYTES = 144 * 1024;
constexpr int KBL = 4104;
constexpr int KRP = 4112;
constexpr int UP = 2056;

struct Args { const float* in[20]; float* out; unsigned char* ws; int ph_lo, ph_hi; };
struct Frame {
    const float *x, *norm_g, *w_in, *b_in, *conv_w, *conv_b, *w1, *b1, *w2, *b2, *w3, *b3, *w4, *freq, *skip, *qg, *kg, *w_hy, *w_at, *w_out;
    float* out; unsigned char* ws; unsigned char* dob;
    int tid, lane, wid;
};

__device__ __forceinline__ u16 f2bf(float f) { unsigned u = __float_as_uint(f); u += 0x7FFFu + ((u >> 16) & 1u); return (u16)(u >> 16); }
__device__ __forceinline__ float bf2f(u16 b) { return __uint_as_float(((unsigned)b) << 16); }
__device__ __forceinline__ float bflo(unsigned w) { return __uint_as_float(w << 16); }
__device__ __forceinline__ float bfhi(unsigned w) { return __uint_as_float(w & 0xffff0000u); }
typedef float f32x2v __attribute__((ext_vector_type(2)));
typedef __bf16 bf16x2v __attribute__((ext_vector_type(2)));
__device__ __forceinline__ unsigned pk2(float lo, float hi) { const f32x2v v = {lo, hi}; return __builtin_bit_cast(unsigned, __builtin_convertvector(v, bf16x2v)); }
__device__ __forceinline__ float sigmoidf_(float v) { return __builtin_amdgcn_rcpf(1.0f + __builtin_amdgcn_exp2f(-1.4426950408889634f * v)); }
__device__ __forceinline__ float siluf_(float v) { return v * __builtin_amdgcn_rcpf(1.0f + __builtin_amdgcn_exp2f(-1.4426950408889634f * v)); }

typedef unsigned u32x4u __attribute__((ext_vector_type(4), aligned(2)));
__device__ __forceinline__ void transpose_tile_f32(const float* src, int K, int N, u16* dst, int k0, int n0, u16* tile, int tid) {
    const int kl = tid >> 3, nc = (tid & 7) * 8;
    const float4* p = (const float4*)(src + (size_t)(k0 + kl) * N + n0 + nc);
    const float4* p2 = (const float4*)(src + (size_t)(k0 + 64 + kl) * N + n0 + nc);
    const float4 a = p[0], b = p[1], c = p2[0], d = p2[1];
    tile[(nc + 0) * 136 + kl] = f2bf(a.x); tile[(nc + 1) * 136 + kl] = f2bf(a.y); tile[(nc + 2) * 136 + kl] = f2bf(a.z); tile[(nc + 3) * 136 + kl] = f2bf(a.w);
    tile[(nc + 4) * 136 + kl] = f2bf(b.x); tile[(nc + 5) * 136 + kl] = f2bf(b.y); tile[(nc + 6) * 136 + kl] = f2bf(b.z); tile[(nc + 7) * 136 + kl] = f2bf(b.w);
    tile[(nc + 0) * 136 + 64 + kl] = f2bf(c.x); tile[(nc + 1) * 136 + 64 + kl] = f2bf(c.y); tile[(nc + 2) * 136 + 64 + kl] = f2bf(c.z); tile[(nc + 3) * 136 + 64 + kl] = f2bf(c.w);
    tile[(nc + 4) * 136 + 64 + kl] = f2bf(d.x); tile[(nc + 5) * 136 + 64 + kl] = f2bf(d.y); tile[(nc + 6) * 136 + 64 + kl] = f2bf(d.z); tile[(nc + 7) * 136 + 64 + kl] = f2bf(d.w);
    __syncthreads();
    const int nl = tid >> 3, kc = (tid & 7) * 16;
    const uint4 w0 = *(const uint4*)&tile[nl * 136 + kc], w1 = *(const uint4*)&tile[nl * 136 + kc + 8];
    uint4* dp = (uint4*)(dst + (size_t)(n0 + nl) * K + k0 + kc); dp[0] = w0; dp[1] = w1;
    __syncthreads();
}
__device__ void transpose_weight(const float* src, int K, int N, u16* dst, u16* tile, int tid) {
    const int nkt = K / 128, nnt = N / 64;
    for (int t = blockIdx.x; t < nkt * nnt; t += gridDim.x) transpose_tile_f32(src, K, N, dst, (t % nkt) * 128, (t / nkt) * 64, tile, tid);
}

__device__ __forceinline__ void bar4(PG8_LAS unsigned* cnt, unsigned& target, int lane) {
    asm volatile("s_waitcnt lgkmcnt(0)" ::: "memory");
    target += 4u;
    if (lane == 0) {
        __hip_atomic_fetch_add(cnt, 1u, __ATOMIC_RELAXED, __HIP_MEMORY_SCOPE_WORKGROUP);
        while (__hip_atomic_load(cnt, __ATOMIC_RELAXED, __HIP_MEMORY_SCOPE_WORKGROUP) < target) __builtin_amdgcn_s_sleep(1);
    }
    asm volatile("" ::: "memory");
}
__device__ void p0_prologue(const Frame& F, unsigned char* lds) {
    const int tid = F.tid, lane = F.lane, wid = F.wid;
    u16* tile = (u16*)lds;
    transpose_weight(F.w_in, DM, 10240, (u16*)(F.dob + DO_WIN), tile, tid);
    transpose_weight(F.w_hy, HYW, DM, (u16*)(F.dob + DO_WHY), tile, tid);
    transpose_weight(F.w_at, ATW, DM, (u16*)(F.dob + DO_WAT), tile, tid);
    PG8_LAS unsigned* cnt = (PG8_LAS unsigned*)((PG8_LAS unsigned char*)lds + 65536);
    __syncthreads();
    if (tid == 0) *(volatile PG8_LAS unsigned*)cnt = 0u;
    __syncthreads();
    if (wid >= 4) {
        u16* XN = (u16*)(F.dob + DO_XN);
        for (int row = (blockIdx.x * 4 + (wid - 4)) * 2; row < MTOK; row += gridDim.x * 8) {
            const float4* xr = (const float4*)(F.x + (size_t)row * DM);
            float4 v[8]; float s0 = 0.f, s1 = 0.f;
#pragma unroll
            for (int i = 0; i < 8; ++i) { const f32x4 t = __builtin_nontemporal_load((const f32x4*)xr + lane + 64 * i); v[i] = make_float4(t.x, t.y, t.z, t.w); }
#pragma unroll
            for (int i = 0; i < 4; ++i) { s0 += v[i].x * v[i].x + v[i].y * v[i].y + v[i].z * v[i].z + v[i].w * v[i].w;
                s1 += v[i + 4].x * v[i + 4].x + v[i + 4].y * v[i + 4].y + v[i + 4].z * v[i + 4].z + v[i + 4].w * v[i + 4].w; }
#pragma unroll
            for (int o = 32; o >= 1; o >>= 1) { s0 += __shfl_xor(s0, o); s1 += __shfl_xor(s1, o); }
            const float r0 = rsqrtf(s0 * (1.0f / DM) + 1e-6f), r1 = rsqrtf(s1 * (1.0f / DM) + 1e-6f);
#pragma unroll
            for (int i = 0; i < 4; ++i) { const float4 g = ((const float4*)F.norm_g)[lane + 64 * i];
                uint2 w; w.x = pk2(v[i].x * r0 * g.x, v[i].y * r0 * g.y); w.y = pk2(v[i].z * r0 * g.z, v[i].w * r0 * g.w);
                *(uint2*)(XN + (size_t)row * DM + 4 * (lane + 64 * i)) = w;
                uint2 w2; w2.x = pk2(v[i + 4].x * r1 * g.x, v[i + 4].y * r1 * g.y); w2.y = pk2(v[i + 4].z * r1 * g.z, v[i + 4].w * r1 * g.w);
                *(uint2*)(XN + (size_t)(row + 1) * DM + 4 * (lane + 64 * i)) = w2; }
        }
    } else {
        unsigned target = 0u;
        u16* KB = (u16*)(F.dob + DO_HF);
        float* zs = (float*)lds;
        float* ha = zs + 8 * 40;
        float* hb = ha + 8 * 64;
        float* ws1 = hb + 8 * 64;
        float* ws2 = ws1 + 33 * 64;
        float* ws3 = ws2 + 64 * 64;
        for (int e = tid; e < 33 * 16; e += 256) ((float4*)ws1)[e] = ((const float4*)F.w1)[e];
        for (int e = tid; e < 64 * 16; e += 256) { ((float4*)ws2)[e] = ((const float4*)F.w2)[e]; ((float4*)ws3)[e] = ((const float4*)F.w3)[e]; }
        for (int blk = blockIdx.x; blk < SEQ / 8; blk += gridDim.x) {
            const int t0 = blk * 8;
            bar4(cnt, target, lane);
            for (int e = tid; e < 8 * 33; e += 256) { const int p = e / 33, i = e % 33; const float tt = (float)(t0 + p);
                float val;
                if (i == 0) val = tt * (1.0f / 2047.0f);
                else { const int j = (i - 1) & 15; const float f = 1e-4f + (float)j * ((15.0f - 1e-4f) / 15.0f); const float w = 6.283185307179586f * tt * (1.0f / 2048.0f); const float a = f * w;
                    val = (i <= 16) ? cosf(a) : -sinf(a); }
                zs[p * 40 + i] = val; }
            bar4(cnt, target, lane);
            const int p0 = tid >> 6, j = tid & 63; const float fr = F.freq[j];
#pragma unroll 1
            for (int pp = p0; pp < 8; pp += 4) { float a = F.b1[j];
#pragma unroll 3
                for (int i = 0; i < 33; ++i) a += zs[pp * 40 + i] * ws1[i * 64 + j]; ha[pp * 64 + j] = sinf(fr * a); }
            bar4(cnt, target, lane);
#pragma unroll 1
            for (int pp = p0; pp < 8; pp += 4) { float a = F.b2[j];
#pragma unroll 4
                for (int i = 0; i < 64; ++i) a += ha[pp * 64 + i] * ws2[i * 64 + j]; hb[pp * 64 + j] = sinf(fr * a); }
            bar4(cnt, target, lane);
#pragma unroll 1
            for (int pp = p0; pp < 8; pp += 4) { float a = F.b3[j];
#pragma unroll 4
                for (int i = 0; i < 64; ++i) a += hb[pp * 64 + i] * ws3[i * 64 + j]; ha[pp * 64 + j] = sinf(fr * a); }
            bar4(cnt, target, lane);
#pragma unroll 1
            for (int col = tid; col < 3072; col += 256) {
                float acc[8];
#pragma unroll
                for (int q = 0; q < 8; ++q) acc[q] = 0.f;
                float wv[64];
#pragma unroll
                for (int k = 0; k < 64; ++k) wv[k] = F.w4[k * 3072 + col];
                int hoff = 0; asm volatile("" : "+v"(hoff));
#pragma unroll
                for (int k4 = 0; k4 < 16; ++k4)
#pragma unroll
                    for (int q = 0; q < 8; ++q) { const float4 h = *(const float4*)&ha[hoff + q * 64 + 4 * k4];
                        acc[q] += h.x * wv[4 * k4] + h.y * wv[4 * k4 + 1] + h.z * wv[4 * k4 + 2] + h.w * wv[4 * k4 + 3]; }
                const int o = col / 1536, d = (col % 1536) / 768, c = col % 768;
                const float dmin = 3.0701134573253944f, dmax = 15.350567286626972f;
                const float ad = dmin + (float)c * ((dmax - dmin) / 767.0f);
#pragma unroll
                for (int q = 0; q < 8; ++q) acc[q] *= expf(-((float)(t0 + q) * (1.0f / 2047.0f)) * ad);
                u16* kb = KB + (size_t)(o * HYW + c) * KBL;
                if (d == 0) { u32x4u w; w.x = pk2(acc[7], acc[6]); w.y = pk2(acc[5], acc[4]); w.z = pk2(acc[3], acc[2]); w.w = pk2(acc[1], acc[0]);
                    *(u32x4u*)(kb + 2041 - t0) = w;
                    if (t0 == 0) { kb[0] = 0;
#pragma unroll
                        for (int q = 0; q < 8; ++q) kb[4096 + q] = 0; } }
                else if (t0 > 0) { u32x4u w; w.x = pk2(acc[0], acc[1]); w.y = pk2(acc[2], acc[3]); w.z = pk2(acc[4], acc[5]); w.w = pk2(acc[6], acc[7]); *(u32x4u*)(kb + 2048 + t0) = w; }
                else {
#pragma unroll
                    for (int q = 1; q < 8; ++q) kb[2048 + q] = f2bf(acc[q]); }
            }
        }
    }
    __syncthreads();
}

template <int ACT> __device__ __forceinline__ void store_rm(const f32x4 (&acc)[2][2][4][2], const f32x4 (&bv)[2][2], u16* base, int ldc, int row0, int col0) {
#pragma unroll
    for (int ai = 0; ai < 2; ++ai)
#pragma unroll
        for (int m = 0; m < 4; ++m) { u16* rowp = base + (size_t)(row0 + ai * 128 + m * 16) * ldc + col0;
#pragma unroll
            for (int bj = 0; bj < 2; ++bj) { f32x4 v0 = acc[ai][bj][m][0] + bv[bj][0], v1 = acc[ai][bj][m][1] + bv[bj][1];
                if (ACT) {
#pragma unroll
                    for (int j = 0; j < 4; ++j) { v0[j] = siluf_(v0[j]); v1[j] = siluf_(v1[j]); } }
                u32x4 w; w.x = pk2(v0[0], v0[1]); w.y = pk2(v0[2], v0[3]); w.z = pk2(v1[0], v1[1]); w.w = pk2(v1[2], v1[3]);
                __builtin_nontemporal_store(w, (u32x4*)(rowp + bj * 128)); } }
}
struct Epi1 {
    static constexpr bool PERM = true, AFTER_DRAIN = false;
    u16 *hyt, *qkv, *hyg, *atg; const float* bias; PG8_LAS unsigned char* tr;
    __device__ __forceinline__ void operator()(const f32x4 (&acc)[2][2][4][2], const pg8::Unit& u, int wr, int wc, int fr, int fq) const {
        const int row0 = u.pm * 256 + wr * 64 + fr, colg = u.pn * 256 + wc * 32 + 8 * fq;
        f32x4 bv[2][2];
#pragma unroll
        for (int bj = 0; bj < 2; ++bj)
#pragma unroll
            for (int n = 0; n < 2; ++n) bv[bj][n] = *(const f32x4*)(bias + colg + bj * 128 + 4 * n);
        if (u.pn < 9) {
            const int lane = fr + 16 * fq;
            PG8_LAS unsigned char* T = tr + (wr * 4 + wc) * 2048;
            const int colw = u.pn * 256 + wc * 32, roww = u.pm * 256 + wr * 64;
#pragma unroll
            for (int ai = 0; ai < 2; ++ai)
#pragma unroll
                for (int mp = 0; mp < 2; ++mp)
#pragma unroll
                    for (int bj = 0; bj < 2; ++bj) {
#pragma unroll
                        for (int mm = 0; mm < 2; ++mm)
#pragma unroll
                            for (int n = 0; n < 2; ++n) { const f32x4 v = acc[ai][bj][2 * mp + mm][n] + bv[bj][n];
#pragma unroll
                                for (int j = 0; j < 4; ++j) *(PG8_LAS u16*)(T + (8 * fq + 4 * n + j) * 64 + (16 * mm + fr) * 2) = f2bf(v[j]); }
                        asm volatile("s_waitcnt lgkmcnt(0)" ::: "memory");
                        const u32x4 w0 = *(PG8_LAS const u32x4*)(T + (lane >> 1) * 64 + (lane & 1) * 32), w1 = *(PG8_LAS const u32x4*)(T + (lane >> 1) * 64 + (lane & 1) * 32 + 16);
                        u16* dst = hyt + (size_t)(colw + bj * 128 + (lane >> 1)) * MTOK + roww + ai * 128 + 32 * mp + 16 * (lane & 1);
                        __builtin_nontemporal_store(w0, (u32x4*)dst); __builtin_nontemporal_store(w1, (u32x4*)(dst + 8));
                        asm volatile("" ::: "memory");
                    }
            return;
        }
        if (u.pn < 12) store_rm<1>(acc, bv, hyg, HYW, row0, colg - 2304);
        else if (u.pn < 30) store_rm<0>(acc, bv, qkv, NQKV, row0, colg - 3072);
        else store_rm<1>(acc, bv, atg, ATW, row0, colg - 7680);
    }
};
struct EpiSig {
    static constexpr bool PERM = true, AFTER_DRAIN = false;
    u16* sg; const float* bias;
    __device__ __forceinline__ void operator()(const f32x4 (&acc)[2][2][4][2], const pg8::Unit& u, int wr, int wc, int fr, int fq) const {
        const int row0 = u.pm * 256 + wr * 64 + fr, col0 = u.pn * 256 + wc * 32 + 8 * fq;
        f32x4 bv[2][2];
#pragma unroll
        for (int bj = 0; bj < 2; ++bj)
#pragma unroll
            for (int n = 0; n < 2; ++n) bv[bj][n] = *(const f32x4*)(bias + col0 + bj * 128 + 4 * n);
#pragma unroll
        for (int ai = 0; ai < 2; ++ai)
#pragma unroll
            for (int m = 0; m < 4; ++m) { u16* rowp = sg + (size_t)(row0 + ai * 128 + m * 16) * DM + col0;
#pragma unroll
                for (int bj = 0; bj < 2; ++bj) { f32x4 v0 = acc[ai][bj][m][0] + bv[bj][0], v1 = acc[ai][bj][m][1] + bv[bj][1];
#pragma unroll
                    for (int j = 0; j < 4; ++j) { v0[j] = sigmoidf_(v0[j]); v1[j] = sigmoidf_(v1[j]); }
                    u32x4 w; w.x = pk2(v0[0], v0[1]); w.y = pk2(v0[2], v0[3]); w.z = pk2(v1[0], v1[1]); w.w = pk2(v1[2], v1[3]);
                    *(u32x4*)(rowp + bj * 128) = w; } }
    }
};
template <int MODE  > struct EpiGate {
    static constexpr bool PERM = true, AFTER_DRAIN = false;
    const u16* sg; u16* tmp; u16* mrg;
    __device__ __forceinline__ void operator()(const f32x4 (&acc)[2][2][4][2], const pg8::Unit& u, int wr, int wc, int fr, int fq) const {
        const int row0 = u.pm * 256 + wr * 64 + fr, col0 = u.pn * 256 + wc * 32 + 8 * fq;
#pragma unroll
        for (int ai = 0; ai < 2; ++ai)
#pragma unroll
            for (int m = 0; m < 4; ++m) { const size_t off = (size_t)(row0 + ai * 128 + m * 16) * DM + col0;
#pragma unroll
                for (int bj = 0; bj < 2; ++bj) { const u32x4 s = *(const u32x4*)(sg + off + bj * 128);
                    f32x4 v0 = acc[ai][bj][m][0], v1 = acc[ai][bj][m][1];
                    v0[0] *= bflo(s.x); v0[1] *= bfhi(s.x); v0[2] *= bflo(s.y); v0[3] *= bfhi(s.y); v1[0] *= bflo(s.z); v1[1] *= bfhi(s.z); v1[2] *= bflo(s.w); v1[3] *= bfhi(s.w);
                    if (MODE == 1) { const u32x4 t = *(const u32x4*)(tmp + off + bj * 128);
                        v0[0] += bflo(t.x); v0[1] += bfhi(t.x); v0[2] += bflo(t.y); v0[3] += bfhi(t.y); v1[0] += bflo(t.z); v1[1] += bfhi(t.z); v1[2] += bflo(t.w); v1[3] += bfhi(t.w); }
                    u32x4 w; w.x = pk2(v0[0], v0[1]); w.y = pk2(v0[2], v0[3]); w.z = pk2(v1[0], v1[1]); w.w = pk2(v1[2], v1[3]);
                    *(u32x4*)((MODE == 0 ? tmp : mrg) + off + bj * 128) = w; } }
    }
};
struct EpiOut {
    static constexpr bool PERM = true, AFTER_DRAIN = false;
    const float* x; float* out;
    __device__ __forceinline__ void operator()(const f32x4 (&acc)[2][2][4][2], const pg8::Unit& u, int wr, int wc, int fr, int fq) const {
        const int row0 = u.pm * 256 + wr * 64 + fr, col0 = u.pn * 256 + wc * 32 + 8 * fq;
#pragma unroll
        for (int ai = 0; ai < 2; ++ai) {
            f32x4 xv[4][2][2];
#pragma unroll
            for (int m = 0; m < 4; ++m) { const size_t off = (size_t)(row0 + ai * 128 + m * 16) * DM + col0;
#pragma unroll
                for (int bj = 0; bj < 2; ++bj) { xv[m][bj][0] = *(const f32x4*)(x + off + bj * 128); xv[m][bj][1] = *(const f32x4*)(x + off + bj * 128 + 4); } }
            __builtin_amdgcn_sched_barrier(0);
#pragma unroll
            for (int m = 0; m < 4; ++m) { const size_t off = (size_t)(row0 + ai * 128 + m * 16) * DM + col0;
#pragma unroll
                for (int bj = 0; bj < 2; ++bj) { *(f32x4*)(out + off + bj * 128) = xv[m][bj][0] + acc[ai][bj][m][0]; *(f32x4*)(out + off + bj * 128 + 4) = xv[m][bj][1] + acc[ai][bj][m][1]; } }
            __builtin_amdgcn_sched_barrier(0);
        }
    }
};

typedef pg8::bf16x8 bf16x8;
__device__ __forceinline__ void load_conv(const u16* grow, float w0, float w1, float w2, float cb, u16* dst, int tid) {
#pragma unroll 2
    for (int k = 0; k < 8; ++k) { const int chunk = tid + 512 * k, b = chunk >> 8, t8 = (chunk & 255) * 8; const u16* p = grow + b * SEQ + t8;
        const u32x4 wq = __builtin_nontemporal_load((const u32x4*)p); const uint4 w = (uint4){wq.x, wq.y, wq.z, wq.w}; const float pm = t8 > 0 ? bf2f(p[-1]) : 0.f, pn = t8 + 8 < SEQ ? bf2f(p[8]) : 0.f;
        const float e0 = bflo(w.x), e1 = bfhi(w.x), e2 = bflo(w.y), e3 = bfhi(w.y), e4 = bflo(w.z), e5 = bfhi(w.z), e6 = bflo(w.w), e7 = bfhi(w.w);
        uint4 r; r.x = pk2(cb + w0 * pm + w1 * e0 + w2 * e1, cb + w0 * e0 + w1 * e1 + w2 * e2); r.y = pk2(cb + w0 * e1 + w1 * e2 + w2 * e3, cb + w0 * e2 + w1 * e3 + w2 * e4);
        r.z = pk2(cb + w0 * e3 + w1 * e4 + w2 * e5, cb + w0 * e4 + w1 * e5 + w2 * e6); r.w = pk2(cb + w0 * e5 + w1 * e6 + w2 * e7, cb + w0 * e6 + w1 * e7 + w2 * pn);
        *(uint4*)(dst + b * UP + t8) = r; }
}
__device__ __forceinline__ void build_kr(const u16* kb, u16* KR, int tid) {
#pragma unroll
    for (int k = 0; k < 8; ++k) { const int ch = tid + 512 * k, sg = ch >> 9, x8 = (ch & 511) * 8;
        u32x4u w = (u32x4u){0u, 0u, 0u, 0u};
        if (x8 != 0) w = *(const u32x4u*)(kb + x8 - sg);
        *(uint4*)(KR + sg * KRP + x8) = (uint4){w.x, w.y, w.z, w.w}; }
}
__device__ __forceinline__ void conv_mfma(PG8_LAS const unsigned char* KRb, PG8_LAS const unsigned char* Ub, int wid, int lane, f32x4 (&acc)[16]) {
    const int i = lane & 15, q = lane >> 4, T0 = wid * 16;
    const int abase = (i & 7) * (KRP * 2) + (8 * (q - (i >> 3)) + 2048) * 2;
    const int bbase = i * (UP * 2) + 16 * q;
#pragma unroll
    for (int t = 0; t < 16; ++t) acc[t] = (f32x4){0.f, 0.f, 0.f, 0.f};
#pragma unroll 1
    for (int sr = 0; sr < 4; ++sr) {
        const int S0 = sr * 16;
        bf16x8 Bf[16];
#pragma unroll
        for (int sl = 0; sl < 16; ++sl) Bf[sl] = *(PG8_LAS const bf16x8*)(Ub + bbase + 64 * (S0 + sl));
        PG8_LAS const unsigned char* ap = KRb + (abase - 32 * (T0 - 2 * S0) - 480);
#pragma unroll
        for (int dl = -30; dl <= 15; ++dl) {
            const bf16x8 a = *(PG8_LAS const bf16x8*)(ap + 32 * (15 - dl));
#pragma unroll
            for (int sl = 0; sl < 16; ++sl) { const int t = dl + 2 * sl; if (t >= 0 && t < 16) acc[t] = __builtin_amdgcn_mfma_f32_16x16x32_bf16(a, Bf[sl], acc[t], 0, 0, 0); }
        }
    }
}
__device__ __forceinline__ void hy_epilogue(const f32x4 (&acc)[16], const u16* X, u16* U, float skip, int wid, int lane) {
    const int b = lane & 15, q = lane >> 4;
#pragma unroll
    for (int tl = 0; tl < 16; ++tl) { const int t = 16 * (wid * 16 + tl) + 4 * q;
        const uint2 xv = *(const uint2*)(X + b * UP + t), uv = *(const uint2*)(U + b * UP + t); uint2 r;
        r.x = pk2(bflo(xv.x) * (acc[tl][0] + bflo(uv.x) * skip), bfhi(xv.x) * (acc[tl][1] + bfhi(uv.x) * skip));
        r.y = pk2(bflo(xv.y) * (acc[tl][2] + bflo(uv.y) * skip), bfhi(xv.y) * (acc[tl][3] + bfhi(uv.y) * skip));
        *(uint2*)(U + b * UP + t) = r; }
}
__device__ __forceinline__ unsigned touch64k(const u16* blk, int tid) { return *(const unsigned*)(blk + tid * 64); }
__device__ void hyena_mfma(const Frame& F, unsigned char* lds, bool do_store = true) {
    int tid = threadIdx.x; asm volatile("" : "+v"(tid));
    const int lane = tid & 63, wid = __builtin_amdgcn_readfirstlane(tid >> 6);
    u16* KR = (u16*)lds; u16* U = (u16*)(lds + 8 * KRP * 2);
    PG8_LAS const unsigned char* KRb = (PG8_LAS const unsigned char*)lds; PG8_LAS const unsigned char* Ub = KRb + 8 * KRP * 2;
    const u16* KB = (const u16*)(F.dob + DO_HF);
    u16* HYT = (u16*)(F.ws + WS_HYT);
    for (int c = blockIdx.x; c < HYW; c += gridDim.x) {
        const float wv0 = F.conv_w[c], wv1 = F.conv_w[NHY + c], wv2 = F.conv_w[2 * NHY + c], cbv = F.conv_b[c];
        const float wa0 = F.conv_w[HYW + c], wa1 = F.conv_w[NHY + HYW + c], wa2 = F.conv_w[2 * NHY + HYW + c], cba = F.conv_b[HYW + c];
        const float wb0 = F.conv_w[2 * HYW + c], wb1 = F.conv_w[NHY + 2 * HYW + c], wb2 = F.conv_w[2 * NHY + 2 * HYW + c], cbb = F.conv_b[2 * HYW + c];
        const float skip0 = F.skip[c], skip1 = F.skip[HYW + c];
        f32x4 acc[16];
        __syncthreads();
        load_conv(HYT + (size_t)c * MTOK, wv0, wv1, wv2, cbv, U, tid);
        build_kr(KB + (size_t)(0 * HYW + c) * KBL, KR, tid);
        unsigned tc0 = touch64k(HYT + (size_t)(HYW + c) * MTOK, tid), tc1 = tid < 65 ? touch64k(KB + (size_t)(HYW + c) * KBL, tid) : 0u;
        __syncthreads();
        conv_mfma(KRb, Ub, wid, lane, acc);
        asm volatile("" :: "v"(tc0), "v"(tc1));
        __syncthreads();
        load_conv(HYT + (size_t)(HYW + c) * MTOK, wa0, wa1, wa2, cba, KR, tid);
        __syncthreads();
        hy_epilogue(acc, KR, U, skip0, wid, lane);
        __syncthreads();
        build_kr(KB + (size_t)(1 * HYW + c) * KBL, KR, tid);
        { const int cn = c + (int)gridDim.x < HYW ? c + (int)gridDim.x : c;
          tc0 = touch64k(HYT + (size_t)(2 * HYW + c) * MTOK, tid); tc1 = touch64k(HYT + (size_t)cn * MTOK, tid); }
        __syncthreads();
        conv_mfma(KRb, Ub, wid, lane, acc);
        asm volatile("" :: "v"(tc0), "v"(tc1));
        __syncthreads();
        load_conv(HYT + (size_t)(2 * HYW + c) * MTOK, wb0, wb1, wb2, cbb, KR, tid);
        __syncthreads();
        hy_epilogue(acc, KR, U, skip1, wid, lane);
        __syncthreads();
        if (do_store)
#pragma unroll 2
        for (int k = 0; k < 8; ++k) { const int chunk = tid + 512 * k, b = chunk >> 8, t8 = (chunk & 255) * 8;
            __builtin_nontemporal_store(*(const u32x4*)(U + b * UP + t8), (u32x4*)(HYT + (size_t)c * MTOK + b * SEQ + t8)); }
    }
    __syncthreads();
}

constexpr size_t DO_LG = 111 * MiB;
__device__ __forceinline__ uint4 pk8(const float (&v)[8]) { uint4 r; r.x = pk2(v[0], v[1]); r.y = pk2(v[2], v[3]); r.z = pk2(v[4], v[5]); r.w = pk2(v[6], v[7]); return r; }
__device__ __forceinline__ void up8(const uint4 w, float (&v)[8]) { v[0] = bflo(w.x); v[1] = bfhi(w.x); v[2] = bflo(w.y); v[3] = bfhi(w.y); v[4] = bflo(w.z); v[5] = bfhi(w.z); v[6] = bflo(w.w); v[7] = bfhi(w.w); }
__device__ __forceinline__ bf16x8 as_frag(const uint4 w) { union { uint4 u; bf16x8 f; } c; c.u = w; return c.f; }
struct AChunk { uint4 k[2][2]; uint4 v[4]; };
typedef short s16x4 __attribute__((ext_vector_type(4)));
__device__ void attn_mfma(const Frame& F, unsigned char* lds, bool do_store = true) {
    int tid = threadIdx.x; asm volatile("" : "+v"(tid));
    const int lane = tid & 63, wid = __builtin_amdgcn_readfirstlane(tid >> 6), c16 = lane & 15, q = lane >> 4;
    u16* QKV = (u16*)(F.ws + WS_QKV); float* LG = (float*)(F.dob + DO_LG);
    unsigned char* Vs = lds + wid * 5120;
    PG8_LAS const unsigned char* Vs3 = (PG8_LAS const unsigned char*)Vs;
    const int krow_off = 8 * (c16 >> 2) + (c16 & 3);
    const int tr_off = (8 * q + (c16 >> 2)) * 144 + 8 * (lane & 3);
    const float LOG2E = 1.4426950408889634f;
    float gm = fabsf(F.qg[lane] * F.kg[lane]);
#pragma unroll
    for (int o = 32; o >= 1; o >>= 1) gm = fmaxf(gm, __shfl_xor(gm, o));
    const float cmax2 = 8.0f * gm * LOG2E;
    volatile PG8_LAS float* gqt = (volatile PG8_LAS float*)((PG8_LAS unsigned char*)lds + 8 * 5120);
    __syncthreads();
    if (tid < 64) gqt[tid] = F.qg[tid] * F.kg[tid] * (0.125f * LOG2E);
    __syncthreads();
    for (int item = blockIdx.x * 8 + wid; item < NB * 8 * 3 * 32; item += gridDim.x * 8) {
        const int blk = item & 31, rest = item >> 5, g = rest % 3, bh = rest / 3, h = bh & 7, b = bh >> 3;
        const int dsh = 2 * g, n = SEQ >> dsh, nbn = 32 >> dsh, r = blk >> (5 - dsh), nb = blk & (nbn - 1);
        const float ca2 = exp2f(-(float)(h + 1)) * (float)(1 << dsh) * LOG2E;
        const size_t colq = (size_t)g * 512 + h * 64;
        const u16* base = QKV + (size_t)b * SEQ * NQKV;
        const int kc_lo = nb == 0 ? 2 : 0, kc_hi = nb == nbn - 1 ? 4 : 6;
        auto load_chunk = [&](AChunk& c, int j0c) {
#pragma unroll
            for (int kt = 0; kt < 2; ++kt) { int jk = j0c + 4 * kt + krow_off; jk = jk < 0 ? 0 : (jk > n - 1 ? n - 1 : jk);
                const u16* krow = base + (size_t)((jk << dsh) + r) * NQKV + 1536 + colq;
                c.k[kt][0] = *(const uint4*)(krow + 8 * q); c.k[kt][1] = *(const uint4*)(krow + 32 + 8 * q); }
            int jv = j0c + (lane >> 1); jv = jv < 0 ? 0 : (jv > n - 1 ? n - 1 : jv);
            const u16* vrow = base + (size_t)((jv << dsh) + r) * NQKV + 3072 + colq + 32 * (lane & 1);
#pragma unroll
            for (int v4 = 0; v4 < 4; ++v4) c.v[v4] = *(const uint4*)(vrow + 8 * v4);
        };
        AChunk cur;
        bf16x8 Qf[4][2];
#pragma unroll
        for (int qt = 0; qt < 4; ++qt) { const int i = 64 * nb + 16 * qt + c16; const u16* qrow = base + (size_t)((i << dsh) + r) * NQKV + colq;
            float v0[8], v1[8]; up8(*(const uint4*)(qrow + 8 * q), v0); up8(*(const uint4*)(qrow + 32 + 8 * q), v1);
            float ss = 0.f;
#pragma unroll
            for (int e = 0; e < 8; ++e) ss += v0[e] * v0[e] + v1[e] * v1[e];
            ss += __shfl_xor(ss, 16); ss += __shfl_xor(ss, 32);
            const float rq = rsqrtf(ss * (1.0f / 64.0f) + 1e-6f);
#pragma unroll
            for (int e = 0; e < 8; ++e) { v0[e] *= rq * gqt[8 * q + e]; v1[e] *= rq * gqt[32 + 8 * q + e]; }
            Qf[qt][0] = as_frag(pk8(v0)); Qf[qt][1] = as_frag(pk8(v1)); }
        f32x4 Oacc[4][4]; f32x4 Lacc[4];
#pragma unroll
        for (int dt = 0; dt < 4; ++dt)
#pragma unroll
            for (int qt = 0; qt < 4; ++qt) Oacc[dt][qt] = (f32x4){0.f, 0.f, 0.f, 0.f};
#pragma unroll
        for (int qt = 0; qt < 4; ++qt) Lacc[qt] = (f32x4){0.f, 0.f, 0.f, 0.f};
#pragma unroll 1
        for (int kc = kc_lo; kc < kc_hi; ++kc) {
            const int j0c = 64 * (nb - 1) + 32 * kc;
            load_chunk(cur, j0c);
            unsigned tch0 = 0, tch1 = 0;
            if (kc + 1 < kc_hi) {
                int jk = j0c + 32 + (lane >> 1); jk = jk < 0 ? 0 : (jk > n - 1 ? n - 1 : jk);
                const u16* rowp = base + (size_t)((jk << dsh) + r) * NQKV + colq + ((lane & 1) ? 3072 : 1536);
                tch0 = *(const unsigned*)rowp; }
            { unsigned char* dst = Vs + (lane >> 1) * 144 + (lane & 1) * 64;
#pragma unroll
              for (int v4 = 0; v4 < 4; ++v4) *(uint4*)(dst + 16 * v4) = cur.v[v4]; }
            bf16x8 kf[2][2];
#pragma unroll
            for (int kt = 0; kt < 2; ++kt) {
                float v0[8], v1[8]; up8(cur.k[kt][0], v0); up8(cur.k[kt][1], v1);
                float ss = 0.f;
#pragma unroll
                for (int e = 0; e < 8; ++e) ss += v0[e] * v0[e] + v1[e] * v1[e];
                ss += __shfl_xor(ss, 16); ss += __shfl_xor(ss, 32);
                const float rk = rsqrtf(ss * (1.0f / 64.0f) + 1e-6f);
#pragma unroll
                for (int e = 0; e < 8; ++e) { v0[e] *= rk; v1[e] *= rk; }
                kf[kt][0] = as_frag(pk8(v0)); kf[kt][1] = as_frag(pk8(v1)); }
            bf16x8 Pf[4];
            int rel0 = 64 + c16 - 8 * q - 32 * kc;
            asm volatile("" : "+v"(rel0));
            const float relf0 = (float)rel0;
            const bool edge = (kc < 2) || (kc > 3);
#pragma unroll
            for (int qt = 0; qt < 4; ++qt) { float p[8];
#pragma unroll
                for (int kt = 0; kt < 2; ++kt) { f32x4 z = (f32x4){-cmax2, -cmax2, -cmax2, -cmax2};
                    z = __builtin_amdgcn_mfma_f32_16x16x32_bf16(kf[kt][0], Qf[qt][0], z, 0, 0, 0);
                    z = __builtin_amdgcn_mfma_f32_16x16x32_bf16(kf[kt][1], Qf[qt][1], z, 0, 0, 0);
#pragma unroll
                    for (int j = 0; j < 4; ++j) { const float dist = fabsf(relf0 + (float)(16 * qt - 4 * kt - j));
                        const float pv = __builtin_amdgcn_exp2f(z[j] - ca2 * dist);
                        p[4 * kt + j] = (edge && dist > 64.0f) ? 0.f : pv; } }
                Pf[qt] = as_frag(pk8(p)); }
            asm volatile("" ::: "memory");
#pragma unroll
            for (int dt = 0; dt < 4; ++dt) {
                const s16x4 a0 = __builtin_amdgcn_ds_read_tr16_b64_v4i16((PG8_LAS s16x4*)(Vs3 + tr_off + 32 * dt));
                const s16x4 a1 = __builtin_amdgcn_ds_read_tr16_b64_v4i16((PG8_LAS s16x4*)(Vs3 + tr_off + 4 * 144 + 32 * dt));
                const bf16x8 vf = __builtin_shufflevector(a0, a1, 0, 1, 2, 3, 4, 5, 6, 7);
#pragma unroll
                for (int qt = 0; qt < 4; ++qt) Oacc[dt][qt] = __builtin_amdgcn_mfma_f32_16x16x32_bf16(vf, Pf[qt], Oacc[dt][qt], 0, 0, 0); }
            { const bf16x8 ones = (bf16x8){0x3F80, 0x3F80, 0x3F80, 0x3F80, 0x3F80, 0x3F80, 0x3F80, 0x3F80};
#pragma unroll
              for (int qt = 0; qt < 4; ++qt) Lacc[qt] = __builtin_amdgcn_mfma_f32_16x16x32_bf16(ones, Pf[qt], Lacc[qt], 0, 0, 0); }
            asm volatile("" :: "v"(tch0), "v"(tch1) : "memory");
        }
        if (do_store)
#pragma unroll
        for (int qt = 0; qt < 4; ++qt) { const int i = 64 * nb + 16 * qt + c16, tok = (i << dsh) + r;
            const float lt = Lacc[qt][0];
            u16* orow = QKV + (size_t)(b * SEQ + tok) * NQKV + colq;
#pragma unroll
            for (int dp = 0; dp < 2; ++dp) {
                const unsigned ax = pk2(Oacc[2 * dp][qt][0], Oacc[2 * dp][qt][1]), ay = pk2(Oacc[2 * dp][qt][2], Oacc[2 * dp][qt][3]);
                const unsigned bx = pk2(Oacc[2 * dp + 1][qt][0], Oacc[2 * dp + 1][qt][1]), by = pk2(Oacc[2 * dp + 1][qt][2], Oacc[2 * dp + 1][qt][3]);
                const auto r0 = __builtin_amdgcn_permlane16_swap(ax, bx, false, false);
                const auto r1 = __builtin_amdgcn_permlane16_swap(ay, by, false, false);
                const int doff = (q & 1) ? 16 * (2 * dp + 1) + 4 * (q - 1) : 16 * (2 * dp) + 4 * q;
                *(uint4*)(orow + doff) = make_uint4(r0[0], r1[0], r0[1], r1[1]); }
            if (q == 0) LG[((size_t)g * MTOK + b * SEQ + tok) * 8 + h] = lt; }
    }
    __syncthreads();
}
__device__ void attn_combine(const Frame& F) {
    const u16* QKV = (const u16*)(F.ws + WS_QKV); const float* LG = (const float*)(F.dob + DO_LG); u16* ATG = (u16*)(F.ws + WS_ATG);
    for (int idx = blockIdx.x * 512 + F.tid; idx < MTOK * 64; idx += gridDim.x * 512) {
        const int m = idx >> 6, cc = (idx & 63) * 8, h = cc >> 6;
        const float lt = LG[(size_t)m * 8 + h] + LG[((size_t)MTOK + m) * 8 + h] + LG[((size_t)2 * MTOK + m) * 8 + h];
        const u16* qrow = QKV + (size_t)m * NQKV + cc;
        float o0[8], o1[8], o2[8], gt[8]; up8(*(const uint4*)qrow, o0); up8(*(const uint4*)(qrow + 512), o1); up8(*(const uint4*)(qrow + 1024), o2);
        uint4* gp = (uint4*)(ATG + (size_t)m * ATW + cc); up8(*gp, gt);
        const float il = 1.0f / lt;
#pragma unroll
        for (int e = 0; e < 8; ++e) o0[e] = (o0[e] + o1[e] + o2[e]) * il * gt[e];
        *gp = pk8(o0);
    }
}

__device__ void p2b_transpose(const Frame& F, unsigned char* lds) {
    const int tid = F.tid; u16* tl = (u16*)lds;
    const u16* HYT = (const u16*)(F.ws + WS_HYT); const u16* HYG = (const u16*)(F.ws + WS_HYG); u16* YH = (u16*)(F.ws + WS_YH);
    for (int tile = blockIdx.x; tile < 12 * 512; tile += gridDim.x) {
        const int c0 = (tile % 12) * 64, m0 = (tile / 12) * 64;
        const int cl = tid >> 3, mc = (tid & 7) * 8;
        const u32x4 wq = __builtin_nontemporal_load((const u32x4*)(HYT + (size_t)(c0 + cl) * MTOK + m0 + mc)); const uint4 w = (uint4){wq.x, wq.y, wq.z, wq.w};
        tl[(mc + 0) * 72 + cl] = (u16)(w.x & 0xffff); tl[(mc + 1) * 72 + cl] = (u16)(w.x >> 16); tl[(mc + 2) * 72 + cl] = (u16)(w.y & 0xffff); tl[(mc + 3) * 72 + cl] = (u16)(w.y >> 16);
        tl[(mc + 4) * 72 + cl] = (u16)(w.z & 0xffff); tl[(mc + 5) * 72 + cl] = (u16)(w.z >> 16); tl[(mc + 6) * 72 + cl] = (u16)(w.w & 0xffff); tl[(mc + 7) * 72 + cl] = (u16)(w.w >> 16);
        __syncthreads();
        const int ml = tid >> 3, cc = (tid & 7) * 8;
        const uint4 y = *(const uint4*)&tl[ml * 72 + cc]; const uint4 g = *(const uint4*)(HYG + (size_t)(m0 + ml) * HYW + c0 + cc);
        uint4 r; r.x = pk2(bflo(y.x) * bflo(g.x), bfhi(y.x) * bfhi(g.x)); r.y = pk2(bflo(y.y) * bflo(g.y), bfhi(y.y) * bfhi(g.y));
        r.z = pk2(bflo(y.z) * bflo(g.z), bfhi(y.z) * bfhi(g.z)); r.w = pk2(bflo(y.w) * bflo(g.w), bfhi(y.w) * bfhi(g.w));
        __builtin_nontemporal_store((u32x4){r.x, r.y, r.z, r.w}, (u32x4*)(YH + (size_t)(m0 + ml) * HYW + c0 + cc));
        __syncthreads();
    }
    transpose_weight(F.w_out, DM, DM, (u16*)(F.ws + WS_WOUT), tl, tid);
}


__device__ unsigned g_bar[8 * 64 + 64 + 8 * 64];
__device__ __forceinline__ unsigned gb_ld(unsigned* p) { return __hip_atomic_load(p, __ATOMIC_RELAXED, __HIP_MEMORY_SCOPE_AGENT); }
__device__ __forceinline__ unsigned gb_add(unsigned* p) { return __hip_atomic_fetch_add(p, 1u, __ATOMIC_RELAXED, __HIP_MEMORY_SCOPE_AGENT); }
__device__ __forceinline__ void grid_bar() {
    asm volatile("s_waitcnt vmcnt(0) lgkmcnt(0)" ::: "memory");
    __syncthreads();
    if (threadIdx.x == 0) {
        __builtin_amdgcn_fence(__ATOMIC_RELEASE, "agent");
        asm volatile("s_waitcnt vmcnt(0)" ::: "memory");
        const unsigned G = gridDim.x, ng = (G % 8u == 0u) ? 8u : 1u, n = G / ng, g = blockIdx.x % ng;
        const unsigned old = gb_add(&g_bar[g * 64]), gen = old / n;
        if (old % n == n - 1u) {
            const unsigned t = gb_add(&g_bar[512]), want = (t / ng + 1u) * ng;
            while ((int)(gb_ld(&g_bar[512]) - want) < 0) __builtin_amdgcn_s_sleep(10);
            gb_add(&g_bar[576 + g * 64]);
        } else {
            while ((int)(gb_ld(&g_bar[576 + g * 64]) - (gen + 1u)) < 0) __builtin_amdgcn_s_sleep(40);
        }
        __builtin_amdgcn_fence(__ATOMIC_ACQUIRE, "agent");
        asm volatile("s_waitcnt vmcnt(0)" ::: "memory");
    }
    __syncthreads();
}

__global__ void __launch_bounds__(512) mk_fwd(Args args) {
    extern __shared__ __attribute__((aligned(16))) unsigned char lds[];
    cg::grid_group grid = cg::this_grid();
    Frame F;
    F.x = args.in[0]; F.norm_g = args.in[1]; F.w_in = args.in[2]; F.b_in = args.in[3]; F.conv_w = args.in[4]; F.conv_b = args.in[5];
    F.w1 = args.in[6]; F.b1 = args.in[7]; F.w2 = args.in[8]; F.b2 = args.in[9]; F.w3 = args.in[10]; F.b3 = args.in[11]; F.w4 = args.in[12]; F.freq = args.in[13];
    F.skip = args.in[14]; F.qg = args.in[15]; F.kg = args.in[16]; F.w_hy = args.in[17]; F.w_at = args.in[18]; F.w_out = args.in[19];
    F.out = args.out; F.ws = args.ws; F.dob = (unsigned char*)args.out;
    F.tid = threadIdx.x; F.lane = F.tid & 63; F.wid = __builtin_amdgcn_readfirstlane(F.tid >> 6);
    const int lo = args.ph_lo, hi = args.ph_hi;
    PG8_LAS unsigned char* ldsa = (PG8_LAS unsigned char*)lds;
    const int G = gridDim.x, c = blockIdx.x;
#ifdef ONLY
#define IN(k) ((k) == ONLY && lo <= (k) && (k) < hi)
#elif defined(SKIP)
#define IN(k) ((k) != SKIP && lo <= (k) && (k) < hi)
#else
#define IN(k) (lo <= (k) && (k) < hi)
#endif
#define SEAM(k) do { if (IN(k) && IN((k) + 1)) { if (hi > 100) grid.sync(); else grid_bar(); } } while (0)
#ifdef REPEAT
#define NREP(k) ((k) == REPEAT ? 2 : 1)
#else
#define NREP(k) 1
#endif
    if (IN(0)) for (int rep = 0; rep < NREP(0); ++rep) p0_prologue(F, lds);
    SEAM(0);
    if (IN(1)) for (int rep = 0; rep < NREP(1); ++rep) {
        pg8::Gemm g{(const u16*)(F.dob + DO_XN), (const u16*)(F.dob + DO_WIN), MTOK, 8192, DM}; pg8::StaticOrder S; S.init(MTOK, 8192, G, c);
        Epi1 E{(u16*)(F.ws + WS_HYT), (u16*)(F.ws + WS_QKV), (u16*)(F.ws + WS_HYG), (u16*)(F.ws + WS_ATG), F.b_in, ldsa + 131072};
        pg8::gemm_phase<Epi1, pg8::StaticOrder>(ldsa, g, S, E, nullptr);
    }
    SEAM(1);
    if (IN(2)) {
#if defined(REPEAT) && REPEAT == 2
        hyena_mfma(F, lds, hi > 100);
#endif
        hyena_mfma(F, lds);
#if defined(REPEAT) && REPEAT == 6
        attn_mfma(F, lds, hi > 100);
#endif
        attn_mfma(F, lds);
#if defined(REPEAT) && REPEAT == 7
        for (int k = 0; k < 5; ++k) grid.sync();
#endif
    }
    SEAM(2);
    if (IN(3)) { for (int rep = 0; rep < NREP(3); ++rep) p2b_transpose(F, lds); attn_combine(F); }
    SEAM(3);
    if (IN(4)) for (int rep = 0; rep < NREP(4); ++rep) {
        pg8::StaticOrder S; S.init(MTOK, DM, G, c);
        { pg8::Gemm g{(const u16*)(F.dob + DO_XN), (const u16*)(F.dob + DO_WIN) + (size_t)8192 * DM, MTOK, DM, DM}; EpiSig E{(u16*)(F.ws + WS_SG), F.b_in + 8192};
          pg8::gemm_phase<EpiSig, pg8::StaticOrder>(ldsa, g, S, E, nullptr); }
        { pg8::Gemm g{(const u16*)(F.ws + WS_YH), (const u16*)(F.dob + DO_WHY), MTOK, DM, HYW}; EpiGate<0> E{(const u16*)(F.ws + WS_SG), (u16*)(F.ws + WS_TMP), nullptr};
          pg8::gemm_phase<EpiGate<0>, pg8::StaticOrder>(ldsa, g, S, E, nullptr); }
        { pg8::Gemm g{(const u16*)(F.dob + DO_XN), (const u16*)(F.dob + DO_WIN) + (size_t)9216 * DM, MTOK, DM, DM}; EpiSig E{(u16*)(F.ws + WS_SG), F.b_in + 9216};
          pg8::gemm_phase<EpiSig, pg8::StaticOrder>(ldsa, g, S, E, nullptr); }
        { pg8::Gemm g{(const u16*)(F.ws + WS_ATG), (const u16*)(F.dob + DO_WAT), MTOK, DM, ATW}; EpiGate<1> E{(const u16*)(F.ws + WS_SG), (u16*)(F.ws + WS_TMP), (u16*)(F.ws + WS_MRG)};
          pg8::gemm_phase<EpiGate<1>, pg8::StaticOrder>(ldsa, g, S, E, nullptr); }
    }
    SEAM(4);
    if (IN(5)) for (int rep = 0; rep < NREP(5); ++rep) {
        pg8::Gemm g{(const u16*)(F.ws + WS_MRG), (const u16*)(F.ws + WS_WOUT), MTOK, DM, DM}; pg8::StaticOrder S; S.init(MTOK, DM, G, c);
        EpiOut E{F.x, F.out};
        pg8::gemm_phase<EpiOut, pg8::StaticOrder>(ldsa, g, S, E, nullptr);
    }
#undef IN
#undef SEAM
}

extern "C" void kernel_launch(void* const* d_in, const int* in_sizes, int n_in, void* d_out, int out_size, void* d_ws, size_t ws_size, hipStream_t stream) {
    static int grid = 0;
    if (grid == 0) {
        if (n_in != 20 || out_size != MTOK * DM || ws_size < WS_END) { fprintf(stderr, "kernel_launch: unexpected shapes (n_in %d out %d ws %zu)\n", n_in, out_size, ws_size); grid = -1; return; }
        int dev = 0, cus = 0, per_cu = 0;
        hipGetDevice(&dev); hipDeviceGetAttribute(&cus, hipDeviceAttributeMultiprocessorCount, dev);
        if (hipFuncSetAttribute((const void*)mk_fwd, hipFuncAttributeMaxDynamicSharedMemorySize, LDS_BYTES) != hipSuccess) { fprintf(stderr, "kernel_launch: hipFuncSetAttribute failed\n"); grid = -1; return; }
        if (hipOccupancyMaxActiveBlocksPerMultiprocessor(&per_cu, (const void*)mk_fwd, 512, LDS_BYTES) != hipSuccess || per_cu < 1) { fprintf(stderr, "kernel_launch: occupancy query failed (%d)\n", per_cu); per_cu = 1; }
        (void)hipGetLastError();
        grid = cus;
        if (grid != 256) fprintf(stderr, "kernel_launch: note: %d CUs\n", grid);
    }
    if (grid < 0) return;
    Args a{};
    for (int i = 0; i < 20; ++i) a.in[i] = (const float*)d_in[i];
    a.out = (float*)d_out; a.ws = (unsigned char*)d_ws;
#if ONE_LAUNCH
    a.ph_lo = 0; a.ph_hi = 6;
    void* kargs[] = {&a};
    hipError_t e = hipLaunchCooperativeKernel((const void*)mk_fwd, dim3(grid), dim3(512), kargs, LDS_BYTES, stream);
    if (e != hipSuccess) fprintf(stderr, "cooperative launch failed: %s (grid %d)\n", hipGetErrorString(e), grid);
#else
    for (int ph = 0; ph < 6; ++ph) { a.ph_lo = ph; a.ph_hi = ph + 1; hipLaunchKernelGGL(mk_fwd, dim3(grid), dim3(512), LDS_BYTES, stream, a); }
#endif
}
```

```cpp
#include <hip/hip_runtime.h>
#include <hip/hip_cooperative_groups.h>
#include <cstdio>
namespace cg = cooperative_groups;
namespace pg8 {
#define PG8_LAS __attribute__((address_space(3)))
typedef unsigned short bf16_t;
typedef short bf16x8 __attribute__((ext_vector_type(8)));
typedef float f32x4 __attribute__((ext_vector_type(4)));
typedef unsigned u32x4 __attribute__((ext_vector_type(4)));
constexpr int BM = 256, BK = 64, HALF = 128, HTB = HALF * BK * 2  , STAGE_BYTES = 8 * HTB, NXCD = 8, WGM = 8;

__host__ __device__ __forceinline__ int lds_byte(int r, int c) { const int st = (r >> 4) * 2 + (c >> 5), rr = r & 15, cc = c & 31, ob = rr * 64 + cc * 2; return st * 1024 + (ob ^ (((ob >> 9) & 1) << 5)); }
__host__ __device__ __forceinline__ void stage_rc(int b, int& R, int& C) { const int st = b / 1024, sb = b % 1024, swz = sb ^ (((sb >> 9) & 1) << 5); R = (st >> 1) * 16 + swz / 64; C = (st & 1) * 32 + (swz % 64) / 2; }
__host__ __device__ __forceinline__ int perm32(int rho) { const int n = rho >> 4, i = rho & 15; return 8 * (i >> 2) + 4 * n + (i & 3); }

struct Unit { int pm, pn; };
struct Gemm { const bf16_t* A; const bf16_t* Bt; int M, N, K; };

struct StaticOrder {
    int nM, nN, nwg, G, c;
    __host__ __device__ void init(int M, int N, int G_, int c_) { nM = M / BM; nN = N / BM; nwg = nM * nN; G = G_; c = c_; }
    __host__ __device__ bool next(int i, Unit& u) const {
        const long L = (long)i * G + c; if (L >= nwg) return false;
        int wgid = (int)L; { const int q = nwg / NXCD, r = nwg % NXCD, xcd = wgid % NXCD, off = wgid / NXCD; wgid = (xcd < r ? xcd * (q + 1) : r * (q + 1) + (xcd - r) * q) + off; }
        const int nig = WGM * nN, gid = wgid / nig, fm = gid * WGM, gsz = (nM - fm) < WGM ? (nM - fm) : WGM;
        u.pm = fm + ((wgid % nig) % gsz); u.pn = (wgid % nig) / gsz; return true;
    }
    __device__ __forceinline__ void a_ready(const Unit&) const {}
    __device__ __forceinline__ void done(const Unit&) const {}
};
__device__ __forceinline__ unsigned cvt_pk_bf16(float lo, float hi) { unsigned r; asm volatile("v_cvt_pk_bf16_f32 %0, %1, %2" : "=v"(r) : "v"(lo), "v"(hi)); return r; }
typedef float f32x2 __attribute__((ext_vector_type(2)));
template <class Epi, class Sched, bool STAMP = false>
__device__ __forceinline__ void gemm_phase(PG8_LAS unsigned char* lds, const Gemm g, const Sched& S, const Epi& E, unsigned long long* stamps) {
    int tid_ = threadIdx.x; asm volatile("" : "+v"(tid_));
    const int tid = tid_, wid = __builtin_amdgcn_readfirstlane(tid >> 6), lane = tid & 63, wr = wid >> 2, wc = wid & 3, fr = lane & 15, fq = lane >> 4;
    const int K = g.K, nt = K / BK;
    int ts_lo = 0, ts_hi = 0, nts = 0; const unsigned long long rt_entry = STAMP ? (unsigned long long)wall_clock64() : 0ull;
#define PG8_STAMP() do { if (STAMP && wid == 0 && nts < 64) { const unsigned long long _c = (unsigned long long)clock64(); \
        ts_lo = (lane == nts) ? (int)(unsigned)_c : ts_lo; ts_hi = (lane == nts) ? (int)(unsigned)(_c >> 32) : ts_hi; ++nts; } } while (0)
    PG8_STAMP();
    unsigned voffA[2], voffB[2];
#pragma unroll
    for (int i = 0; i < 2; ++i) { int R, C; stage_rc(tid * 16 + i * 8192, R, C); const int Rb = Epi::PERM ? ((R & ~31) + perm32(R & 31)) : R;
        voffA[i] = (unsigned)(R * K + C) * 2u; voffB[i] = (unsigned)(Rb * K + C) * 2u; }
    const size_t kstep = (size_t)(BK * 2);
    const size_t hstep = (size_t)HALF * K * 2;
    const size_t tstep = 2 * hstep;
    const unsigned ldsw = (unsigned)wid * 1024u;
    const int aoff = lds_byte(wr * 64 + fr, fq * 8), boff = lds_byte(wc * 32 + fr, fq * 8);
#define PG8_SA(b, h) (((b) * 2 + (h)) * HTB)
#define PG8_SB(b, h) ((4 + (b) * 2 + (h)) * HTB)
#define PG8_STAGE(bufoff, gbase, voff) do { _Pragma("unroll") for (int _i = 0; _i < 2; ++_i) \
        __builtin_amdgcn_global_load_lds((const unsigned*)((const char*)(gbase) + (voff)[_i]), (PG8_LAS unsigned*)(lds + (bufoff) + ldsw + _i * 8192), 16, 0, 0); } while (0)
#define PG8_LDA(dst, b, h) do { _Pragma("unroll") for (int m = 0; m < 4; ++m) _Pragma("unroll") for (int k = 0; k < 2; ++k) dst[m][k] = *(const PG8_LAS bf16x8*)(lds + PG8_SA(b, h) + aoff + m * 2048 + k * 1024); } while (0)
#define PG8_LDB(dst, b, h) do { _Pragma("unroll") for (int n = 0; n < 2; ++n) _Pragma("unroll") for (int k = 0; k < 2; ++k) dst[n][k] = *(const PG8_LAS bf16x8*)(lds + PG8_SB(b, h) + boff + n * 2048 + k * 1024); } while (0)
#define PG8_MMA(ai, bj, At, Bt) do { __builtin_amdgcn_s_setprio(1); _Pragma("unroll") for (int m = 0; m < 4; ++m) _Pragma("unroll") for (int n = 0; n < 2; ++n) _Pragma("unroll") for (int k = 0; k < 2; ++k) \
        acc[ai][bj][m][n] = __builtin_amdgcn_mfma_f32_16x16x32_bf16(Bt[n][k], At[m][k], acc[ai][bj][m][n], 0, 0, 0); __builtin_amdgcn_s_setprio(0); } while (0)
#define PG8_WAIT_V(n) asm volatile("s_waitcnt vmcnt(" #n ")" ::: "memory")
#define PG8_WAIT_L(n) asm volatile("s_waitcnt lgkmcnt(" #n ")" ::: "memory")
#define PG8_BAR __builtin_amdgcn_s_barrier()
#define PG8_SCHED __builtin_amdgcn_sched_barrier(0)
    Unit cur, nxt; int ui = 0;
    if (!S.next(0, cur)) return;
    f32x4 acc[2][2][4][2];
#pragma unroll
    for (int a = 0; a < 2; ++a)
#pragma unroll
        for (int b = 0; b < 2; ++b)
#pragma unroll
            for (int m = 0; m < 4; ++m)
#pragma unroll
                for (int n = 0; n < 2; ++n) acc[a][b][m][n] = (f32x4){0.f, 0.f, 0.f, 0.f};
    bf16x8 At[4][2], B0[2][2], B1[2][2];
    const char* cA = (const char*)g.A + (size_t)cur.pm * tstep; const char* cB = (const char*)g.Bt + (size_t)cur.pn * tstep;
    S.a_ready(cur);
    PG8_STAGE(PG8_SB(0, 0), cB, voffB); PG8_STAGE(PG8_SA(0, 0), cA, voffA); PG8_STAGE(PG8_SB(0, 1), cB + hstep, voffB); PG8_STAGE(PG8_SA(0, 1), cA + hstep, voffA);
    if (wr == 1) PG8_BAR;
    PG8_WAIT_V(4); PG8_BAR;
    PG8_STAGE(PG8_SB(1, 0), cB + kstep, voffB); PG8_STAGE(PG8_SA(1, 0), cA + kstep, voffA); PG8_STAGE(PG8_SB(1, 1), cB + hstep + kstep, voffB);
    PG8_WAIT_V(6); PG8_BAR;
    PG8_STAMP();
    for (;;) {
        const bool has_next = S.next(ui + 1, nxt);
        const char* nA = has_next ? (const char*)g.A + (size_t)nxt.pm * tstep : cA; const char* nB = has_next ? (const char*)g.Bt + (size_t)nxt.pn * tstep : cB;
        for (int t = 0; t < nt; t += 2) {
            const bool last = (t == nt - 2);
            const char* a1 = cA + (size_t)(t + 1) * kstep;
            const char* a2 = last ? nA : cA + (size_t)(t + 2) * kstep; const char* b2 = last ? nB : cB + (size_t)(t + 2) * kstep;
            const char* a3 = a2 + kstep; const char* b3 = b2 + kstep;
            if (last && has_next) S.a_ready(nxt);
            PG8_LDB(B0, 0, 0); PG8_SCHED; PG8_LDA(At, 0, 0); PG8_STAGE(PG8_SA(1, 1), a1 + hstep, voffA);
            PG8_WAIT_L(8); PG8_BAR; PG8_WAIT_L(0); PG8_MMA(0, 0, At, B0); PG8_BAR; PG8_SCHED;
            PG8_LDB(B1, 0, 1); PG8_STAGE(PG8_SB(0, 0), b2, voffB);
            PG8_BAR; PG8_WAIT_L(0); PG8_MMA(0, 1, At, B1); PG8_BAR;
            PG8_LDA(At, 0, 1); PG8_STAGE(PG8_SA(0, 0), a2, voffA);
            PG8_BAR; PG8_WAIT_L(0); PG8_MMA(1, 0, At, B0); PG8_BAR; PG8_SCHED;
            PG8_STAGE(PG8_SB(0, 1), b2 + hstep, voffB);
            PG8_WAIT_V(6); PG8_BAR; PG8_MMA(1, 1, At, B1); PG8_BAR;
            PG8_LDB(B0, 1, 0); PG8_SCHED; PG8_LDA(At, 1, 0); PG8_STAGE(PG8_SA(0, 1), a2 + hstep, voffA);
            PG8_WAIT_L(8); PG8_BAR; PG8_WAIT_L(0); PG8_MMA(0, 0, At, B0); PG8_BAR; PG8_SCHED;
            PG8_LDB(B1, 1, 1); PG8_STAGE(PG8_SB(1, 0), b3, voffB);
            PG8_BAR; PG8_WAIT_L(0); PG8_MMA(0, 1, At, B1); PG8_BAR;
            PG8_LDA(At, 1, 1); PG8_STAGE(PG8_SA(1, 0), a3, voffA);
            PG8_BAR; PG8_WAIT_L(0); PG8_MMA(1, 0, At, B0); PG8_BAR; PG8_SCHED;
            PG8_STAGE(PG8_SB(1, 1), b3 + hstep, voffB);
            PG8_WAIT_V(6); PG8_BAR; PG8_MMA(1, 1, At, B1); PG8_BAR;
        }
        PG8_STAMP();
        if constexpr (!Epi::AFTER_DRAIN) { E(acc, cur, wr, wc, fr, fq); S.done(cur); }
        PG8_STAMP();
        if (!has_next) break;
#pragma unroll
        for (int a = 0; a < 2; ++a)
#pragma unroll
            for (int b = 0; b < 2; ++b)
#pragma unroll
                for (int m = 0; m < 4; ++m)
#pragma unroll
                    for (int n = 0; n < 2; ++n) acc[a][b][m][n] = (f32x4){0.f, 0.f, 0.f, 0.f};
        cur = nxt; cA = nA; cB = nB; ++ui;
    }
    PG8_WAIT_V(0);
    if (wr == 0) PG8_BAR;
    PG8_BAR;
    if constexpr (Epi::AFTER_DRAIN) { E.fused(acc, cur, wr, wc, fr, fq, lds, wid, lane); S.done(cur); }
    PG8_STAMP();
    if (STAMP && wid == 0) { stamps[lane] = lane < nts ? (((unsigned long long)(unsigned)ts_hi << 32) | (unsigned)ts_lo) : 0ull;
        if (lane == 62) stamps[62] = rt_entry; if (lane == 63) stamps[63] = (unsigned long long)wall_clock64(); }
#undef PG8_STAMP
#undef PG8_SA
#undef PG8_SB
#undef PG8_STAGE
#undef PG8_LDA
#undef PG8_LDB
#undef PG8_MMA
#undef PG8_WAIT_V
#undef PG8_WAIT_L
#undef PG8_BAR
#undef PG8_SCHED
}
}

#ifndef ONE_LAUNCH
#define ONE_LAUNCH 1
#endif
typedef unsigned short u16;
typedef pg8::f32x4 f32x4;
typedef pg8::u32x4 u32x4;
constexpr int MTOK = 32768, DM = 1024, SEQ = 2048, NB = 16, HYW = 768, NHY = 2304, NQKV = 4608, ATW = 512;
constexpr size_t MiB = 1024 * 1024;
constexpr size_t WS_HYT = 0;
constexpr size_t WS_QKV = 144 * MiB;
constexpr size_t WS_HYG = 432 * MiB;
constexpr size_t WS_ATG = 480 * MiB;
constexpr size_t WS_END = 512 * MiB;
constexpr size_t WS_YH = WS_HYT + 48 * MiB, WS_WOUT = WS_HYT + 96 * MiB;
constexpr size_t WS_SG = WS_QKV, WS_TMP = WS_QKV + 64 * MiB, WS_MRG = WS_QKV + 192 * MiB;
constexpr size_t DO_XN = 0, DO_WIN = 64 * MiB, DO_WHY = 84 * MiB, DO_WAT = DO_WHY + 1536 * 1024, DO_HF = 87 * MiB;
constexpr int LDS_BYTES = 144 * 1024;
constexpr int KBL = 4104;
constexpr int KRP = 4112;
constexpr int UP = 2056;

struct Args { const float* in[20]; float* out; unsigned char* ws; int ph_lo, ph_hi; };
struct Frame {
    const float *x, *norm_g, *w_in, *b_in, *conv_w, *conv_b, *w1, *b1, *w2, *b2, *w3, *b3, *w4, *freq, *skip, *qg, *kg, *w_hy, *w_at, *w_out;
    float* out; unsigned char* ws; unsigned char* dob;
    int tid, lane, wid;
};

__device__ __forceinline__ u16 f2bf(float f) { unsigned u = __float_as_uint(f); u += 0x7FFFu + ((u >> 16) & 1u); return (u16)(u >> 16); }
__device__ __forceinline__ float bf2f(u16 b) { return __uint_as_float(((unsigned)b) << 16); }
__device__ __forceinline__ float bflo(unsigned w) { return __uint_as_float(w << 16); }
__device__ __forceinline__ float bfhi(unsigned w) { return __uint_as_float(w & 0xffff0000u); }
typedef float f32x2v __attribute__((ext_vector_type(2)));
typedef __bf16 bf16x2v __attribute__((ext_vector_type(2)));
__device__ __forceinline__ unsigned pk2(float lo, float hi) { const f32x2v v = {lo, hi}; return __builtin_bit_cast(unsigned, __builtin_convertvector(v, bf16x2v)); }
__device__ __forceinline__ float sigmoidf_(float v) { return __builtin_amdgcn_rcpf(1.0f + __builtin_amdgcn_exp2f(-1.4426950408889634f * v)); }
__device__ __forceinline__ float siluf_(float v) { return v * __builtin_amdgcn_rcpf(1.0f + __builtin_amdgcn_exp2f(-1.4426950408889634f * v)); }

typedef unsigned u32x4u __attribute__((ext_vector_type(4), aligned(2)));
__device__ __forceinline__ void transpose_tile_f32(const float* src, int K, int N, u16* dst, int k0, int n0, u16* tile, int tid) {
    const int kl = tid >> 3, nc = (tid & 7) * 8;
    const float4* p = (const float4*)(src + (size_t)(k0 + kl) * N + n0 + nc);
    const float4* p2 = (const float4*)(src + (size_t)(k0 + 64 + kl) * N + n0 + nc);
    const float4 a = p[0], b = p[1], c = p2[0], d = p2[1];
    tile[(nc + 0) * 136 + kl] = f2bf(a.x); tile[(nc + 1) * 136 + kl] = f2bf(a.y); tile[(nc + 2) * 136 + kl] = f2bf(a.z); tile[(nc + 3) * 136 + kl] = f2bf(a.w);
    tile[(nc + 4) * 136 + kl] = f2bf(b.x); tile[(nc + 5) * 136 + kl] = f2bf(b.y); tile[(nc + 6) * 136 + kl] = f2bf(b.z); tile[(nc + 7) * 136 + kl] = f2bf(b.w);
    tile[(nc + 0) * 136 + 64 + kl] = f2bf(c.x); tile[(nc + 1) * 136 + 64 + kl] = f2bf(c.y); tile[(nc + 2) * 136 + 64 + kl] = f2bf(c.z); tile[(nc + 3) * 136 + 64 + kl] = f2bf(c.w);
    tile[(nc + 4) * 136 + 64 + kl] = f2bf(d.x); tile[(nc + 5) * 136 + 64 + kl] = f2bf(d.y); tile[(nc + 6) * 136 + 64 + kl] = f2bf(d.z); tile[(nc + 7) * 136 + 64 + kl] = f2bf(d.w);
    __syncthreads();
    const int nl = tid >> 3, kc = (tid & 7) * 16;
    const uint4 w0 = *(const uint4*)&tile[nl * 136 + kc], w1 = *(const uint4*)&tile[nl * 136 + kc + 8];
    uint4* dp = (uint4*)(dst + (size_t)(n0 + nl) * K + k0 + kc); dp[0] = w0; dp[1] = w1;
    __syncthreads();
}
__device__ void transpose_weight(const float* src, int K, int N, u16* dst, u16* tile, int tid) {
    const int nkt = K / 128, nnt = N / 64;
    for (int t = blockIdx.x; t < nkt * nnt; t += gridDim.x) transpose_tile_f32(src, K, N, dst, (t % nkt) * 128, (t / nkt) * 64, tile, tid);
}

__device__ __forceinline__ void bar4(PG8_LAS unsigned* cnt, unsigned& target, int lane) {
    asm volatile("s_waitcnt lgkmcnt(0)" ::: "memory");
    target += 4u;
    if (lane == 0) {
        __hip_atomic_fetch_add(cnt, 1u, __ATOMIC_RELAXED, __HIP_MEMORY_SCOPE_WORKGROUP);
        while (__hip_atomic_load(cnt, __ATOMIC_RELAXED, __HIP_MEMORY_SCOPE_WORKGROUP) < target) __builtin_amdgcn_s_sleep(1);
    }
    asm volatile("" ::: "memory");
}
__device__ void p0_prologue(const Frame& F, unsigned char* lds) {
    const int tid = F.tid, lane = F.lane, wid = F.wid;
    u16* tile = (u16*)lds;
    transpose_weight(F.w_in, DM, 10240, (u16*)(F.dob + DO_WIN), tile, tid);
    transpose_weight(F.w_hy, HYW, DM, (u16*)(F.dob + DO_WHY), tile, tid);
    transpose_weight(F.w_at, ATW, DM, (u16*)(F.dob + DO_WAT), tile, tid);
    PG8_LAS unsigned* cnt = (PG8_LAS unsigned*)((PG8_LAS unsigned char*)lds + 65536);
    __syncthreads();
    if (tid == 0) *(volatile PG8_LAS unsigned*)cnt = 0u;
    __syncthreads();
    if (wid >= 4) {
        u16* XN = (u16*)(F.dob + DO_XN);
        for (int row = (blockIdx.x * 4 + (wid - 4)) * 2; row < MTOK; row += gridDim.x * 8) {
            const float4* xr = (const float4*)(F.x + (size_t)row * DM);
            float4 v[8]; float s0 = 0.f, s1 = 0.f;
#pragma unroll
            for (int i = 0; i < 8; ++i) { const f32x4 t = __builtin_nontemporal_load((const f32x4*)xr + lane + 64 * i); v[i] = make_float4(t.x, t.y, t.z, t.w); }
#pragma unroll
            for (int i = 0; i < 4; ++i) { s0 += v[i].x * v[i].x + v[i].y * v[i].y + v[i].z * v[i].z + v[i].w * v[i].w;
                s1 += v[i + 4].x * v[i + 4].x + v[i + 4].y * v[i + 4].y + v[i + 4].z * v[i + 4].z + v[i + 4].w * v[i + 4].w; }
#pragma unroll
            for (int o = 32; o >= 1; o >>= 1) { s0 += __shfl_xor(s0, o); s1 += __shfl_xor(s1, o); }
            const float r0 = rsqrtf(s0 * (1.0f / DM) + 1e-6f), r1 = rsqrtf(s1 * (1.0f / DM) + 1e-6f);
#pragma unroll
            for (int i = 0; i < 4; ++i) { const float4 g = ((const float4*)F.norm_g)[lane + 64 * i];
                uint2 w; w.x = pk2(v[i].x * r0 * g.x, v[i].y * r0 * g.y); w.y = pk2(v[i].z * r0 * g.z, v[i].w * r0 * g.w);
                *(uint2*)(XN + (size_t)row * DM + 4 * (lane + 64 * i)) = w;
                uint2 w2; w2.x = pk2(v[i + 4].x * r1 * g.x, v[i + 4].y * r1 * g.y); w2.y = pk2(v[i + 4].z * r1 * g.z, v[i + 4].w * r1 * g.w);
                *(uint2*)(XN + (size_t)(row + 1) * DM + 4 * (lane + 64 * i)) = w2; }
        }
    } else {
        unsigned target = 0u;
        u16* KB = (u16*)(F.dob + DO_HF);
        float* zs = (float*)lds;
        float* ha = zs + 8 * 40;
        float* hb = ha + 8 * 64;
        float* ws1 = hb + 8 * 64;
        float* ws2 = ws1 + 33 * 64;
        float* ws3 = ws2 + 64 * 64;
        for (int e = tid; e < 33 * 16; e += 256) ((float4*)ws1)[e] = ((const float4*)F.w1)[e];
        for (int e = tid; e < 64 * 16; e += 256) { ((float4*)ws2)[e] = ((const float4*)F.w2)[e]; ((float4*)ws3)[e] = ((const float4*)F.w3)[e]; }
        for (int blk = blockIdx.x; blk < SEQ / 8; blk += gridDim.x) {
            const int t0 = blk * 8;
            bar4(cnt, target, lane);
            for (int e = tid; e < 8 * 33; e += 256) { const int p = e / 33, i = e % 33; const float tt = (float)(t0 + p);
                float val;
                if (i == 0) val = tt * (1.0f / 2047.0f);
                else { const int j = (i - 1) & 15; const float f = 1e-4f + (float)j * ((15.0f - 1e-4f) / 15.0f); const float w = 6.283185307179586f * tt * (1.0f / 2048.0f); const float a = f * w;
                    val = (i <= 16) ? cosf(a) : -sinf(a); }
                zs[p * 40 + i] = val; }
            bar4(cnt, target, lane);
            const int p0 = tid >> 6, j = tid & 63; const float fr = F.freq[j];
#pragma unroll 1
            for (int pp = p0; pp < 8; pp += 4) { float a = F.b1[j];
#pragma unroll 3
                for (int i = 0; i < 33; ++i) a += zs[pp * 40 + i] * ws1[i * 64 + j]; ha[pp * 64 + j] = sinf(fr * a); }
            bar4(cnt, target, lane);
#pragma unroll 1
            for (int pp = p0; pp < 8; pp += 4) { float a = F.b2[j];
#pragma unroll 4
                for (int i = 0; i < 64; ++i) a += ha[pp * 64 + i] * ws2[i * 64 + j]; hb[pp * 64 + j] = sinf(fr * a); }
            bar4(cnt, target, lane);
#pragma unroll 1
            for (int pp = p0; pp < 8; pp += 4) { float a = F.b3[j];
#pragma unroll 4
                for (int i = 0; i < 64; ++i) a += hb[pp * 64 + i] * ws3[i * 64 + j]; ha[pp * 64 + j] = sinf(fr * a); }
            bar4(cnt, target, lane);
#pragma unroll 1
            for (int col = tid; col < 3072; col += 256) {
                float acc[8];
#pragma unroll
                for (int q = 0; q < 8; ++q) acc[q] = 0.f;
                float wv[64];
#pragma unroll
                for (int k = 0; k < 64; ++k) wv[k] = F.w4[k * 3072 + col];
                int hoff = 0; asm volatile("" : "+v"(hoff));
#pragma unroll
                for (int k4 = 0; k4 < 16; ++k4)
#pragma unroll
                    for (int q = 0; q < 8; ++q) { const float4 h = *(const float4*)&ha[hoff + q * 64 + 4 * k4];
                        acc[q] += h.x * wv[4 * k4] + h.y * wv[4 * k4 + 1] + h.z * wv[4 * k4 + 2] + h.w * wv[4 * k4 + 3]; }
                const int o = col / 1536, d = (col % 1536) / 768, c = col % 768;
                const float dmin = 3.0701134573253944f, dmax = 15.350567286626972f;
                const float ad = dmin + (float)c * ((dmax - dmin) / 767.0f);
#pragma unroll
                for (int q = 0; q < 8; ++q) acc[q] *= expf(-((float)(t0 + q) * (1.0f / 2047.0f)) * ad);
                u16* kb = KB + (size_t)(o * HYW + c) * KBL;
                if (d == 0) { u32x4u w; w.x = pk2(acc[7], acc[6]); w.y = pk2(acc[5], acc[4]); w.z = pk2(acc[3], acc[2]); w.w = pk2(acc[1], acc[0]);
                    *(u32x4u*)(kb + 2041 - t0) = w;
                    if (t0 == 0) { kb[0] = 0;
#pragma unroll
                        for (int q = 0; q < 8; ++q) kb[4096 + q] = 0; } }
                else if (t0 > 0) { u32x4u w; w.x = pk2(acc[0], acc[1]); w.y = pk2(acc[2], acc[3]); w.z = pk2(acc[4], acc[5]); w.w = pk2(acc[6], acc[7]); *(u32x4u*)(kb + 2048 + t0) = w; }
                else {
#pragma unroll
                    for (int q = 1; q < 8; ++q) kb[2048 + q] = f2bf(acc[q]); }
            }
        }
    }
    __syncthreads();
}

template <int ACT> __device__ __forceinline__ void store_rm(const f32x4 (&acc)[2][2][4][2], const f32x4 (&bv)[2][2], u16* base, int ldc, int row0, int col0) {
#pragma unroll
    for (int ai = 0; ai < 2; ++ai)
#pragma unroll
        for (int m = 0; m < 4; ++m) { u16* rowp = base + (size_t)(row0 + ai * 128 + m * 16) * ldc + col0;
#pragma unroll
            for (int bj = 0; bj < 2; ++bj) { f32x4 v0 = acc[ai][bj][m][0] + bv[bj][0], v1 = acc[ai][bj][m][1] + bv[bj][1];
                if (ACT) {
#pragma unroll
                    for (int j = 0; j < 4; ++j) { v0[j] = siluf_(v0[j]); v1[j] = siluf_(v1[j]); } }
                u32x4 w; w.x = pk2(v0[0], v0[1]); w.y = pk2(v0[2], v0[3]); w.z = pk2(v1[0], v1[1]); w.w = pk2(v1[2], v1[3]);
                __builtin_nontemporal_store(w, (u32x4*)(rowp + bj * 128)); } }
}
struct Epi1 {
    static constexpr bool PERM = true, AFTER_DRAIN = false;
    u16 *hyt, *qkv, *hyg, *atg; const float* bias; PG8_LAS unsigned char* tr;
    __device__ __forceinline__ void operator()(const f32x4 (&acc)[2][2][4][2], const pg8::Unit& u, int wr, int wc, int fr, int fq) const {
        const int row0 = u.pm * 256 + wr * 64 + fr, colg = u.pn * 256 + wc * 32 + 8 * fq;
        f32x4 bv[2][2];
#pragma unroll
        for (int bj = 0; bj < 2; ++bj)
#pragma unroll
            for (int n = 0; n < 2; ++n) bv[bj][n] = *(const f32x4*)(bias + colg + bj * 128 + 4 * n);
        if (u.pn < 9) {
            const int lane = fr + 16 * fq;
            PG8_LAS unsigned char* T = tr + (wr * 4 + wc) * 2048;
            const int colw = u.pn * 256 + wc * 32, roww = u.pm * 256 + wr * 64;
#pragma unroll
            for (int ai = 0; ai < 2; ++ai)
#pragma unroll
                for (int mp = 0; mp < 2; ++mp)
#pragma unroll
                    for (int bj = 0; bj < 2; ++bj) {
#pragma unroll
                        for (int mm = 0; mm < 2; ++mm)
#pragma unroll
                            for (int n = 0; n < 2; ++n) { const f32x4 v = acc[ai][bj][2 * mp + mm][n] + bv[bj][n];
#pragma unroll
                                for (int j = 0; j < 4; ++j) *(PG8_LAS u16*)(T + (8 * fq + 4 * n + j) * 64 + (16 * mm + fr) * 2) = f2bf(v[j]); }
                        asm volatile("s_waitcnt lgkmcnt(0)" ::: "memory");
                        const u32x4 w0 = *(PG8_LAS const u32x4*)(T + (lane >> 1) * 64 + (lane & 1) * 32), w1 = *(PG8_LAS const u32x4*)(T + (lane >> 1) * 64 + (lane & 1) * 32 + 16);
                        u16* dst = hyt + (size_t)(colw + bj * 128 + (lane >> 1)) * MTOK + roww + ai * 128 + 32 * mp + 16 * (lane & 1);
                        __builtin_nontemporal_store(w0, (u32x4*)dst); __builtin_nontemporal_store(w1, (u32x4*)(dst + 8));
                        asm volatile("" ::: "memory");
                    }
            return;
        }
        if (u.pn < 12) store_rm<1>(acc, bv, hyg, HYW, row0, colg - 2304);
        else if (u.pn < 30) store_rm<0>(acc, bv, qkv, NQKV, row0, colg - 3072);
        else store_rm<1>(acc, bv, atg, ATW, row0, colg - 7680);
    }
};
struct EpiSig {
    static constexpr bool PERM = true, AFTER_DRAIN = false;
    u16* sg; const float* bias;
    __device__ __forceinline__ void operator()(const f32x4 (&acc)[2][2][4][2], const pg8::Unit& u, int wr, int wc, int fr, int fq) const {
        const int row0 = u.pm * 256 + wr * 64 + fr, col0 = u.pn * 256 + wc * 32 + 8 * fq;
        f32x4 bv[2][2];
#pragma unroll
        for (int bj = 0; bj < 2; ++bj)
#pragma unroll
            for (int n = 0; n < 2; ++n) bv[bj][n] = *(const f32x4*)(bias + col0 + bj * 128 + 4 * n);
#pragma unroll
        for (int ai = 0; ai < 2; ++ai)
#pragma unroll
            for (int m = 0; m < 4; ++m) { u16* rowp = sg + (size_t)(row0 + ai * 128 + m * 16) * DM + col0;
#pragma unroll
                for (int bj = 0; bj < 2; ++bj) { f32x4 v0 = acc[ai][bj][m][0] + bv[bj][0], v1 = acc[ai][bj][m][1] + bv[bj][1];
#pragma unroll
                    for (int j = 0; j < 4; ++j) { v0[j] = sigmoidf_(v0[j]); v1[j] = sigmoidf_(v1[j]); }
                    u32x4 w; w.x = pk2(v0[0], v0[1]); w.y = pk2(v0[2], v0[3]); w.z = pk2(v1[0], v1[1]); w.w = pk2(v1[2], v1[3]);
                    *(u32x4*)(rowp + bj * 128) = w; } }
    }
};
template <int MODE  > struct EpiGate {
    static constexpr bool PERM = true, AFTER_DRAIN = false;
    const u16* sg; u16* tmp; u16* mrg;
    __device__ __forceinline__ void operator()(const f32x4 (&acc)[2][2][4][2], const pg8::Unit& u, int wr, int wc, int fr, int fq) const {
        const int row0 = u.pm * 256 + wr * 64 + fr, col0 = u.pn * 256 + wc * 32 + 8 * fq;
#pragma unroll
        for (int ai = 0; ai < 2; ++ai)
#pragma unroll
            for (int m = 0; m < 4; ++m) { const size_t off = (size_t)(row0 + ai * 128 + m * 16) * DM + col0;
#pragma unroll
                for (int bj = 0; bj < 2; ++bj) { const u32x4 s = *(const u32x4*)(sg + off + bj * 128);
                    f32x4 v0 = acc[ai][bj][m][0], v1 = acc[ai][bj][m][1];
                    v0[0] *= bflo(s.x); v0[1] *= bfhi(s.x); v0[2] *= bflo(s.y); v0[3] *= bfhi(s.y); v1[0] *= bflo(s.z); v1[1] *= bfhi(s.z); v1[2] *= bflo(s.w); v1[3] *= bfhi(s.w);
                    if (MODE == 1) { const u32x4 t = *(const u32x4*)(tmp + off + bj * 128);
                        v0[0] += bflo(t.x); v0[1] += bfhi(t.x); v0[2] += bflo(t.y); v0[3] += bfhi(t.y); v1[0] += bflo(t.z); v1[1] += bfhi(t.z); v1[2] += bflo(t.w); v1[3] += bfhi(t.w); }
                    u32x4 w; w.x = pk2(v0[0], v0[1]); w.y = pk2(v0[2], v0[3]); w.z = pk2(v1[0], v1[1]); w.w = pk2(v1[2], v1[3]);
                    *(u32x4*)((MODE == 0 ? tmp : mrg) + off + bj * 128) = w; } }
    }
};
struct EpiOut {
    static constexpr bool PERM = true, AFTER_DRAIN = false;
    const float* x; float* out;
    __device__ __forceinline__ void operator()(const f32x4 (&acc)[2][2][4][2], const pg8::Unit& u, int wr, int wc, int fr, int fq) const {
        const int row0 = u.pm * 256 + wr * 64 + fr, col0 = u.pn * 256 + wc * 32 + 8 * fq;
#pragma unroll
        for (int ai = 0; ai < 2; ++ai) {
            f32x4 xv[4][2][2];
#pragma unroll
            for (int m = 0; m < 4; ++m) { const size_t off = (size_t)(row0 + ai * 128 + m * 16) * DM + col0;
#pragma unroll
                for (int bj = 0; bj < 2; ++bj) { xv[m][bj][0] = *(const f32x4*)(x + off + bj * 128); xv[m][bj][1] = *(const f32x4*)(x + off + bj * 128 + 4); } }
            __builtin_amdgcn_sched_barrier(0);
#pragma unroll
            for (int m = 0; m < 4; ++m) { const size_t off = (size_t)(row0 + ai * 128 + m * 16) * DM + col0;
#pragma unroll
                for (int bj = 0; bj < 2; ++bj) { *(f32x4*)(out + off + bj * 128) = xv[m][bj][0] + acc[ai][bj][m][0]; *(f32x4*)(out + off + bj * 128 + 4) = xv[m][bj][1] + acc[ai][bj][m][1]; } }
            __builtin_amdgcn_sched_barrier(0);
        }
    }
};

typedef pg8::bf16x8 bf16x8;
__device__ __forceinline__ void load_conv(const u16* grow, float w0, float w1, float w2, float cb, u16* dst, int tid) {
#pragma unroll 2
    for (int k = 0; k < 8; ++k) { const int chunk = tid + 512 * k, b = chunk >> 8, t8 = (chunk & 255) * 8; const u16* p = grow + b * SEQ + t8;
        const u32x4 wq = __builtin_nontemporal_load((const u32x4*)p); const uint4 w = (uint4){wq.x, wq.y, wq.z, wq.w}; const float pm = t8 > 0 ? bf2f(p[-1]) : 0.f, pn = t8 + 8 < SEQ ? bf2f(p[8]) : 0.f;
        const float e0 = bflo(w.x), e1 = bfhi(w.x), e2 = bflo(w.y), e3 = bfhi(w.y), e4 = bflo(w.z), e5 = bfhi(w.z), e6 = bflo(w.w), e7 = bfhi(w.w);
        uint4 r; r.x = pk2(cb + w0 * pm + w1 * e0 + w2 * e1, cb + w0 * e0 + w1 * e1 + w2 * e2); r.y = pk2(cb + w0 * e1 + w1 * e2 + w2 * e3, cb + w0 * e2 + w1 * e3 + w2 * e4);
        r.z = pk2(cb + w0 * e3 + w1 * e4 + w2 * e5, cb + w0 * e4 + w1 * e5 + w2 * e6); r.w = pk2(cb + w0 * e5 + w1 * e6 + w2 * e7, cb + w0 * e6 + w1 * e7 + w2 * pn);
        *(uint4*)(dst + b * UP + t8) = r; }
}
__device__ __forceinline__ void build_kr(const u16* kb, u16* KR, int tid) {
#pragma unroll
    for (int k = 0; k < 8; ++k) { const int ch = tid + 512 * k, sg = ch >> 9, x8 = (ch & 511) * 8;
        u32x4u w = (u32x4u){0u, 0u, 0u, 0u};
        if (x8 != 0) w = *(const u32x4u*)(kb + x8 - sg);
        *(uint4*)(KR + sg * KRP + x8) = (uint4){w.x, w.y, w.z, w.w}; }
}
__device__ __forceinline__ void conv_mfma(PG8_LAS const unsigned char* KRb, PG8_LAS const unsigned char* Ub, int wid, int lane, f32x4 (&acc)[16]) {
    const int i = lane & 15, q = lane >> 4, T0 = wid * 16;
    const int abase = (i & 7) * (KRP * 2) + (8 * (q - (i >> 3)) + 2048) * 2;
    const int bbase = i * (UP * 2) + 16 * q;
#pragma unroll
    for (int t = 0; t < 16; ++t) acc[t] = (f32x4){0.f, 0.f, 0.f, 0.f};
#pragma unroll 1
    for (int sr = 0; sr < 4; ++sr) {
        const int S0 = sr * 16;
        bf16x8 Bf[16];
#pragma unroll
        for (int sl = 0; sl < 16; ++sl) Bf[sl] = *(PG8_LAS const bf16x8*)(Ub + bbase + 64 * (S0 + sl));
        PG8_LAS const unsigned char* ap = KRb + (abase - 32 * (T0 - 2 * S0) - 480);
#pragma unroll
        for (int dl = -30; dl <= 15; ++dl) {
            const bf16x8 a = *(PG8_LAS const bf16x8*)(ap + 32 * (15 - dl));
#pragma unroll
            for (int sl = 0; sl < 16; ++sl) { const int t = dl + 2 * sl; if (t >= 0 && t < 16) acc[t] = __builtin_amdgcn_mfma_f32_16x16x32_bf16(a, Bf[sl], acc[t], 0, 0, 0); }
        }
    }
}
__device__ __forceinline__ void hy_epilogue(const f32x4 (&acc)[16], const u16* X, u16* U, float skip, int wid, int lane) {
    const int b = lane & 15, q = lane >> 4;
#pragma unroll
    for (int tl = 0; tl < 16; ++tl) { const int t = 16 * (wid * 16 + tl) + 4 * q;
        const uint2 xv = *(const uint2*)(X + b * UP + t), uv = *(const uint2*)(U + b * UP + t); uint2 r;
        r.x = pk2(bflo(xv.x) * (acc[tl][0] + bflo(uv.x) * skip), bfhi(xv.x) * (acc[tl][1] + bfhi(uv.x) * skip));
        r.y = pk2(bflo(xv.y) * (acc[tl][2] + bflo(uv.y) * skip), bfhi(xv.y) * (acc[tl][3] + bfhi(uv.y) * skip));
        *(uint2*)(U + b * UP + t) = r; }
}
__device__ __forceinline__ unsigned touch64k(const u16* blk, int tid) { return *(const unsigned*)(blk + tid * 64); }
__device__ void hyena_mfma(const Frame& F, unsigned char* lds, bool do_store = true) {
    int tid = threadIdx.x; asm volatile("" : "+v"(tid));
    const int lane = tid & 63, wid = __builtin_amdgcn_readfirstlane(tid >> 6);
    u16* KR = (u16*)lds; u16* U = (u16*)(lds + 8 * KRP * 2);
    PG8_LAS const unsigned char* KRb = (PG8_LAS const unsigned char*)lds; PG8_LAS const unsigned char* Ub = KRb + 8 * KRP * 2;
    const u16* KB = (const u16*)(F.dob + DO_HF);
    u16* HYT = (u16*)(F.ws + WS_HYT);
    for (int c = blockIdx.x; c < HYW; c += gridDim.x) {
        const float wv0 = F.conv_w[c], wv1 = F.conv_w[NHY + c], wv2 = F.conv_w[2 * NHY + c], cbv = F.conv_b[c];
        const float wa0 = F.conv_w[HYW + c], wa1 = F.conv_w[NHY + HYW + c], wa2 = F.conv_w[2 * NHY + HYW + c], cba = F.conv_b[HYW + c];
        const float wb0 = F.conv_w[2 * HYW + c], wb1 = F.conv_w[NHY + 2 * HYW + c], wb2 = F.conv_w[2 * NHY + 2 * HYW + c], cbb = F.conv_b[2 * HYW + c];
        const float skip0 = F.skip[c], skip1 = F.skip[HYW + c];
        f32x4 acc[16];
        __syncthreads();
        load_conv(HYT + (size_t)c * MTOK, wv0, wv1, wv2, cbv, U, tid);
        build_kr(KB + (size_t)(0 * HYW + c) * KBL, KR, tid);
        unsigned tc0 = touch64k(HYT + (size_t)(HYW + c) * MTOK, tid), tc1 = tid < 65 ? touch64k(KB + (size_t)(HYW + c) * KBL, tid) : 0u;
        __syncthreads();
        conv_mfma(KRb, Ub, wid, lane, acc);
        asm volatile("" :: "v"(tc0), "v"(tc1));
        __syncthreads();
        load_conv(HYT + (size_t)(HYW + c) * MTOK, wa0, wa1, wa2, cba, KR, tid);
        __syncthreads();
        hy_epilogue(acc, KR, U, skip0, wid, lane);
        __syncthreads();
        build_kr(KB + (size_t)(1 * HYW + c) * KBL, KR, tid);
        { const int cn = c + (int)gridDim.x < HYW ? c + (int)gridDim.x : c;
          tc0 = touch64k(HYT + (size_t)(2 * HYW + c) * MTOK, tid); tc1 = touch64k(HYT + (size_t)cn * MTOK, tid); }
        __syncthreads();
        conv_mfma(KRb, Ub, wid, lane, acc);
        asm volatile("" :: "v"(tc0), "v"(tc1));
        __syncthreads();
        load_conv(HYT + (size_t)(2 * HYW + c) * MTOK, wb0, wb1, wb2, cbb, KR, tid);
        __syncthreads();
        hy_epilogue(acc, KR, U, skip1, wid, lane);
        __syncthreads();
        if (do_store)
#pragma unroll 2
        for (int k = 0; k < 8; ++k) { const int chunk = tid + 512 * k, b = chunk >> 8, t8 = (chunk & 255) * 8;
            __builtin_nontemporal_store(*(const u32x4*)(U + b * UP + t8), (u32x4*)(HYT + (size_t)c * MTOK + b * SEQ + t8)); }
    }
    __syncthreads();
}

constexpr size_t DO_LG = 111 * MiB;
__device__ __forceinline__ uint4 pk8(const float (&v)[8]) { uint4 r; r.x = pk2(v[0], v[1]); r.y = pk2(v[2], v[3]); r.z = pk2(v[4], v[5]); r.w = pk2(v[6], v[7]); return r; }
__device__ __forceinline__ void up8(const uint4 w, float (&v)[8]) { v[0] = bflo(w.x); v[1] = bfhi(w.x); v[2] = bflo(w.y); v[3] = bfhi(w.y); v[4] = bflo(w.z); v[5] = bfhi(w.z); v[6] = bflo(w.w); v[7] = bfhi(w.w); }
__device__ __forceinline__ bf16x8 as_frag(const uint4 w) { union { uint4 u; bf16x8 f; } c; c.u = w; return c.f; }
struct AChunk { uint4 k[2][2]; uint4 v[4]; };
typedef short s16x4 __attribute__((ext_vector_type(4)));
__device__ void attn_mfma(const Frame& F, unsigned char* lds, bool do_store = true) {
    int tid = threadIdx.x; asm volatile("" : "+v"(tid));
    const int lane = tid & 63, wid = __builtin_amdgcn_readfirstlane(tid >> 6), c16 = lane & 15, q = lane >> 4;
    u16* QKV = (u16*)(F.ws + WS_QKV); float* LG = (float*)(F.dob + DO_LG);
    unsigned char* Vs = lds + wid * 5120;
    PG8_LAS const unsigned char* Vs3 = (PG8_LAS const unsigned char*)Vs;
    const int krow_off = 8 * (c16 >> 2) + (c16 & 3);
    const int tr_off = (8 * q + (c16 >> 2)) * 144 + 8 * (lane & 3);
    const float LOG2E = 1.4426950408889634f;
    float gm = fabsf(F.qg[lane] * F.kg[lane]);
#pragma unroll
    for (int o = 32; o >= 1; o >>= 1) gm = fmaxf(gm, __shfl_xor(gm, o));
    const float cmax2 = 8.0f * gm * LOG2E;
    volatile PG8_LAS float* gqt = (volatile PG8_LAS float*)((PG8_LAS unsigned char*)lds + 8 * 5120);
    __syncthreads();
    if (tid < 64) gqt[tid] = F.qg[tid] * F.kg[tid] * (0.125f * LOG2E);
    __syncthreads();
    const int Gd = gridDim.x, vcu = (Gd % 8 == 0) ? ((int)blockIdx.x % 8) * (Gd / 8) + (int)blockIdx.x / 8 : (int)blockIdx.x;
    for (int item = vcu * 8 + wid; item < NB * 8 * 3 * 32; item += Gd * 8) {
        const int blk = item & 31, rest = item >> 5, g = rest % 3, bh = rest / 3, h = bh & 7, b = bh >> 3;
        const int dsh = 2 * g, n = SEQ >> dsh, nbn = 32 >> dsh, r = blk >> (5 - dsh), nb = blk & (nbn - 1);
        const float ca2 = exp2f(-(float)(h + 1)) * (float)(1 << dsh) * LOG2E;
        const size_t colq = (size_t)g * 512 + h * 64;
        const u16* base = QKV + (size_t)b * SEQ * NQKV;
        const int kc_lo = nb == 0 ? 2 : 0, kc_hi = nb == nbn - 1 ? 4 : 6;
        auto load_chunk = [&](AChunk& c, int j0c) {
#pragma unroll
            for (int kt = 0; kt < 2; ++kt) { int jk = j0c + 4 * kt + krow_off; jk = jk < 0 ? 0 : (jk > n - 1 ? n - 1 : jk);
                const u16* krow = base + (size_t)((jk << dsh) + r) * NQKV + 1536 + colq;
                c.k[kt][0] = *(const uint4*)(krow + 8 * q); c.k[kt][1] = *(const uint4*)(krow + 32 + 8 * q); }
            int jv = j0c + (lane >> 1); jv = jv < 0 ? 0 : (jv > n - 1 ? n - 1 : jv);
            const u16* vrow = base + (size_t)((jv << dsh) + r) * NQKV + 3072 + colq + 32 * (lane & 1);
#pragma unroll
            for (int v4 = 0; v4 < 4; ++v4) c.v[v4] = *(const uint4*)(vrow + 8 * v4);
        };
        AChunk cur;
        bf16x8 Qf[4][2];
#pragma unroll
        for (int qt = 0; qt < 4; ++qt) { const int i = 64 * nb + 16 * qt + c16; const u16* qrow = base + (size_t)((i << dsh) + r) * NQKV + colq;
            float v0[8], v1[8]; up8(*(const uint4*)(qrow + 8 * q), v0); up8(*(const uint4*)(qrow + 32 + 8 * q), v1);
            float ss = 0.f;
#pragma unroll
            for (int e = 0; e < 8; ++e) ss += v0[e] * v0[e] + v1[e] * v1[e];
            ss += __shfl_xor(ss, 16); ss += __shfl_xor(ss, 32);
            const float rq = rsqrtf(ss * (1.0f / 64.0f) + 1e-6f);
#pragma unroll
            for (int e = 0; e < 8; ++e) { v0[e] *= rq * gqt[8 * q + e]; v1[e] *= rq * gqt[32 + 8 * q + e]; }
            Qf[qt][0] = as_frag(pk8(v0)); Qf[qt][1] = as_frag(pk8(v1)); }
        f32x4 Oacc[4][4]; f32x4 Lacc[4];
#pragma unroll
        for (int dt = 0; dt < 4; ++dt)
#pragma unroll
            for (int qt = 0; qt < 4; ++qt) Oacc[dt][qt] = (f32x4){0.f, 0.f, 0.f, 0.f};
#pragma unroll
        for (int qt = 0; qt < 4; ++qt) Lacc[qt] = (f32x4){0.f, 0.f, 0.f, 0.f};
#pragma unroll 1
        for (int kc = kc_lo; kc < kc_hi; ++kc) {
            const int j0c = 64 * (nb - 1) + 32 * kc;
            load_chunk(cur, j0c);
            unsigned tch0 = 0, tch1 = 0;
            if (kc + 1 < kc_hi) {
                int jk = j0c + 32 + (lane >> 1); jk = jk < 0 ? 0 : (jk > n - 1 ? n - 1 : jk);
                const u16* rowp = base + (size_t)((jk << dsh) + r) * NQKV + colq + ((lane & 1) ? 3072 : 1536);
                tch0 = *(const unsigned*)rowp; }
            { unsigned char* dst = Vs + (lane >> 1) * 144 + (lane & 1) * 64;
#pragma unroll
              for (int v4 = 0; v4 < 4; ++v4) *(uint4*)(dst + 16 * v4) = cur.v[v4]; }
            bf16x8 kf[2][2];
#pragma unroll
            for (int kt = 0; kt < 2; ++kt) {
                float v0[8], v1[8]; up8(cur.k[kt][0], v0); up8(cur.k[kt][1], v1);
                float ss = 0.f;
#pragma unroll
                for (int e = 0; e < 8; ++e) ss += v0[e] * v0[e] + v1[e] * v1[e];
                ss += __shfl_xor(ss, 16); ss += __shfl_xor(ss, 32);
                const float rk = rsqrtf(ss * (1.0f / 64.0f) + 1e-6f);
#pragma unroll
                for (int e = 0; e < 8; ++e) { v0[e] *= rk; v1[e] *= rk; }
                kf[kt][0] = as_frag(pk8(v0)); kf[kt][1] = as_frag(pk8(v1)); }
            bf16x8 Pf[4];
            int rel0 = 64 + c16 - 8 * q - 32 * kc;
            asm volatile("" : "+v"(rel0));
            const float relf0 = (float)rel0;
            const bool edge = (kc < 2) || (kc > 3);
#pragma unroll
            for (int qt = 0; qt < 4; ++qt) { float p[8];
#pragma unroll
                for (int kt = 0; kt < 2; ++kt) { f32x4 z = (f32x4){-cmax2, -cmax2, -cmax2, -cmax2};
                    z = __builtin_amdgcn_mfma_f32_16x16x32_bf16(kf[kt][0], Qf[qt][0], z, 0, 0, 0);
                    z = __builtin_amdgcn_mfma_f32_16x16x32_bf16(kf[kt][1], Qf[qt][1], z, 0, 0, 0);
#pragma unroll
                    for (int j = 0; j < 4; ++j) { const float dist = fabsf(relf0 + (float)(16 * qt - 4 * kt - j));
                        const float pv = __builtin_amdgcn_exp2f(z[j] - ca2 * dist);
                        p[4 * kt + j] = (edge && dist > 64.0f) ? 0.f : pv; } }
                Pf[qt] = as_frag(pk8(p)); }
            asm volatile("" ::: "memory");
#pragma unroll
            for (int dt = 0; dt < 4; ++dt) {
                const s16x4 a0 = __builtin_amdgcn_ds_read_tr16_b64_v4i16((PG8_LAS s16x4*)(Vs3 + tr_off + 32 * dt));
                const s16x4 a1 = __builtin_amdgcn_ds_read_tr16_b64_v4i16((PG8_LAS s16x4*)(Vs3 + tr_off + 4 * 144 + 32 * dt));
                const bf16x8 vf = __builtin_shufflevector(a0, a1, 0, 1, 2, 3, 4, 5, 6, 7);
#pragma unroll
                for (int qt = 0; qt < 4; ++qt) Oacc[dt][qt] = __builtin_amdgcn_mfma_f32_16x16x32_bf16(vf, Pf[qt], Oacc[dt][qt], 0, 0, 0); }
            { const bf16x8 ones = (bf16x8){0x3F80, 0x3F80, 0x3F80, 0x3F80, 0x3F80, 0x3F80, 0x3F80, 0x3F80};
#pragma unroll
              for (int qt = 0; qt < 4; ++qt) Lacc[qt] = __builtin_amdgcn_mfma_f32_16x16x32_bf16(ones, Pf[qt], Lacc[qt], 0, 0, 0); }
            asm volatile("" :: "v"(tch0), "v"(tch1) : "memory");
        }
        if (do_store)
#pragma unroll
        for (int qt = 0; qt < 4; ++qt) { const int i = 64 * nb + 16 * qt + c16, tok = (i << dsh) + r;
            const float lt = Lacc[qt][0];
            u16* orow = QKV + (size_t)(b * SEQ + tok) * NQKV + colq;
#pragma unroll
            for (int dp = 0; dp < 2; ++dp) {
                const unsigned ax = pk2(Oacc[2 * dp][qt][0], Oacc[2 * dp][qt][1]), ay = pk2(Oacc[2 * dp][qt][2], Oacc[2 * dp][qt][3]);
                const unsigned bx = pk2(Oacc[2 * dp + 1][qt][0], Oacc[2 * dp + 1][qt][1]), by = pk2(Oacc[2 * dp + 1][qt][2], Oacc[2 * dp + 1][qt][3]);
                const auto r0 = __builtin_amdgcn_permlane16_swap(ax, bx, false, false);
                const auto r1 = __builtin_amdgcn_permlane16_swap(ay, by, false, false);
                const int doff = (q & 1) ? 16 * (2 * dp + 1) + 4 * (q - 1) : 16 * (2 * dp) + 4 * q;
                *(uint4*)(orow + doff) = make_uint4(r0[0], r1[0], r0[1], r1[1]); }
            if (q == 0) LG[((size_t)g * MTOK + b * SEQ + tok) * 8 + h] = lt; }
    }
    __syncthreads();
}
__device__ void attn_combine(const Frame& F) {
    const u16* QKV = (const u16*)(F.ws + WS_QKV); const float* LG = (const float*)(F.dob + DO_LG); u16* ATG = (u16*)(F.ws + WS_ATG);
    for (int idx = blockIdx.x * 512 + F.tid; idx < MTOK * 64; idx += gridDim.x * 512) {
        const int m = idx >> 6, cc = (idx & 63) * 8, h = cc >> 6;
        const float lt = LG[(size_t)m * 8 + h] + LG[((size_t)MTOK + m) * 8 + h] + LG[((size_t)2 * MTOK + m) * 8 + h];
        const u16* qrow = QKV + (size_t)m * NQKV + cc;
        float o0[8], o1[8], o2[8], gt[8]; up8(*(const uint4*)qrow, o0); up8(*(const uint4*)(qrow + 512), o1); up8(*(const uint4*)(qrow + 1024), o2);
        uint4* gp = (uint4*)(ATG + (size_t)m * ATW + cc); up8(*gp, gt);
        const float il = 1.0f / lt;
#pragma unroll
        for (int e = 0; e < 8; ++e) o0[e] = (o0[e] + o1[e] + o2[e]) * il * gt[e];
        *gp = pk8(o0);
    }
}

__device__ void p2b_transpose(const Frame& F, unsigned char* lds) {
    const int tid = F.tid; u16* tl = (u16*)lds;
    const u16* HYT = (const u16*)(F.ws + WS_HYT); const u16* HYG = (const u16*)(F.ws + WS_HYG); u16* YH = (u16*)(F.ws + WS_YH);
    for (int tile = blockIdx.x; tile < 12 * 512; tile += gridDim.x) {
        const int c0 = (tile % 12) * 64, m0 = (tile / 12) * 64;
        const int cl = tid >> 3, mc = (tid & 7) * 8;
        const u32x4 wq = __builtin_nontemporal_load((const u32x4*)(HYT + (size_t)(c0 + cl) * MTOK + m0 + mc)); const uint4 w = (uint4){wq.x, wq.y, wq.z, wq.w};
        tl[(mc + 0) * 72 + cl] = (u16)(w.x & 0xffff); tl[(mc + 1) * 72 + cl] = (u16)(w.x >> 16); tl[(mc + 2) * 72 + cl] = (u16)(w.y & 0xffff); tl[(mc + 3) * 72 + cl] = (u16)(w.y >> 16);
        tl[(mc + 4) * 72 + cl] = (u16)(w.z & 0xffff); tl[(mc + 5) * 72 + cl] = (u16)(w.z >> 16); tl[(mc + 6) * 72 + cl] = (u16)(w.w & 0xffff); tl[(mc + 7) * 72 + cl] = (u16)(w.w >> 16);
        __syncthreads();
        const int ml = tid >> 3, cc = (tid & 7) * 8;
        const uint4 y = *(const uint4*)&tl[ml * 72 + cc]; const uint4 g = *(const uint4*)(HYG + (size_t)(m0 + ml) * HYW + c0 + cc);
        uint4 r; r.x = pk2(bflo(y.x) * bflo(g.x), bfhi(y.x) * bfhi(g.x)); r.y = pk2(bflo(y.y) * bflo(g.y), bfhi(y.y) * bfhi(g.y));
        r.z = pk2(bflo(y.z) * bflo(g.z), bfhi(y.z) * bfhi(g.z)); r.w = pk2(bflo(y.w) * bflo(g.w), bfhi(y.w) * bfhi(g.w));
        __builtin_nontemporal_store((u32x4){r.x, r.y, r.z, r.w}, (u32x4*)(YH + (size_t)(m0 + ml) * HYW + c0 + cc));
        __syncthreads();
    }
    transpose_weight(F.w_out, DM, DM, (u16*)(F.ws + WS_WOUT), tl, tid);
}


__device__ unsigned g_bar[8 * 64 + 64 + 8 * 64];
__device__ __forceinline__ unsigned gb_ld(unsigned* p) { return __hip_atomic_load(p, __ATOMIC_RELAXED, __HIP_MEMORY_SCOPE_AGENT); }
__device__ __forceinline__ unsigned gb_add(unsigned* p) { return __hip_atomic_fetch_add(p, 1u, __ATOMIC_RELAXED, __HIP_MEMORY_SCOPE_AGENT); }
__device__ __forceinline__ void grid_bar() {
    asm volatile("s_waitcnt vmcnt(0) lgkmcnt(0)" ::: "memory");
    __syncthreads();
    if (threadIdx.x == 0) {
        __builtin_amdgcn_fence(__ATOMIC_RELEASE, "agent");
        asm volatile("s_waitcnt vmcnt(0)" ::: "memory");
        const unsigned G = gridDim.x, ng = (G % 8u == 0u) ? 8u : 1u, n = G / ng, g = blockIdx.x % ng;
        const unsigned old = gb_add(&g_bar[g * 64]), gen = old / n;
        if (old % n == n - 1u) {
            const unsigned t = gb_add(&g_bar[512]), want = (t / ng + 1u) * ng;
            while ((int)(gb_ld(&g_bar[512]) - want) < 0) __builtin_amdgcn_s_sleep(10);
            gb_add(&g_bar[576 + g * 64]);
        } else {
            while ((int)(gb_ld(&g_bar[576 + g * 64]) - (gen + 1u)) < 0) __builtin_amdgcn_s_sleep(40);
        }
        __builtin_amdgcn_fence(__ATOMIC_ACQUIRE, "agent");
        asm volatile("s_waitcnt vmcnt(0)" ::: "memory");
    }
    __syncthreads();
}

__global__ void __launch_bounds__(512) mk_fwd(Args args) {
    extern __shared__ __attribute__((aligned(16))) unsigned char lds[];
    cg::grid_group grid = cg::this_grid();
    Frame F;
    F.x = args.in[0]; F.norm_g = args.in[1]; F.w_in = args.in[2]; F.b_in = args.in[3]; F.conv_w = args.in[4]; F.conv_b = args.in[5];
    F.w1 = args.in[6]; F.b1 = args.in[7]; F.w2 = args.in[8]; F.b2 = args.in[9]; F.w3 = args.in[10]; F.b3 = args.in[11]; F.w4 = args.in[12]; F.freq = args.in[13];
    F.skip = args.in[14]; F.qg = args.in[15]; F.kg = args.in[16]; F.w_hy = args.in[17]; F.w_at = args.in[18]; F.w_out = args.in[19];
    F.out = args.out; F.ws = args.ws; F.dob = (unsigned char*)args.out;
    F.tid = threadIdx.x; F.lane = F.tid & 63; F.wid = __builtin_amdgcn_readfirstlane(F.tid >> 6);
    const int lo = args.ph_lo, hi = args.ph_hi;
    PG8_LAS unsigned char* ldsa = (PG8_LAS unsigned char*)lds;
    const int G = gridDim.x, c = blockIdx.x;
#ifdef ONLY
#define IN(k) ((k) == ONLY && lo <= (k) && (k) < hi)
#elif defined(SKIP)
#define IN(k) ((k) != SKIP && lo <= (k) && (k) < hi)
#else
#define IN(k) (lo <= (k) && (k) < hi)
#endif
#define SEAM(k) do { if (IN(k) && IN((k) + 1)) { if (hi > 100) grid.sync(); else grid_bar(); } } while (0)
#ifdef REPEAT
#define NREP(k) ((k) == REPEAT ? 2 : 1)
#else
#define NREP(k) 1
#endif
    if (IN(0)) for (int rep = 0; rep < NREP(0); ++rep) p0_prologue(F, lds);
    SEAM(0);
    if (IN(1)) for (int rep = 0; rep < NREP(1); ++rep) {
        pg8::Gemm g{(const u16*)(F.dob + DO_XN), (const u16*)(F.dob + DO_WIN), MTOK, 8192, DM}; pg8::StaticOrder S; S.init(MTOK, 8192, G, c);
        Epi1 E{(u16*)(F.ws + WS_HYT), (u16*)(F.ws + WS_QKV), (u16*)(F.ws + WS_HYG), (u16*)(F.ws + WS_ATG), F.b_in, ldsa + 131072};
        pg8::gemm_phase<Epi1, pg8::StaticOrder>(ldsa, g, S, E, nullptr);
    }
    SEAM(1);
    if (IN(2)) {
#if defined(REPEAT) && REPEAT == 2
        hyena_mfma(F, lds, hi > 100);
#endif
        hyena_mfma(F, lds);
#if defined(REPEAT) && REPEAT == 6
        attn_mfma(F, lds, hi > 100);
#endif
        attn_mfma(F, lds);
#if defined(REPEAT) && REPEAT == 7
        for (int k = 0; k < 5; ++k) grid.sync();
#endif
    }
    SEAM(2);
    if (IN(3)) { for (int rep = 0; rep < NREP(3); ++rep) p2b_transpose(F, lds); attn_combine(F); }
    SEAM(3);
    if (IN(4)) for (int rep = 0; rep < NREP(4); ++rep) {
        pg8::StaticOrder S; S.init(MTOK, DM, G, c);
        { pg8::Gemm g{(const u16*)(F.dob + DO_XN), (const u16*)(F.dob + DO_WIN) + (size_t)8192 * DM, MTOK, DM, DM}; EpiSig E{(u16*)(F.ws + WS_SG), F.b_in + 8192};
          pg8::gemm_phase<EpiSig, pg8::StaticOrder>(ldsa, g, S, E, nullptr); }
        { pg8::Gemm g{(const u16*)(F.ws + WS_YH), (const u16*)(F.dob + DO_WHY), MTOK, DM, HYW}; EpiGate<0> E{(const u16*)(F.ws + WS_SG), (u16*)(F.ws + WS_TMP), nullptr};
          pg8::gemm_phase<EpiGate<0>, pg8::StaticOrder>(ldsa, g, S, E, nullptr); }
        { pg8::Gemm g{(const u16*)(F.dob + DO_XN), (const u16*)(F.dob + DO_WIN) + (size_t)9216 * DM, MTOK, DM, DM}; EpiSig E{(u16*)(F.ws + WS_SG), F.b_in + 9216};
          pg8::gemm_phase<EpiSig, pg8::StaticOrder>(ldsa, g, S, E, nullptr); }
        { pg8::Gemm g{(const u16*)(F.ws + WS_ATG), (const u16*)(F.dob + DO_WAT), MTOK, DM, ATW}; EpiGate<1> E{(const u16*)(F.ws + WS_SG), (u16*)(F.ws + WS_TMP), (u16*)(F.ws + WS_MRG)};
          pg8::gemm_phase<EpiGate<1>, pg8::StaticOrder>(ldsa, g, S, E, nullptr); }
    }
    SEAM(4);
    if (IN(5)) for (int rep = 0; rep < NREP(5); ++rep) {
        pg8::Gemm g{(const u16*)(F.ws + WS_MRG), (const u16*)(F.ws + WS_WOUT), MTOK, DM, DM}; pg8::StaticOrder S; S.init(MTOK, DM, G, c);
        EpiOut E{F.x, F.out};
        pg8::gemm_phase<EpiOut, pg8::StaticOrder>(ldsa, g, S, E, nullptr);
    }
#undef IN
#undef SEAM
}

extern "C" void kernel_launch(void* const* d_in, const int* in_sizes, int n_in, void* d_out, int out_size, void* d_ws, size_t ws_size, hipStream_t stream) {
    static int grid = 0;
    if (grid == 0) {
        if (n_in != 20 || out_size != MTOK * DM || ws_size < WS_END) { fprintf(stderr, "kernel_launch: unexpected shapes (n_in %d out %d ws %zu)\n", n_in, out_size, ws_size); grid = -1; return; }
        int dev = 0, cus = 0, per_cu = 0;
        hipGetDevice(&dev); hipDeviceGetAttribute(&cus, hipDeviceAttributeMultiprocessorCount, dev);
        if (hipFuncSetAttribute((const void*)mk_fwd, hipFuncAttributeMaxDynamicSharedMemorySize, LDS_BYTES) != hipSuccess) { fprintf(stderr, "kernel_launch: hipFuncSetAttribute failed\n"); grid = -1; return; }
        if (hipOccupancyMaxActiveBlocksPerMultiprocessor(&per_cu, (const void*)mk_fwd, 512, LDS_BYTES) != hipSuccess || per_cu < 1) { fprintf(stderr, "kernel_launch: occupancy query failed (%d)\n", per_cu); per_cu = 1; }
        (void)hipGetLastError();
        grid = cus;
        if (grid != 256) fprintf(stderr, "kernel_launch: note: %d CUs\n", grid);
    }
    if (grid < 0) return;
    Args a{};
    for (int i = 0; i < 20; ++i) a.in[i] = (const float*)d_in[i];
    a.out = (float*)d_out; a.ws = (unsigned char*)d_ws;
#if ONE_LAUNCH
    a.ph_lo = 0; a.ph_hi = 6;
    void* kargs[] = {&a};
    hipError_t e = hipLaunchCooperativeKernel((const void*)mk_fwd, dim3(grid), dim3(512), kargs, LDS_BYTES, stream);
    if (e != hipSuccess) fprintf(stderr, "cooperative launch failed: %s (grid %d)\n", hipGetErrorString(e), grid);
#else
    for (int ph = 0; ph < 6; ++ph) { a.ph_lo = ph; a.ph_hi = ph + 1; hipLaunchKernelGGL(mk_fwd, dim3(grid), dim3(512), LDS_BYTES, stream, a); }
#endif
}
```

```cpp
#include <hip/hip_runtime.h>
#include <hip/hip_cooperative_groups.h>
#include <cstdio>
namespace cg = cooperative_groups;
namespace pg8 {
#define PG8_LAS __attribute__((address_space(3)))
typedef unsigned short bf16_t;
typedef short bf16x8 __attribute__((ext_vector_type(8)));
typedef float f32x4 __attribute__((ext_vector_type(4)));
typedef unsigned u32x4 __attribute__((ext_vector_type(4)));
constexpr int BM = 256, BK = 64, HALF = 128, HTB = HALF * BK * 2  , STAGE_BYTES = 8 * HTB, NXCD = 8, WGM = 8;

__host__ __device__ __forceinline__ int lds_byte(int r, int c) { const int st = (r >> 4) * 2 + (c >> 5), rr = r & 15, cc = c & 31, ob = rr * 64 + cc * 2; return st * 1024 + (ob ^ (((ob >> 9) & 1) << 5)); }
__host__ __device__ __forceinline__ void stage_rc(int b, int& R, int& C) { const int st = b / 1024, sb = b % 1024, swz = sb ^ (((sb >> 9) & 1) << 5); R = (st >> 1) * 16 + swz / 64; C = (st & 1) * 32 + (swz % 64) / 2; }
__host__ __device__ __forceinline__ int perm32(int rho) { const int n = rho >> 4, i = rho & 15; return 8 * (i >> 2) + 4 * n + (i & 3); }

struct Unit { int pm, pn; };
struct Gemm { const bf16_t* A; const bf16_t* Bt; int M, N, K; };

struct StaticOrder {
    int nM, nN, nwg, G, c;
    __host__ __device__ void init(int M, int N, int G_, int c_) { nM = M / BM; nN = N / BM; nwg = nM * nN; G = G_; c = c_; }
    __host__ __device__ bool next(int i, Unit& u) const {
        const long L = (long)i * G + c; if (L >= nwg) return false;
        int wgid = (int)L; { const int q = nwg / NXCD, r = nwg % NXCD, xcd = wgid % NXCD, off = wgid / NXCD; wgid = (xcd < r ? xcd * (q + 1) : r * (q + 1) + (xcd - r) * q) + off; }
        const int nig = WGM * nN, gid = wgid / nig, fm = gid * WGM, gsz = (nM - fm) < WGM ? (nM - fm) : WGM;
        u.pm = fm + ((wgid % nig) % gsz); u.pn = (wgid % nig) / gsz; return true;
    }
    __device__ __forceinline__ void a_ready(const Unit&) const {}
    __device__ __forceinline__ void done(const Unit&) const {}
};
__device__ __forceinline__ unsigned cvt_pk_bf16(float lo, float hi) { unsigned r; asm volatile("v_cvt_pk_bf16_f32 %0, %1, %2" : "=v"(r) : "v"(lo), "v"(hi)); return r; }
typedef float f32x2 __attribute__((ext_vector_type(2)));
template <class Epi, class Sched, bool STAMP = false>
__device__ __forceinline__ void gemm_phase(PG8_LAS unsigned char* lds, const Gemm g, const Sched& S, const Epi& E, unsigned long long* stamps) {
    int tid_ = threadIdx.x; asm volatile("" : "+v"(tid_));
    const int tid = tid_, wid = __builtin_amdgcn_readfirstlane(tid >> 6), lane = tid & 63, wr = wid >> 2, wc = wid & 3, fr = lane & 15, fq = lane >> 4;
    const int K = g.K, nt = K / BK;
    int ts_lo = 0, ts_hi = 0, nts = 0; const unsigned long long rt_entry = STAMP ? (unsigned long long)wall_clock64() : 0ull;
#define PG8_STAMP() do { if (STAMP && wid == 0 && nts < 64) { const unsigned long long _c = (unsigned long long)clock64(); \
        ts_lo = (lane == nts) ? (int)(unsigned)_c : ts_lo; ts_hi = (lane == nts) ? (int)(unsigned)(_c >> 32) : ts_hi; ++nts; } } while (0)
    PG8_STAMP();
    unsigned voffA[2], voffB[2];
#pragma unroll
    for (int i = 0; i < 2; ++i) { int R, C; stage_rc(tid * 16 + i * 8192, R, C); const int Rb = Epi::PERM ? ((R & ~31) + perm32(R & 31)) : R;
        voffA[i] = (unsigned)(R * K + C) * 2u; voffB[i] = (unsigned)(Rb * K + C) * 2u; }
    const size_t kstep = (size_t)(BK * 2);
    const size_t hstep = (size_t)HALF * K * 2;
    const size_t tstep = 2 * hstep;
    const unsigned ldsw = (unsigned)wid * 1024u;
    const int aoff = lds_byte(wr * 64 + fr, fq * 8), boff = lds_byte(wc * 32 + fr, fq * 8);
#define PG8_SA(b, h) (((b) * 2 + (h)) * HTB)
#define PG8_SB(b, h) ((4 + (b) * 2 + (h)) * HTB)
#define PG8_STAGE(bufoff, gbase, voff) do { _Pragma("unroll") for (int _i = 0; _i < 2; ++_i) \
        __builtin_amdgcn_global_load_lds((const unsigned*)((const char*)(gbase) + (voff)[_i]), (PG8_LAS unsigned*)(lds + (bufoff) + ldsw + _i * 8192), 16, 0, 0); } while (0)
#define PG8_LDA(dst, b, h) do { _Pragma("unroll") for (int m = 0; m < 4; ++m) _Pragma("unroll") for (int k = 0; k < 2; ++k) dst[m][k] = *(const PG8_LAS bf16x8*)(lds + PG8_SA(b, h) + aoff + m * 2048 + k * 1024); } while (0)
#define PG8_LDB(dst, b, h) do { _Pragma("unroll") for (int n = 0; n < 2; ++n) _Pragma("unroll") for (int k = 0; k < 2; ++k) dst[n][k] = *(const PG8_LAS bf16x8*)(lds + PG8_SB(b, h) + boff + n * 2048 + k * 1024); } while (0)
#define PG8_MMA(ai, bj, At, Bt) do { __builtin_amdgcn_s_setprio(1); _Pragma("unroll") for (int m = 0; m < 4; ++m) _Pragma("unroll") for (int n = 0; n < 2; ++n) _Pragma("unroll") for (int k = 0; k < 2; ++k) \
        acc[ai][bj][m][n] = __builtin_amdgcn_mfma_f32_16x16x32_bf16(Bt[n][k], At[m][k], acc[ai][bj][m][n], 0, 0, 0); __builtin_amdgcn_s_setprio(0); } while (0)
#define PG8_WAIT_V(n) asm volatile("s_waitcnt vmcnt(" #n ")" ::: "memory")
#define PG8_WAIT_L(n) asm volatile("s_waitcnt lgkmcnt(" #n ")" ::: "memory")
#define PG8_BAR __builtin_amdgcn_s_barrier()
#define PG8_SCHED __builtin_amdgcn_sched_barrier(0)
    Unit cur, nxt; int ui = 0;
    if (!S.next(0, cur)) return;
    f32x4 acc[2][2][4][2];
#pragma unroll
    for (int a = 0; a < 2; ++a)
#pragma unroll
        for (int b = 0; b < 2; ++b)
#pragma unroll
            for (int m = 0; m < 4; ++m)
#pragma unroll
                for (int n = 0; n < 2; ++n) acc[a][b][m][n] = (f32x4){0.f, 0.f, 0.f, 0.f};
    bf16x8 At[4][2], B0[2][2], B1[2][2];
    const char* cA = (const char*)g.A + (size_t)cur.pm * tstep; const char* cB = (const char*)g.Bt + (size_t)cur.pn * tstep;
    S.a_ready(cur);
    PG8_STAGE(PG8_SB(0, 0), cB, voffB); PG8_STAGE(PG8_SA(0, 0), cA, voffA); PG8_STAGE(PG8_SB(0, 1), cB + hstep, voffB); PG8_STAGE(PG8_SA(0, 1), cA + hstep, voffA);
    if (wr == 1) PG8_BAR;
    PG8_WAIT_V(4); PG8_BAR;
    PG8_STAGE(PG8_SB(1, 0), cB + kstep, voffB); PG8_STAGE(PG8_SA(1, 0), cA + kstep, voffA); PG8_STAGE(PG8_SB(1, 1), cB + hstep + kstep, voffB);
    PG8_WAIT_V(6); PG8_BAR;
    PG8_STAMP();
    for (;;) {
        const bool has_next = S.next(ui + 1, nxt);
        const char* nA = has_next ? (const char*)g.A + (size_t)nxt.pm * tstep : cA; const char* nB = has_next ? (const char*)g.Bt + (size_t)nxt.pn * tstep : cB;
        for (int t = 0; t < nt; t += 2) {
            const bool last = (t == nt - 2);
            const char* a1 = cA + (size_t)(t + 1) * kstep;
            const char* a2 = last ? nA : cA + (size_t)(t + 2) * kstep; const char* b2 = last ? nB : cB + (size_t)(t + 2) * kstep;
            const char* a3 = a2 + kstep; const char* b3 = b2 + kstep;
            if (last && has_next) S.a_ready(nxt);
            PG8_LDB(B0, 0, 0); PG8_SCHED; PG8_LDA(At, 0, 0); PG8_STAGE(PG8_SA(1, 1), a1 + hstep, voffA);
            PG8_WAIT_L(8); PG8_BAR; PG8_WAIT_L(0); PG8_MMA(0, 0, At, B0); PG8_BAR; PG8_SCHED;
            PG8_LDB(B1, 0, 1); PG8_STAGE(PG8_SB(0, 0), b2, voffB);
            PG8_BAR; PG8_WAIT_L(0); PG8_MMA(0, 1, At, B1); PG8_BAR;
            PG8_LDA(At, 0, 1); PG8_STAGE(PG8_SA(0, 0), a2, voffA);
            PG8_BAR; PG8_WAIT_L(0); PG8_MMA(1, 0, At, B0); PG8_BAR; PG8_SCHED;
            PG8_STAGE(PG8_SB(0, 1), b2 + hstep, voffB);
            PG8_WAIT_V(6); PG8_BAR; PG8_MMA(1, 1, At, B1); PG8_BAR;
            PG8_LDB(B0, 1, 0); PG8_SCHED; PG8_LDA(At, 1, 0); PG8_STAGE(PG8_SA(0, 1), a2 + hstep, voffA);
            PG8_WAIT_L(8); PG8_BAR; PG8_WAIT_L(0); PG8_MMA(0, 0, At, B0); PG8_BAR; PG8_SCHED;
            PG8_LDB(B1, 1, 1); PG8_STAGE(PG8_SB(1, 0), b3, voffB);
            PG8_BAR; PG8_WAIT_L(0); PG8_MMA(0, 1, At, B1); PG8_BAR;
            PG8_LDA(At, 1, 1); PG8_STAGE(PG8_SA(1, 0), a3, voffA);
            PG8_BAR; PG8_WAIT_L(0); PG8_MMA(1, 0, At, B0); PG8_BAR; PG8_SCHED;
            PG8_STAGE(PG8_SB(1, 1), b3 + hstep, voffB);
            PG8_WAIT_V(6); PG8_BAR; PG8_MMA(1, 1, At, B1); PG8_BAR;
        }
        PG8_STAMP();
        if constexpr (!Epi::AFTER_DRAIN) { E(acc, cur, wr, wc, fr, fq); S.done(cur); }
        PG8_STAMP();
        if (!has_next) break;
#pragma unroll
        for (int a = 0; a < 2; ++a)
#pragma unroll
            for (int b = 0; b < 2; ++b)
#pragma unroll
                for (int m = 0; m < 4; ++m)
#pragma unroll
                    for (int n = 0; n < 2; ++n) acc[a][b][m][n] = (f32x4){0.f, 0.f, 0.f, 0.f};
        cur = nxt; cA = nA; cB = nB; ++ui;
    }
    PG8_WAIT_V(0);
    if (wr == 0) PG8_BAR;
    PG8_BAR;
    if constexpr (Epi::AFTER_DRAIN) { E.fused(acc, cur, wr, wc, fr, fq, lds, wid, lane); S.done(cur); }
    PG8_STAMP();
    if (STAMP && wid == 0) { stamps[lane] = lane < nts ? (((unsigned long long)(unsigned)ts_hi << 32) | (unsigned)ts_lo) : 0ull;
        if (lane == 62) stamps[62] = rt_entry; if (lane == 63) stamps[63] = (unsigned long long)wall_clock64(); }
#undef PG8_STAMP
#undef PG8_SA
#undef PG8_SB
#undef PG8_STAGE
#undef PG8_LDA
#undef PG8_LDB
#undef PG8_MMA
#undef PG8_WAIT_V
#undef PG8_WAIT_L
#undef PG8_BAR
#undef PG8_SCHED
}
}

#ifndef ONE_LAUNCH
#define ONE_LAUNCH 1
#endif
typedef unsigned short u16;
typedef pg8::f32x4 f32x4;
typedef pg8::u32x4 u32x4;
constexpr int MTOK = 32768, DM = 1024, SEQ = 2048, NB = 16, HYW = 768, NHY = 2304, NQKV = 4608, ATW = 512;
constexpr size_t MiB = 1024 * 1024;
constexpr size_t WS_HYT = 0;
constexpr size_t WS_QKV = 144 * MiB;
constexpr size_t WS_HYG = 432 * MiB;
constexpr size_t WS_ATG = 480 * MiB;
constexpr size_t WS_END = 512 * MiB;
constexpr size_t WS_YH = WS_HYT + 48 * MiB, WS_WOUT = WS_HYT + 96 * MiB;
constexpr size_t WS_SG = WS_QKV, WS_TMP = WS_QKV + 64 * MiB, WS_MRG = WS_QKV + 192 * MiB;
constexpr size_t DO_XN = 0, DO_WIN = 64 * MiB, DO_WHY = 84 * MiB, DO_WAT = DO_WHY + 1536 * 1024, DO_HF = 87 * MiB;
constexpr int LDS_BYTES = 144 * 1024;
constexpr int KBL = 4104;
constexpr int KRP = 4112;
constexpr int UP = 2056;

struct Args { const float* in[20]; float* out; unsigned char* ws; int ph_lo, ph_hi; };
struct Frame {
    const float *x, *norm_g, *w_in, *b_in, *conv_w, *conv_b, *w1, *b1, *w2, *b2, *w3, *b3, *w4, *freq, *skip, *qg, *kg, *w_hy, *w_at, *w_out;
    float* out; unsigned char* ws; unsigned char* dob;
    int tid, lane, wid;
};

__device__ __forceinline__ u16 f2bf(float f) { unsigned u = __float_as_uint(f); u += 0x7FFFu + ((u >> 16) & 1u); return (u16)(u >> 16); }
__device__ __forceinline__ float bf2f(u16 b) { return __uint_as_float(((unsigned)b) << 16); }
__device__ __forceinline__ float bflo(unsigned w) { return __uint_as_float(w << 16); }
__device__ __forceinline__ float bfhi(unsigned w) { return __uint_as_float(w & 0xffff0000u); }
typedef float f32x2v __attribute__((ext_vector_type(2)));
typedef __bf16 bf16x2v __attribute__((ext_vector_type(2)));
__device__ __forceinline__ unsigned pk2(float lo, float hi) { const f32x2v v = {lo, hi}; return __builtin_bit_cast(unsigned, __builtin_convertvector(v, bf16x2v)); }
__device__ __forceinline__ float sigmoidf_(float v) { return __builtin_amdgcn_rcpf(1.0f + __builtin_amdgcn_exp2f(-1.4426950408889634f * v)); }
__device__ __forceinline__ float siluf_(float v) { return v * __builtin_amdgcn_rcpf(1.0f + __builtin_amdgcn_exp2f(-1.4426950408889634f * v)); }

typedef unsigned u32x4u __attribute__((ext_vector_type(4), aligned(2)));
__device__ __forceinline__ void transpose_tile_f32(const float* src, int K, int N, u16* dst, int k0, int n0, u16* tile, int tid) {
    const int kl = tid >> 3, nc = (tid & 7) * 8;
    const float4* p = (const float4*)(src + (size_t)(k0 + kl) * N + n0 + nc);
    const float4* p2 = (const float4*)(src + (size_t)(k0 + 64 + kl) * N + n0 + nc);
    const float4 a = p[0], b = p[1], c = p2[0], d = p2[1];
    tile[(nc + 0) * 136 + kl] = f2bf(a.x); tile[(nc + 1) * 136 + kl] = f2bf(a.y); tile[(nc + 2) * 136 + kl] = f2bf(a.z); tile[(nc + 3) * 136 + kl] = f2bf(a.w);
    tile[(nc + 4) * 136 + kl] = f2bf(b.x); tile[(nc + 5) * 136 + kl] = f2bf(b.y); tile[(nc + 6) * 136 + kl] = f2bf(b.z); tile[(nc + 7) * 136 + kl] = f2bf(b.w);
    tile[(nc + 0) * 136 + 64 + kl] = f2bf(c.x); tile[(nc + 1) * 136 + 64 + kl] = f2bf(c.y); tile[(nc + 2) * 136 + 64 + kl] = f2bf(c.z); tile[(nc + 3) * 136 + 64 + kl] = f2bf(c.w);
    tile[(nc + 4) * 136 + 64 + kl] = f2bf(d.x); tile[(nc + 5) * 136 + 64 + kl] = f2bf(d.y); tile[(nc + 6) * 136 + 64 + kl] = f2bf(d.z); tile[(nc + 7) * 136 + 64 + kl] = f2bf(d.w);
    __syncthreads();
    const int nl = tid >> 3, kc = (tid & 7) * 16;
    const uint4 w0 = *(const uint4*)&tile[nl * 136 + kc], w1 = *(const uint4*)&tile[nl * 136 + kc + 8];
    uint4* dp = (uint4*)(dst + (size_t)(n0 + nl) * K + k0 + kc); dp[0] = w0; dp[1] = w1;
    __syncthreads();
}
__device__ void transpose_weight(const float* src, int K, int N, u16* dst, u16* tile, int tid) {
    const int nkt = K / 128, nnt = N / 64;
    for (int t = blockIdx.x; t < nkt * nnt; t += gridDim.x) transpose_tile_f32(src, K, N, dst, (t % nkt) * 128, (t / nkt) * 64, tile, tid);
}

__device__ __forceinline__ void bar4(PG8_LAS unsigned* cnt, unsigned& target, int lane) {
    asm volatile("s_waitcnt lgkmcnt(0)" ::: "memory");
    target += 4u;
    if (lane == 0) {
        __hip_atomic_fetch_add(cnt, 1u, __ATOMIC_RELAXED, __HIP_MEMORY_SCOPE_WORKGROUP);
        while (__hip_atomic_load(cnt, __ATOMIC_RELAXED, __HIP_MEMORY_SCOPE_WORKGROUP) < target) __builtin_amdgcn_s_sleep(1);
    }
    asm volatile("" ::: "memory");
}
__device__ void p0_prologue(const Frame& F, unsigned char* lds) {
    const int tid = F.tid, lane = F.lane, wid = F.wid;
    u16* tile = (u16*)lds;
    transpose_weight(F.w_in, DM, 10240, (u16*)(F.dob + DO_WIN), tile, tid);
    transpose_weight(F.w_hy, HYW, DM, (u16*)(F.dob + DO_WHY), tile, tid);
    transpose_weight(F.w_at, ATW, DM, (u16*)(F.dob + DO_WAT), tile, tid);
    PG8_LAS unsigned* cnt = (PG8_LAS unsigned*)((PG8_LAS unsigned char*)lds + 65536);
    __syncthreads();
    if (tid == 0) *(volatile PG8_LAS unsigned*)cnt = 0u;
    __syncthreads();
    if (wid >= 4) {
        u16* XN = (u16*)(F.dob + DO_XN);
        for (int row = (blockIdx.x * 4 + (wid - 4)) * 2; row < MTOK; row += gridDim.x * 8) {
            const float4* xr = (const float4*)(F.x + (size_t)row * DM);
            float4 v[8]; float s0 = 0.f, s1 = 0.f;
#pragma unroll
            for (int i = 0; i < 8; ++i) { const f32x4 t = __builtin_nontemporal_load((const f32x4*)xr + lane + 64 * i); v[i] = make_float4(t.x, t.y, t.z, t.w); }
#pragma unroll
            for (int i = 0; i < 4; ++i) { s0 += v[i].x * v[i].x + v[i].y * v[i].y + v[i].z * v[i].z + v[i].w * v[i].w;
                s1 += v[i + 4].x * v[i + 4].x + v[i + 4].y * v[i + 4].y + v[i + 4].z * v[i + 4].z + v[i + 4].w * v[i + 4].w; }
#pragma unroll
            for (int o = 32; o >= 1; o >>= 1) { s0 += __shfl_xor(s0, o); s1 += __shfl_xor(s1, o); }
            const float r0 = rsqrtf(s0 * (1.0f / DM) + 1e-6f), r1 = rsqrtf(s1 * (1.0f / DM) + 1e-6f);
#pragma unroll
            for (int i = 0; i < 4; ++i) { const float4 g = ((const float4*)F.norm_g)[lane + 64 * i];
                uint2 w; w.x = pk2(v[i].x * r0 * g.x, v[i].y * r0 * g.y); w.y = pk2(v[i].z * r0 * g.z, v[i].w * r0 * g.w);
                *(uint2*)(XN + (size_t)row * DM + 4 * (lane + 64 * i)) = w;
                uint2 w2; w2.x = pk2(v[i + 4].x * r1 * g.x, v[i + 4].y * r1 * g.y); w2.y = pk2(v[i + 4].z * r1 * g.z, v[i + 4].w * r1 * g.w);
                *(uint2*)(XN + (size_t)(row + 1) * DM + 4 * (lane + 64 * i)) = w2; }
        }
    } else {
        unsigned target = 0u;
        u16* KB = (u16*)(F.dob + DO_HF);
        float* zs = (float*)lds;
        float* ha = zs + 8 * 40;
        float* hb = ha + 8 * 64;
        float* ws1 = hb + 8 * 64;
        float* ws2 = ws1 + 33 * 64;
        float* ws3 = ws2 + 64 * 64;
        for (int e = tid; e < 33 * 16; e += 256) ((float4*)ws1)[e] = ((const float4*)F.w1)[e];
        for (int e = tid; e < 64 * 16; e += 256) { ((float4*)ws2)[e] = ((const float4*)F.w2)[e]; ((float4*)ws3)[e] = ((const float4*)F.w3)[e]; }
        for (int blk = blockIdx.x; blk < SEQ / 8; blk += gridDim.x) {
            const int t0 = blk * 8;
            bar4(cnt, target, lane);
            for (int e = tid; e < 8 * 33; e += 256) { const int p = e / 33, i = e % 33; const float tt = (float)(t0 + p);
                float val;
                if (i == 0) val = tt * (1.0f / 2047.0f);
                else { const int j = (i - 1) & 15; const float f = 1e-4f + (float)j * ((15.0f - 1e-4f) / 15.0f); const float w = 6.283185307179586f * tt * (1.0f / 2048.0f); const float a = f * w;
                    val = (i <= 16) ? cosf(a) : -sinf(a); }
                zs[p * 40 + i] = val; }
            bar4(cnt, target, lane);
            const int p0 = tid >> 6, j = tid & 63; const float fr = F.freq[j];
#pragma unroll 1
            for (int pp = p0; pp < 8; pp += 4) { float a = F.b1[j];
#pragma unroll 3
                for (int i = 0; i < 33; ++i) a += zs[pp * 40 + i] * ws1[i * 64 + j]; ha[pp * 64 + j] = sinf(fr * a); }
            bar4(cnt, target, lane);
#pragma unroll 1
            for (int pp = p0; pp < 8; pp += 4) { float a = F.b2[j];
#pragma unroll 4
                for (int i = 0; i < 64; ++i) a += ha[pp * 64 + i] * ws2[i * 64 + j]; hb[pp * 64 + j] = sinf(fr * a); }
            bar4(cnt, target, lane);
#pragma unroll 1
            for (int pp = p0; pp < 8; pp += 4) { float a = F.b3[j];
#pragma unroll 4
                for (int i = 0; i < 64; ++i) a += hb[pp * 64 + i] * ws3[i * 64 + j]; ha[pp * 64 + j] = sinf(fr * a); }
            bar4(cnt, target, lane);
#pragma unroll 1
            for (int col = tid; col < 3072; col += 256) {
                float acc[8];
#pragma unroll
                for (int q = 0; q < 8; ++q) acc[q] = 0.f;
                float wv[64];
#pragma unroll
                for (int k = 0; k < 64; ++k) wv[k] = F.w4[k * 3072 + col];
                int hoff = 0; asm volatile("" : "+v"(hoff));
#pragma unroll
                for (int k4 = 0; k4 < 16; ++k4)
#pragma unroll
                    for (int q = 0; q < 8; ++q) { const float4 h = *(const float4*)&ha[hoff + q * 64 + 4 * k4];
                        acc[q] += h.x * wv[4 * k4] + h.y * wv[4 * k4 + 1] + h.z * wv[4 * k4 + 2] + h.w * wv[4 * k4 + 3]; }
                const int o = col / 1536, d = (col % 1536) / 768, c = col % 768;
                const float dmin = 3.0701134573253944f, dmax = 15.350567286626972f;
                const float ad = dmin + (float)c * ((dmax - dmin) / 767.0f);
#pragma unroll
                for (int q = 0; q < 8; ++q) acc[q] *= expf(-((float)(t0 + q) * (1.0f / 2047.0f)) * ad);
                u16* kb = KB + (size_t)(o * HYW + c) * KBL;
                if (d == 0) { u32x4u w; w.x = pk2(acc[7], acc[6]); w.y = pk2(acc[5], acc[4]); w.z = pk2(acc[3], acc[2]); w.w = pk2(acc[1], acc[0]);
                    *(u32x4u*)(kb + 2041 - t0) = w;
                    if (t0 == 0) { kb[0] = 0;
#pragma unroll
                        for (int q = 0; q < 8; ++q) kb[4096 + q] = 0; } }
                else if (t0 > 0) { u32x4u w; w.x = pk2(acc[0], acc[1]); w.y = pk2(acc[2], acc[3]); w.z = pk2(acc[4], acc[5]); w.w = pk2(acc[6], acc[7]); *(u32x4u*)(kb + 2048 + t0) = w; }
                else {
#pragma unroll
                    for (int q = 1; q < 8; ++q) kb[2048 + q] = f2bf(acc[q]); }
            }
        }
    }
    __syncthreads();
}

template <int ACT> __device__ __forceinline__ void store_rm(const f32x4 (&acc)[2][2][4][2], const f32x4 (&bv)[2][2], u16* base, int ldc, int row0, int col0) {
#pragma unroll
    for (int ai = 0; ai < 2; ++ai)
#pragma unroll
        for (int m = 0; m < 4; ++m) { u16* rowp = base + (size_t)(row0 + ai * 128 + m * 16) * ldc + col0;
#pragma unroll
            for (int bj = 0; bj < 2; ++bj) { f32x4 v0 = acc[ai][bj][m][0] + bv[bj][0], v1 = acc[ai][bj][m][1] + bv[bj][1];
                if (ACT) {
#pragma unroll
                    for (int j = 0; j < 4; ++j) { v0[j] = siluf_(v0[j]); v1[j] = siluf_(v1[j]); } }
                u32x4 w; w.x = pk2(v0[0], v0[1]); w.y = pk2(v0[2], v0[3]); w.z = pk2(v1[0], v1[1]); w.w = pk2(v1[2], v1[3]);
                __builtin_nontemporal_store(w, (u32x4*)(rowp + bj * 128)); } }
}
struct Epi1 {
    static constexpr bool PERM = true, AFTER_DRAIN = false;
    u16 *hyt, *qkv, *hyg, *atg; const float* bias; PG8_LAS unsigned char* tr;
    __device__ __forceinline__ void operator()(const f32x4 (&acc)[2][2][4][2], const pg8::Unit& u, int wr, int wc, int fr, int fq) const {
        const int row0 = u.pm * 256 + wr * 64 + fr, colg = u.pn * 256 + wc * 32 + 8 * fq;
        f32x4 bv[2][2];
#pragma unroll
        for (int bj = 0; bj < 2; ++bj)
#pragma unroll
            for (int n = 0; n < 2; ++n) bv[bj][n] = *(const f32x4*)(bias + colg + bj * 128 + 4 * n);
        if (u.pn < 9) {
            const int lane = fr + 16 * fq;
            PG8_LAS unsigned char* T = tr + (wr * 4 + wc) * 2048;
            const int colw = u.pn * 256 + wc * 32, roww = u.pm * 256 + wr * 64;
#pragma unroll
            for (int ai = 0; ai < 2; ++ai)
#pragma unroll
                for (int mp = 0; mp < 2; ++mp)
#pragma unroll
                    for (int bj = 0; bj < 2; ++bj) {
#pragma unroll
                        for (int mm = 0; mm < 2; ++mm)
#pragma unroll
                            for (int n = 0; n < 2; ++n) { const f32x4 v = acc[ai][bj][2 * mp + mm][n] + bv[bj][n];
#pragma unroll
                                for (int j = 0; j < 4; ++j) *(PG8_LAS u16*)(T + (8 * fq + 4 * n + j) * 64 + (16 * mm + fr) * 2) = f2bf(v[j]); }
                        asm volatile("s_waitcnt lgkmcnt(0)" ::: "memory");
                        const u32x4 w0 = *(PG8_LAS const u32x4*)(T + (lane >> 1) * 64 + (lane & 1) * 32), w1 = *(PG8_LAS const u32x4*)(T + (lane >> 1) * 64 + (lane & 1) * 32 + 16);
                        u16* dst = hyt + (size_t)(colw + bj * 128 + (lane >> 1)) * MTOK + roww + ai * 128 + 32 * mp + 16 * (lane & 1);
                        __builtin_nontemporal_store(w0, (u32x4*)dst); __builtin_nontemporal_store(w1, (u32x4*)(dst + 8));
                        asm volatile("" ::: "memory");
                    }
            return;
        }
        if (u.pn < 12) store_rm<1>(acc, bv, hyg, HYW, row0, colg - 2304);
        else if (u.pn < 30) store_rm<0>(acc, bv, qkv, NQKV, row0, colg - 3072);
        else store_rm<1>(acc, bv, atg, ATW, row0, colg - 7680);
    }
};
struct EpiSig {
    static constexpr bool PERM = true, AFTER_DRAIN = false;
    u16* sg; const float* bias;
    __device__ __forceinline__ void operator()(const f32x4 (&acc)[2][2][4][2], const pg8::Unit& u, int wr, int wc, int fr, int fq) const {
        const int row0 = u.pm * 256 + wr * 64 + fr, col0 = u.pn * 256 + wc * 32 + 8 * fq;
        f32x4 bv[2][2];
#pragma unroll
        for (int bj = 0; bj < 2; ++bj)
#pragma unroll
            for (int n = 0; n < 2; ++n) bv[bj][n] = *(const f32x4*)(bias + col0 + bj * 128 + 4 * n);
#pragma unroll
        for (int ai = 0; ai < 2; ++ai)
#pragma unroll
            for (int m = 0; m < 4; ++m) { u16* rowp = sg + (size_t)(row0 + ai * 128 + m * 16) * DM + col0;
#pragma unroll
                for (int bj = 0; bj < 2; ++bj) { f32x4 v0 = acc[ai][bj][m][0] + bv[bj][0], v1 = acc[ai][bj][m][1] + bv[bj][1];
#pragma unroll
                    for (int j = 0; j < 4; ++j) { v0[j] = sigmoidf_(v0[j]); v1[j] = sigmoidf_(v1[j]); }
                    u32x4 w; w.x = pk2(v0[0], v0[1]); w.y = pk2(v0[2], v0[3]); w.z = pk2(v1[0], v1[1]); w.w = pk2(v1[2], v1[3]);
                    *(u32x4*)(rowp + bj * 128) = w; } }
    }
};
template <int MODE  > struct EpiGate {
    static constexpr bool PERM = true, AFTER_DRAIN = false;
    const u16* sg; u16* tmp; u16* mrg;
    __device__ __forceinline__ void operator()(const f32x4 (&acc)[2][2][4][2], const pg8::Unit& u, int wr, int wc, int fr, int fq) const {
        const int row0 = u.pm * 256 + wr * 64 + fr, col0 = u.pn * 256 + wc * 32 + 8 * fq;
#pragma unroll
        for (int ai = 0; ai < 2; ++ai)
#pragma unroll
            for (int m = 0; m < 4; ++m) { const size_t off = (size_t)(row0 + ai * 128 + m * 16) * DM + col0;
#pragma unroll
                for (int bj = 0; bj < 2; ++bj) { const u32x4 s = *(const u32x4*)(sg + off + bj * 128);
                    f32x4 v0 = acc[ai][bj][m][0], v1 = acc[ai][bj][m][1];
                    v0[0] *= bflo(s.x); v0[1] *= bfhi(s.x); v0[2] *= bflo(s.y); v0[3] *= bfhi(s.y); v1[0] *= bflo(s.z); v1[1] *= bfhi(s.z); v1[2] *= bflo(s.w); v1[3] *= bfhi(s.w);
                    if (MODE == 1) { const u32x4 t = *(const u32x4*)(tmp + off + bj * 128);
                        v0[0] += bflo(t.x); v0[1] += bfhi(t.x); v0[2] += bflo(t.y); v0[3] += bfhi(t.y); v1[0] += bflo(t.z); v1[1] += bfhi(t.z); v1[2] += bflo(t.w); v1[3] += bfhi(t.w); }
                    u32x4 w; w.x = pk2(v0[0], v0[1]); w.y = pk2(v0[2], v0[3]); w.z = pk2(v1[0], v1[1]); w.w = pk2(v1[2], v1[3]);
                    *(u32x4*)((MODE == 0 ? tmp : mrg) + off + bj * 128) = w; } }
    }
};
struct EpiOut {
    static constexpr bool PERM = true, AFTER_DRAIN = false;
    const float* x; float* out;
    __device__ __forceinline__ void operator()(const f32x4 (&acc)[2][2][4][2], const pg8::Unit& u, int wr, int wc, int fr, int fq) const {
        const int row0 = u.pm * 256 + wr * 64 + fr, col0 = u.pn * 256 + wc * 32 + 8 * fq;
#pragma unroll
        for (int ai = 0; ai < 2; ++ai) {
            f32x4 xv[4][2][2];
#pragma unroll
            for (int m = 0; m < 4; ++m) { const size_t off = (size_t)(row0 + ai * 128 + m * 16) * DM + col0;
#pragma unroll
                for (int bj = 0; bj < 2; ++bj) { xv[m][bj][0] = *(const f32x4*)(x + off + bj * 128); xv[m][bj][1] = *(const f32x4*)(x + off + bj * 128 + 4); } }
            __builtin_amdgcn_sched_barrier(0);
#pragma unroll
            for (int m = 0; m < 4; ++m) { const size_t off = (size_t)(row0 + ai * 128 + m * 16) * DM + col0;
#pragma unroll
                for (int bj = 0; bj < 2; ++bj) { *(f32x4*)(out + off + bj * 128) = xv[m][bj][0] + acc[ai][bj][m][0]; *(f32x4*)(out + off + bj * 128 + 4) = xv[m][bj][1] + acc[ai][bj][m][1]; } }
            __builtin_amdgcn_sched_barrier(0);
        }
    }
};

typedef pg8::bf16x8 bf16x8;
__device__ __forceinline__ void load_conv(const u16* grow, float w0, float w1, float w2, float cb, u16* dst, int tid) {
#pragma unroll 2
    for (int k = 0; k < 8; ++k) { const int chunk = tid + 512 * k, b = chunk >> 8, t8 = (chunk & 255) * 8; const u16* p = grow + b * SEQ + t8;
        const u32x4 wq = __builtin_nontemporal_load((const u32x4*)p); const uint4 w = (uint4){wq.x, wq.y, wq.z, wq.w}; const float pm = t8 > 0 ? bf2f(p[-1]) : 0.f, pn = t8 + 8 < SEQ ? bf2f(p[8]) : 0.f;
        const float e0 = bflo(w.x), e1 = bfhi(w.x), e2 = bflo(w.y), e3 = bfhi(w.y), e4 = bflo(w.z), e5 = bfhi(w.z), e6 = bflo(w.w), e7 = bfhi(w.w);
        uint4 r; r.x = pk2(cb + w0 * pm + w1 * e0 + w2 * e1, cb + w0 * e0 + w1 * e1 + w2 * e2); r.y = pk2(cb + w0 * e1 + w1 * e2 + w2 * e3, cb + w0 * e2 + w1 * e3 + w2 * e4);
        r.z = pk2(cb + w0 * e3 + w1 * e4 + w2 * e5, cb + w0 * e4 + w1 * e5 + w2 * e6); r.w = pk2(cb + w0 * e5 + w1 * e6 + w2 * e7, cb + w0 * e6 + w1 * e7 + w2 * pn);
        *(uint4*)(dst + b * UP + t8) = r; }
}
__device__ __forceinline__ void build_kr(const u16* kb, u16* KR, int tid) {
#pragma unroll
    for (int k = 0; k < 8; ++k) { const int ch = tid + 512 * k, sg = ch >> 9, x8 = (ch & 511) * 8;
        u32x4u w = (u32x4u){0u, 0u, 0u, 0u};
        if (x8 != 0) w = *(const u32x4u*)(kb + x8 - sg);
        *(uint4*)(KR + sg * KRP + x8) = (uint4){w.x, w.y, w.z, w.w}; }
}
__device__ __forceinline__ void conv_mfma(PG8_LAS const unsigned char* KRb, PG8_LAS const unsigned char* Ub, int wid, int lane, f32x4 (&acc)[16]) {
    const int i = lane & 15, q = lane >> 4, T0 = wid * 16;
    const int abase = (i & 7) * (KRP * 2) + (8 * (q - (i >> 3)) + 2048) * 2;
    const int bbase = i * (UP * 2) + 16 * q;
#pragma unroll
    for (int t = 0; t < 16; ++t) acc[t] = (f32x4){0.f, 0.f, 0.f, 0.f};
#pragma unroll 1
    for (int sr = 0; sr < 4; ++sr) {
        const int S0 = sr * 16;
        bf16x8 Bf[16];
#pragma unroll
        for (int sl = 0; sl < 16; ++sl) Bf[sl] = *(PG8_LAS const bf16x8*)(Ub + bbase + 64 * (S0 + sl));
        PG8_LAS const unsigned char* ap = KRb + (abase - 32 * (T0 - 2 * S0) - 480);
#pragma unroll
        for (int dl = -30; dl <= 15; ++dl) {
            const bf16x8 a = *(PG8_LAS const bf16x8*)(ap + 32 * (15 - dl));
#pragma unroll
            for (int sl = 0; sl < 16; ++sl) { const int t = dl + 2 * sl; if (t >= 0 && t < 16) acc[t] = __builtin_amdgcn_mfma_f32_16x16x32_bf16(a, Bf[sl], acc[t], 0, 0, 0); }
        }
    }
}
__device__ __forceinline__ void hy_epilogue(const f32x4 (&acc)[16], const u16* X, u16* U, float skip, int wid, int lane) {
    const int b = lane & 15, q = lane >> 4;
#pragma unroll
    for (int tl = 0; tl < 16; ++tl) { const int t = 16 * (wid * 16 + tl) + 4 * q;
        const uint2 xv = *(const uint2*)(X + b * UP + t), uv = *(const uint2*)(U + b * UP + t); uint2 r;
        r.x = pk2(bflo(xv.x) * (acc[tl][0] + bflo(uv.x) * skip), bfhi(xv.x) * (acc[tl][1] + bfhi(uv.x) * skip));
        r.y = pk2(bflo(xv.y) * (acc[tl][2] + bflo(uv.y) * skip), bfhi(xv.y) * (acc[tl][3] + bfhi(uv.y) * skip));
        *(uint2*)(U + b * UP + t) = r; }
}
__device__ __forceinline__ unsigned touch64k(const u16* blk, int tid) { return *(const unsigned*)(blk + tid * 64); }
__device__ void hyena_mfma(const Frame& F, unsigned char* lds, bool do_store = true) {
    int tid = threadIdx.x; asm volatile("" : "+v"(tid));
    const int lane = tid & 63, wid = __builtin_amdgcn_readfirstlane(tid >> 6);
    u16* KR = (u16*)lds; u16* U = (u16*)(lds + 8 * KRP * 2);
    PG8_LAS const unsigned char* KRb = (PG8_LAS const unsigned char*)lds; PG8_LAS const unsigned char* Ub = KRb + 8 * KRP * 2;
    const u16* KB = (const u16*)(F.dob + DO_HF);
    u16* HYT = (u16*)(F.ws + WS_HYT);
    for (int c = blockIdx.x; c < HYW; c += gridDim.x) {
        const float wv0 = F.conv_w[c], wv1 = F.conv_w[NHY + c], wv2 = F.conv_w[2 * NHY + c], cbv = F.conv_b[c];
        const float wa0 = F.conv_w[HYW + c], wa1 = F.conv_w[NHY + HYW + c], wa2 = F.conv_w[2 * NHY + HYW + c], cba = F.conv_b[HYW + c];
        const float wb0 = F.conv_w[2 * HYW + c], wb1 = F.conv_w[NHY + 2 * HYW + c], wb2 = F.conv_w[2 * NHY + 2 * HYW + c], cbb = F.conv_b[2 * HYW + c];
        const float skip0 = F.skip[c], skip1 = F.skip[HYW + c];
        f32x4 acc[16];
        __syncthreads();
        load_conv(HYT + (size_t)c * MTOK, wv0, wv1, wv2, cbv, U, tid);
        build_kr(KB + (size_t)(0 * HYW + c) * KBL, KR, tid);
        unsigned tc0 = touch64k(HYT + (size_t)(HYW + c) * MTOK, tid), tc1 = tid < 65 ? touch64k(KB + (size_t)(HYW + c) * KBL, tid) : 0u;
        __syncthreads();
        conv_mfma(KRb, Ub, wid, lane, acc);
        asm volatile("" :: "v"(tc0), "v"(tc1));
        __syncthreads();
        load_conv(HYT + (size_t)(HYW + c) * MTOK, wa0, wa1, wa2, cba, KR, tid);
        __syncthreads();
        hy_epilogue(acc, KR, U, skip0, wid, lane);
        __syncthreads();
        build_kr(KB + (size_t)(1 * HYW + c) * KBL, KR, tid);
        { const int cn = c + (int)gridDim.x < HYW ? c + (int)gridDim.x : c;
          tc0 = touch64k(HYT + (size_t)(2 * HYW + c) * MTOK, tid); tc1 = touch64k(HYT + (size_t)cn * MTOK, tid); }
        __syncthreads();
        conv_mfma(KRb, Ub, wid, lane, acc);
        asm volatile("" :: "v"(tc0), "v"(tc1));
        __syncthreads();
        load_conv(HYT + (size_t)(2 * HYW + c) * MTOK, wb0, wb1, wb2, cbb, KR, tid);
        __syncthreads();
        hy_epilogue(acc, KR, U, skip1, wid, lane);
        __syncthreads();
        if (do_store)
#pragma unroll 2
        for (int k = 0; k < 8; ++k) { const int chunk = tid + 512 * k, b = chunk >> 8, t8 = (chunk & 255) * 8;
            __builtin_nontemporal_store(*(const u32x4*)(U + b * UP + t8), (u32x4*)(HYT + (size_t)c * MTOK + b * SEQ + t8)); }
    }
    __syncthreads();
}

constexpr size_t DO_LG = 111 * MiB;
__device__ __forceinline__ uint4 pk8(const float (&v)[8]) { uint4 r; r.x = pk2(v[0], v[1]); r.y = pk2(v[2], v[3]); r.z = pk2(v[4], v[5]); r.w = pk2(v[6], v[7]); return r; }
__device__ __forceinline__ void up8(const uint4 w, float (&v)[8]) { v[0] = bflo(w.x); v[1] = bfhi(w.x); v[2] = bflo(w.y); v[3] = bfhi(w.y); v[4] = bflo(w.z); v[5] = bfhi(w.z); v[6] = bflo(w.w); v[7] = bfhi(w.w); }
__device__ __forceinline__ bf16x8 as_frag(const uint4 w) { union { uint4 u; bf16x8 f; } c; c.u = w; return c.f; }
struct AChunk { uint4 k[2][2]; uint4 v[4]; };
typedef short s16x4 __attribute__((ext_vector_type(4)));
__device__ void attn_mfma(const Frame& F, unsigned char* lds, bool do_store = true) {
    int tid = threadIdx.x; asm volatile("" : "+v"(tid));
    const int lane = tid & 63, wid = __builtin_amdgcn_readfirstlane(tid >> 6), c16 = lane & 15, q = lane >> 4;
    u16* QKV = (u16*)(F.ws + WS_QKV); float* LG = (float*)(F.dob + DO_LG);
    unsigned char* Vs = lds + wid * 5120;
    PG8_LAS const unsigned char* Vs3 = (PG8_LAS const unsigned char*)Vs;
    const int krow_off = 8 * (c16 >> 2) + (c16 & 3);
    const int tr_off = (8 * q + (c16 >> 2)) * 144 + 8 * (lane & 3);
    const float LOG2E = 1.4426950408889634f;
    float gm = fabsf(F.qg[lane] * F.kg[lane]);
#pragma unroll
    for (int o = 32; o >= 1; o >>= 1) gm = fmaxf(gm, __shfl_xor(gm, o));
    const float cmax2 = 8.0f * gm * LOG2E;
    volatile PG8_LAS float* gqt = (volatile PG8_LAS float*)((PG8_LAS unsigned char*)lds + 8 * 5120);
    __syncthreads();
    if (tid < 64) gqt[tid] = F.qg[tid] * F.kg[tid] * (0.125f * LOG2E);
    __syncthreads();
    const int Gd = gridDim.x, vcu = (Gd % 8 == 0) ? ((int)blockIdx.x % 8) * (Gd / 8) + (int)blockIdx.x / 8 : (int)blockIdx.x;
    for (int item = vcu * 8 + wid; item < NB * 8 * 3 * 32; item += Gd * 8) {
        const int blk = item & 31, rest = item >> 5, g = rest % 3, bh = rest / 3, h = bh & 7, b = bh >> 3;
        const int dsh = 2 * g, n = SEQ >> dsh, nbn = 32 >> dsh, r = blk >> (5 - dsh), nb = blk & (nbn - 1);
        const float ca2 = exp2f(-(float)(h + 1)) * (float)(1 << dsh) * LOG2E;
        const size_t colq = (size_t)g * 512 + h * 64;
        const u16* base = QKV + (size_t)b * SEQ * NQKV;
        const int kc_lo = nb == 0 ? 2 : 0, kc_hi = nb == nbn - 1 ? 4 : 6;
        auto load_chunk = [&](AChunk& c, int j0c) {
#pragma unroll
            for (int kt = 0; kt < 2; ++kt) { int jk = j0c + 4 * kt + krow_off; jk = jk < 0 ? 0 : (jk > n - 1 ? n - 1 : jk);
                const u16* krow = base + (size_t)((jk << dsh) + r) * NQKV + 1536 + colq;
                c.k[kt][0] = *(const uint4*)(krow + 8 * q); c.k[kt][1] = *(const uint4*)(krow + 32 + 8 * q); }
            int jv = j0c + (lane >> 1); jv = jv < 0 ? 0 : (jv > n - 1 ? n - 1 : jv);
            const u16* vrow = base + (size_t)((jv << dsh) + r) * NQKV + 3072 + colq + 32 * (lane & 1);
#pragma unroll
            for (int v4 = 0; v4 < 4; ++v4) c.v[v4] = *(const uint4*)(vrow + 8 * v4);
        };
        AChunk cur;
        bf16x8 Qf[4][2];
#pragma unroll
        for (int qt = 0; qt < 4; ++qt) { const int i = 64 * nb + 16 * qt + c16; const u16* qrow = base + (size_t)((i << dsh) + r) * NQKV + colq;
            float v0[8], v1[8]; up8(*(const uint4*)(qrow + 8 * q), v0); up8(*(const uint4*)(qrow + 32 + 8 * q), v1);
            float ss = 0.f;
#pragma unroll
            for (int e = 0; e < 8; ++e) ss += v0[e] * v0[e] + v1[e] * v1[e];
            ss += __shfl_xor(ss, 16); ss += __shfl_xor(ss, 32);
            const float rq = rsqrtf(ss * (1.0f / 64.0f) + 1e-6f);
#pragma unroll
            for (int e = 0; e < 8; ++e) { v0[e] *= rq * gqt[8 * q + e]; v1[e] *= rq * gqt[32 + 8 * q + e]; }
            Qf[qt][0] = as_frag(pk8(v0)); Qf[qt][1] = as_frag(pk8(v1)); }
        f32x4 Oacc[4][4]; f32x4 Lacc[4];
#pragma unroll
        for (int dt = 0; dt < 4; ++dt)
#pragma unroll
            for (int qt = 0; qt < 4; ++qt) Oacc[dt][qt] = (f32x4){0.f, 0.f, 0.f, 0.f};
#pragma unroll
        for (int qt = 0; qt < 4; ++qt) Lacc[qt] = (f32x4){0.f, 0.f, 0.f, 0.f};
#pragma unroll 1
        for (int kc = kc_lo; kc < kc_hi; ++kc) {
            const int j0c = 64 * (nb - 1) + 32 * kc;
            load_chunk(cur, j0c);
            unsigned tch0 = 0, tch1 = 0;
            if (kc + 1 < kc_hi) {
                int jk = j0c + 32 + (lane >> 1); jk = jk < 0 ? 0 : (jk > n - 1 ? n - 1 : jk);
                const u16* rowp = base + (size_t)((jk << dsh) + r) * NQKV + colq + ((lane & 1) ? 3072 : 1536);
                tch0 = *(const unsigned*)rowp; }
            { unsigned char* dst = Vs + (lane >> 1) * 144 + (lane & 1) * 64;
#pragma unroll
              for (int v4 = 0; v4 < 4; ++v4) *(uint4*)(dst + 16 * v4) = cur.v[v4]; }
            bf16x8 kf[2][2];
#pragma unroll
            for (int kt = 0; kt < 2; ++kt) {
                float v0[8], v1[8]; up8(cur.k[kt][0], v0); up8(cur.k[kt][1], v1);
                float ss = 0.f;
#pragma unroll
                for (int e = 0; e < 8; ++e) ss += v0[e] * v0[e] + v1[e] * v1[e];
                ss += __shfl_xor(ss, 16); ss += __shfl_xor(ss, 32);
                const float rk = rsqrtf(ss * (1.0f / 64.0f) + 1e-6f);
#pragma unroll
                for (int e = 0; e < 8; ++e) { v0[e] *= rk; v1[e] *= rk; }
                kf[kt][0] = as_frag(pk8(v0)); kf[kt][1] = as_frag(pk8(v1)); }
            bf16x8 Pf[4];
            int rel0 = 64 + c16 - 8 * q - 32 * kc;
            asm volatile("" : "+v"(rel0));
            const float relf0 = (float)rel0;
            const bool edge = (kc < 2) || (kc > 3);
#pragma unroll
            for (int qt = 0; qt < 4; ++qt) { float p[8];
#pragma unroll
                for (int kt = 0; kt < 2; ++kt) { f32x4 z = (f32x4){-cmax2, -cmax2, -cmax2, -cmax2};
                    z = __builtin_amdgcn_mfma_f32_16x16x32_bf16(kf[kt][0], Qf[qt][0], z, 0, 0, 0);
                    z = __builtin_amdgcn_mfma_f32_16x16x32_bf16(kf[kt][1], Qf[qt][1], z, 0, 0, 0);
#pragma unroll
                    for (int j = 0; j < 4; ++j) { const float dist = fabsf(relf0 + (float)(16 * qt - 4 * kt - j));
                        const float pv = __builtin_amdgcn_exp2f(z[j] - ca2 * dist);
                        p[4 * kt + j] = (edge && dist > 64.0f) ? 0.f : pv; } }
                Pf[qt] = as_frag(pk8(p)); }
            asm volatile("" ::: "memory");
#pragma unroll
            for (int dt = 0; dt < 4; ++dt) {
                const s16x4 a0 = __builtin_amdgcn_ds_read_tr16_b64_v4i16((PG8_LAS s16x4*)(Vs3 + tr_off + 32 * dt));
                const s16x4 a1 = __builtin_amdgcn_ds_read_tr16_b64_v4i16((PG8_LAS s16x4*)(Vs3 + tr_off + 4 * 144 + 32 * dt));
                const bf16x8 vf = __builtin_shufflevector(a0, a1, 0, 1, 2, 3, 4, 5, 6, 7);
#pragma unroll
                for (int qt = 0; qt < 4; ++qt) Oacc[dt][qt] = __builtin_amdgcn_mfma_f32_16x16x32_bf16(vf, Pf[qt], Oacc[dt][qt], 0, 0, 0); }
            { const bf16x8 ones = (bf16x8){0x3F80, 0x3F80, 0x3F80, 0x3F80, 0x3F80, 0x3F80, 0x3F80, 0x3F80};
#pragma unroll
              for (int qt = 0; qt < 4; ++qt) Lacc[qt] = __builtin_amdgcn_mfma_f32_16x16x32_bf16(ones, Pf[qt], Lacc[qt], 0, 0, 0); }
            asm volatile("" :: "v"(tch0), "v"(tch1) : "memory");
        }
        if (do_store)
#pragma unroll
        for (int qt = 0; qt < 4; ++qt) { const int i = 64 * nb + 16 * qt + c16, tok = (i << dsh) + r;
            const float lt = Lacc[qt][0];
            u16* orow = QKV + (size_t)(b * SEQ + tok) * NQKV + colq;
#pragma unroll
            for (int dp = 0; dp < 2; ++dp) {
                const unsigned ax = pk2(Oacc[2 * dp][qt][0], Oacc[2 * dp][qt][1]), ay = pk2(Oacc[2 * dp][qt][2], Oacc[2 * dp][qt][3]);
                const unsigned bx = pk2(Oacc[2 * dp + 1][qt][0], Oacc[2 * dp + 1][qt][1]), by = pk2(Oacc[2 * dp + 1][qt][2], Oacc[2 * dp + 1][qt][3]);
                const auto r0 = __builtin_amdgcn_permlane16_swap(ax, bx, false, false);
                const auto r1 = __builtin_amdgcn_permlane16_swap(ay, by, false, false);
                const int doff = (q & 1) ? 16 * (2 * dp + 1) + 4 * (q - 1) : 16 * (2 * dp) + 4 * q;
                *(uint4*)(orow + doff) = make_uint4(r0[0], r1[0], r0[1], r1[1]); }
            if (q == 0) LG[((size_t)g * MTOK + b * SEQ + tok) * 8 + h] = lt; }
    }
    __syncthreads();
}
__device__ void attn_combine(const Frame& F) {
    const u16* QKV = (const u16*)(F.ws + WS_QKV); const float* LG = (const float*)(F.dob + DO_LG); u16* ATG = (u16*)(F.ws + WS_ATG);
    for (int idx = blockIdx.x * 512 + F.tid; idx < MTOK * 64; idx += gridDim.x * 512) {
        const int m = idx >> 6, cc = (idx & 63) * 8, h = cc >> 6;
        const float lt = LG[(size_t)m * 8 + h] + LG[((size_t)MTOK + m) * 8 + h] + LG[((size_t)2 * MTOK + m) * 8 + h];
        const u16* qrow = QKV + (size_t)m * NQKV + cc;
        float o0[8], o1[8], o2[8], gt[8]; up8(*(const uint4*)qrow, o0); up8(*(const uint4*)(qrow + 512), o1); up8(*(const uint4*)(qrow + 1024), o2);
        uint4* gp = (uint4*)(ATG + (size_t)m * ATW + cc); up8(*gp, gt);
        const float il = 1.0f / lt;
#pragma unroll
        for (int e = 0; e < 8; ++e) o0[e] = (o0[e] + o1[e] + o2[e]) * il * gt[e];
        *gp = pk8(o0);
    }
}

__device__ void p2b_transpose(const Frame& F, unsigned char* lds) {
    const int tid = F.tid; u16* tl = (u16*)lds;
    const u16* HYT = (const u16*)(F.ws + WS_HYT); const u16* HYG = (const u16*)(F.ws + WS_HYG); u16* YH = (u16*)(F.ws + WS_YH);
    const int cl = tid >> 3, mc = (tid & 7) * 8, ml = tid >> 3, cc = (tid & 7) * 8;
    for (int base = blockIdx.x; base < 12 * 512; base += 4 * gridDim.x) {
        u32x4 wq[4], gq[4];
#pragma unroll
        for (int u = 0; u < 4; ++u) { const int tile = base + u * gridDim.x;
            if (tile < 12 * 512) { const int c0 = (tile % 12) * 64, m0 = (tile / 12) * 64;
                wq[u] = __builtin_nontemporal_load((const u32x4*)(HYT + (size_t)(c0 + cl) * MTOK + m0 + mc));
                gq[u] = *(const u32x4*)(HYG + (size_t)(m0 + ml) * HYW + c0 + cc); } }
#pragma unroll
        for (int u = 0; u < 4; ++u) { const int tile = base + u * gridDim.x;
            if (tile < 12 * 512) { u16* t = tl + u * (64 * 72); const u32x4 w = wq[u];
                t[(mc + 0) * 72 + cl] = (u16)(w.x & 0xffff); t[(mc + 1) * 72 + cl] = (u16)(w.x >> 16); t[(mc + 2) * 72 + cl] = (u16)(w.y & 0xffff); t[(mc + 3) * 72 + cl] = (u16)(w.y >> 16);
                t[(mc + 4) * 72 + cl] = (u16)(w.z & 0xffff); t[(mc + 5) * 72 + cl] = (u16)(w.z >> 16); t[(mc + 6) * 72 + cl] = (u16)(w.w & 0xffff); t[(mc + 7) * 72 + cl] = (u16)(w.w >> 16); } }
        __syncthreads();
#pragma unroll
        for (int u = 0; u < 4; ++u) { const int tile = base + u * gridDim.x;
            if (tile < 12 * 512) { const int c0 = (tile % 12) * 64, m0 = (tile / 12) * 64; const u16* t = tl + u * (64 * 72);
                const uint4 y = *(const uint4*)&t[ml * 72 + cc]; const u32x4 g = gq[u];
                uint4 r; r.x = pk2(bflo(y.x) * bflo(g.x), bfhi(y.x) * bfhi(g.x)); r.y = pk2(bflo(y.y) * bflo(g.y), bfhi(y.y) * bfhi(g.y));
                r.z = pk2(bflo(y.z) * bflo(g.z), bfhi(y.z) * bfhi(g.z)); r.w = pk2(bflo(y.w) * bflo(g.w), bfhi(y.w) * bfhi(g.w));
                __builtin_nontemporal_store((u32x4){r.x, r.y, r.z, r.w}, (u32x4*)(YH + (size_t)(m0 + ml) * HYW + c0 + cc)); } }
        __syncthreads();
    }
    transpose_weight(F.w_out, DM, DM, (u16*)(F.ws + WS_WOUT), tl, tid);
}


__device__ unsigned g_bar[8 * 64 + 64 + 8 * 64];
__device__ __forceinline__ unsigned gb_ld(unsigned* p) { return __hip_atomic_load(p, __ATOMIC_RELAXED, __HIP_MEMORY_SCOPE_AGENT); }
__device__ __forceinline__ unsigned gb_add(unsigned* p) { return __hip_atomic_fetch_add(p, 1u, __ATOMIC_RELAXED, __HIP_MEMORY_SCOPE_AGENT); }
__device__ __forceinline__ void grid_bar() {
    asm volatile("s_waitcnt vmcnt(0) lgkmcnt(0)" ::: "memory");
    __syncthreads();
    if (threadIdx.x == 0) {
        __builtin_amdgcn_fence(__ATOMIC_RELEASE, "agent");
        asm volatile("s_waitcnt vmcnt(0)" ::: "memory");
        const unsigned G = gridDim.x, ng = (G % 8u == 0u) ? 8u : 1u, n = G / ng, g = blockIdx.x % ng;
        const unsigned old = gb_add(&g_bar[g * 64]), gen = old / n;
        if (old % n == n - 1u) {
            const unsigned t = gb_add(&g_bar[512]), want = (t / ng + 1u) * ng;
            while ((int)(gb_ld(&g_bar[512]) - want) < 0) __builtin_amdgcn_s_sleep(10);
            gb_add(&g_bar[576 + g * 64]);
        } else {
            while ((int)(gb_ld(&g_bar[576 + g * 64]) - (gen + 1u)) < 0) __builtin_amdgcn_s_sleep(40);
        }
        __builtin_amdgcn_fence(__ATOMIC_ACQUIRE, "agent");
        asm volatile("s_waitcnt vmcnt(0)" ::: "memory");
    }
    __syncthreads();
}

__global__ void __launch_bounds__(512) mk_fwd(Args args) {
    extern __shared__ __attribute__((aligned(16))) unsigned char lds[];
    cg::grid_group grid = cg::this_grid();
    Frame F;
    F.x = args.in[0]; F.norm_g = args.in[1]; F.w_in = args.in[2]; F.b_in = args.in[3]; F.conv_w = args.in[4]; F.conv_b = args.in[5];
    F.w1 = args.in[6]; F.b1 = args.in[7]; F.w2 = args.in[8]; F.b2 = args.in[9]; F.w3 = args.in[10]; F.b3 = args.in[11]; F.w4 = args.in[12]; F.freq = args.in[13];
    F.skip = args.in[14]; F.qg = args.in[15]; F.kg = args.in[16]; F.w_hy = args.in[17]; F.w_at = args.in[18]; F.w_out = args.in[19];
    F.out = args.out; F.ws = args.ws; F.dob = (unsigned char*)args.out;
    F.tid = threadIdx.x; F.lane = F.tid & 63; F.wid = __builtin_amdgcn_readfirstlane(F.tid >> 6);
    const int lo = args.ph_lo, hi = args.ph_hi;
    PG8_LAS unsigned char* ldsa = (PG8_LAS unsigned char*)lds;
    const int G = gridDim.x, c = blockIdx.x;
#ifdef ONLY
#define IN(k) ((k) == ONLY && lo <= (k) && (k) < hi)
#elif defined(SKIP)
#define IN(k) ((k) != SKIP && lo <= (k) && (k) < hi)
#else
#define IN(k) (lo <= (k) && (k) < hi)
#endif
#define SEAM(k) do { if (IN(k) && IN((k) + 1)) { if (hi > 100) grid.sync(); else grid_bar(); } } while (0)
#ifdef REPEAT
#define NREP(k) ((k) == REPEAT ? 2 : 1)
#else
#define NREP(k) 1
#endif
    if (IN(0)) for (int rep = 0; rep < NREP(0); ++rep) p0_prologue(F, lds);
    SEAM(0);
    if (IN(1)) for (int rep = 0; rep < NREP(1); ++rep) {
        pg8::Gemm g{(const u16*)(F.dob + DO_XN), (const u16*)(F.dob + DO_WIN), MTOK, 8192, DM}; pg8::StaticOrder S; S.init(MTOK, 8192, G, c);
        Epi1 E{(u16*)(F.ws + WS_HYT), (u16*)(F.ws + WS_QKV), (u16*)(F.ws + WS_HYG), (u16*)(F.ws + WS_ATG), F.b_in, ldsa + 131072};
        pg8::gemm_phase<Epi1, pg8::StaticOrder>(ldsa, g, S, E, nullptr);
    }
    SEAM(1);
    if (IN(2)) {
#if defined(REPEAT) && REPEAT == 2
        hyena_mfma(F, lds, hi > 100);
#endif
        hyena_mfma(F, lds);
#if defined(REPEAT) && REPEAT == 6
        attn_mfma(F, lds, hi > 100);
#endif
        attn_mfma(F, lds);
#if defined(REPEAT) && REPEAT == 7
        for (int k = 0; k < 5; ++k) grid.sync();
#endif
    }
    SEAM(2);
    if (IN(3)) { for (int rep = 0; rep < NREP(3); ++rep) p2b_transpose(F, lds); attn_combine(F); }
    SEAM(3);
    if (IN(4)) for (int rep = 0; rep < NREP(4); ++rep) {
        pg8::StaticOrder S; S.init(MTOK, DM, G, c);
        { pg8::Gemm g{(const u16*)(F.dob + DO_XN), (const u16*)(F.dob + DO_WIN) + (size_t)8192 * DM, MTOK, DM, DM}; EpiSig E{(u16*)(F.ws + WS_SG), F.b_in + 8192};
          pg8::gemm_phase<EpiSig, pg8::StaticOrder>(ldsa, g, S, E, nullptr); }
        { pg8::Gemm g{(const u16*)(F.ws + WS_YH), (const u16*)(F.dob + DO_WHY), MTOK, DM, HYW}; EpiGate<0> E{(const u16*)(F.ws + WS_SG), (u16*)(F.ws + WS_TMP), nullptr};
          pg8::gemm_phase<EpiGate<0>, pg8::StaticOrder>(ldsa, g, S, E, nullptr); }
        { pg8::Gemm g{(const u16*)(F.dob + DO_XN), (const u16*)(F.dob + DO_WIN) + (size_t)9216 * DM, MTOK, DM, DM}; EpiSig E{(u16*)(F.ws + WS_SG), F.b_in + 9216};
          pg8::gemm_phase<EpiSig, pg8::StaticOrder>(ldsa, g, S, E, nullptr); }
        { pg8::Gemm g{(const u16*)(F.ws + WS_ATG), (const u16*)(F.dob + DO_WAT), MTOK, DM, ATW}; EpiGate<1> E{(const u16*)(F.ws + WS_SG), (u16*)(F.ws + WS_TMP), (u16*)(F.ws + WS_MRG)};
          pg8::gemm_phase<EpiGate<1>, pg8::StaticOrder>(ldsa, g, S, E, nullptr); }
    }
    SEAM(4);
    if (IN(5)) for (int rep = 0; rep < NREP(5); ++rep) {
        pg8::Gemm g{(const u16*)(F.ws + WS_MRG), (const u16*)(F.ws + WS_WOUT), MTOK, DM, DM}; pg8::StaticOrder S; S.init(MTOK, DM, G, c);
        EpiOut E{F.x, F.out};
        pg8::gemm_phase<EpiOut, pg8::StaticOrder>(ldsa, g, S, E, nullptr);
    }
#undef IN
#undef SEAM
}

extern "C" void kernel_launch(void* const* d_in, const int* in_sizes, int n_in, void* d_out, int out_size, void* d_ws, size_t ws_size, hipStream_t stream) {
    static int grid = 0;
    if (grid == 0) {
        if (n_in != 20 || out_size != MTOK * DM || ws_size < WS_END) { fprintf(stderr, "kernel_launch: unexpected shapes (n_in %d out %d ws %zu)\n", n_in, out_size, ws_size); grid = -1; return; }
        int dev = 0, cus = 0, per_cu = 0;
        hipGetDevice(&dev); hipDeviceGetAttribute(&cus, hipDeviceAttributeMultiprocessorCount, dev);
        if (hipFuncSetAttribute((const void*)mk_fwd, hipFuncAttributeMaxDynamicSharedMemorySize, LDS_BYTES) != hipSuccess) { fprintf(stderr, "kernel_launch: hipFuncSetAttribute failed\n"); grid = -1; return; }
        if (hipOccupancyMaxActiveBlocksPerMultiprocessor(&per_cu, (const void*)mk_fwd, 512, LDS_BYTES) != hipSuccess || per_cu < 1) { fprintf(stderr, "kernel_launch: occupancy query failed (%d)\n", per_cu); per_cu = 1; }
        (void)hipGetLastError();
        grid = cus;
        if (grid != 256) fprintf(stderr, "kernel_launch: note: %d CUs\n", grid);
    }
    if (grid < 0) return;
    Args a{};
    for (int i = 0; i < 20; ++i) a.in[i] = (const float*)d_in[i];
    a.out = (float*)d_out; a.ws = (unsigned char*)d_ws;
#if ONE_LAUNCH
    a.ph_lo = 0; a.ph_hi = 6;
    void* kargs[] = {&a};
    hipError_t e = hipLaunchCooperativeKernel((const void*)mk_fwd, dim3(grid), dim3(512), kargs, LDS_BYTES, stream);
    if (e != hipSuccess) fprintf(stderr, "cooperative launch failed: %s (grid %d)\n", hipGetErrorString(e), grid);
#else
    for (int ph = 0; ph < 6; ++ph) { a.ph_lo = ph; a.ph_hi = ph + 1; hipLaunchKernelGGL(mk_fwd, dim3(grid), dim3(512), LDS_BYTES, stream, a); }
#endif
}
```

```cpp
#include <hip/hip_runtime.h>
#include <hip/hip_cooperative_groups.h>
#include <cstdio>
namespace cg = cooperative_groups;
namespace pg8 {
#define PG8_LAS __attribute__((address_space(3)))
typedef unsigned short bf16_t;
typedef short bf16x8 __attribute__((ext_vector_type(8)));
typedef float f32x4 __attribute__((ext_vector_type(4)));
typedef unsigned u32x4 __attribute__((ext_vector_type(4)));
constexpr int BM = 256, BK = 64, HALF = 128, HTB = HALF * BK * 2  , STAGE_BYTES = 8 * HTB, NXCD = 8, WGM = 8;

__host__ __device__ __forceinline__ int lds_byte(int r, int c) { const int st = (r >> 4) * 2 + (c >> 5), rr = r & 15, cc = c & 31, ob = rr * 64 + cc * 2; return st * 1024 + (ob ^ (((ob >> 9) & 1) << 5)); }
__host__ __device__ __forceinline__ void stage_rc(int b, int& R, int& C) { const int st = b / 1024, sb = b % 1024, swz = sb ^ (((sb >> 9) & 1) << 5); R = (st >> 1) * 16 + swz / 64; C = (st & 1) * 32 + (swz % 64) / 2; }
__host__ __device__ __forceinline__ int perm32(int rho) { const int n = rho >> 4, i = rho & 15; return 8 * (i >> 2) + 4 * n + (i & 3); }

struct Unit { int pm, pn; };
struct Gemm { const bf16_t* A; const bf16_t* Bt; int M, N, K; };

struct StaticOrder {
    int nM, nN, nwg, G, c;
    __host__ __device__ void init(int M, int N, int G_, int c_) { nM = M / BM; nN = N / BM; nwg = nM * nN; G = G_; c = c_; }
    __host__ __device__ bool next(int i, Unit& u) const {
        const long L = (long)i * G + c; if (L >= nwg) return false;
        int wgid = (int)L; { const int q = nwg / NXCD, r = nwg % NXCD, xcd = wgid % NXCD, off = wgid / NXCD; wgid = (xcd < r ? xcd * (q + 1) : r * (q + 1) + (xcd - r) * q) + off; }
        const int nig = WGM * nN, gid = wgid / nig, fm = gid * WGM, gsz = (nM - fm) < WGM ? (nM - fm) : WGM;
        u.pm = fm + ((wgid % nig) % gsz); u.pn = (wgid % nig) / gsz; return true;
    }
    __device__ __forceinline__ void a_ready(const Unit&) const {}
    __device__ __forceinline__ void done(const Unit&) const {}
};
__device__ __forceinline__ unsigned cvt_pk_bf16(float lo, float hi) { unsigned r; asm volatile("v_cvt_pk_bf16_f32 %0, %1, %2" : "=v"(r) : "v"(lo), "v"(hi)); return r; }
typedef float f32x2 __attribute__((ext_vector_type(2)));
template <class Epi, class Sched, bool STAMP = false>
__device__ __forceinline__ void gemm_phase(PG8_LAS unsigned char* lds, const Gemm g, const Sched& S, const Epi& E, unsigned long long* stamps) {
    int tid_ = threadIdx.x; asm volatile("" : "+v"(tid_));
    const int tid = tid_, wid = __builtin_amdgcn_readfirstlane(tid >> 6), lane = tid & 63, wr = wid >> 2, wc = wid & 3, fr = lane & 15, fq = lane >> 4;
    const int K = g.K, nt = K / BK;
    int ts_lo = 0, ts_hi = 0, nts = 0; const unsigned long long rt_entry = STAMP ? (unsigned long long)wall_clock64() : 0ull;
#define PG8_STAMP() do { if (STAMP && wid == 0 && nts < 64) { const unsigned long long _c = (unsigned long long)clock64(); \
        ts_lo = (lane == nts) ? (int)(unsigned)_c : ts_lo; ts_hi = (lane == nts) ? (int)(unsigned)(_c >> 32) : ts_hi; ++nts; } } while (0)
    PG8_STAMP();
    unsigned voffA[2], voffB[2];
#pragma unroll
    for (int i = 0; i < 2; ++i) { int R, C; stage_rc(tid * 16 + i * 8192, R, C); const int Rb = Epi::PERM ? ((R & ~31) + perm32(R & 31)) : R;
        voffA[i] = (unsigned)(R * K + C) * 2u; voffB[i] = (unsigned)(Rb * K + C) * 2u; }
    const size_t kstep = (size_t)(BK * 2);
    const size_t hstep = (size_t)HALF * K * 2;
    const size_t tstep = 2 * hstep;
    const unsigned ldsw = (unsigned)wid * 1024u;
    const int aoff = lds_byte(wr * 64 + fr, fq * 8), boff = lds_byte(wc * 32 + fr, fq * 8);
#define PG8_SA(b, h) (((b) * 2 + (h)) * HTB)
#define PG8_SB(b, h) ((4 + (b) * 2 + (h)) * HTB)
#define PG8_STAGE(bufoff, gbase, voff) do { _Pragma("unroll") for (int _i = 0; _i < 2; ++_i) \
        __builtin_amdgcn_global_load_lds((const unsigned*)((const char*)(gbase) + (voff)[_i]), (PG8_LAS unsigned*)(lds + (bufoff) + ldsw + _i * 8192), 16, 0, 0); } while (0)
#define PG8_LDA(dst, b, h) do { _Pragma("unroll") for (int m = 0; m < 4; ++m) _Pragma("unroll") for (int k = 0; k < 2; ++k) dst[m][k] = *(const PG8_LAS bf16x8*)(lds + PG8_SA(b, h) + aoff + m * 2048 + k * 1024); } while (0)
#define PG8_LDB(dst, b, h) do { _Pragma("unroll") for (int n = 0; n < 2; ++n) _Pragma("unroll") for (int k = 0; k < 2; ++k) dst[n][k] = *(const PG8_LAS bf16x8*)(lds + PG8_SB(b, h) + boff + n * 2048 + k * 1024); } while (0)
#define PG8_MMA(ai, bj, At, Bt) do { __builtin_amdgcn_s_setprio(1); _Pragma("unroll") for (int m = 0; m < 4; ++m) _Pragma("unroll") for (int n = 0; n < 2; ++n) _Pragma("unroll") for (int k = 0; k < 2; ++k) \
        acc[ai][bj][m][n] = __builtin_amdgcn_mfma_f32_16x16x32_bf16(Bt[n][k], At[m][k], acc[ai][bj][m][n], 0, 0, 0); __builtin_amdgcn_s_setprio(0); } while (0)
#define PG8_WAIT_V(n) asm volatile("s_waitcnt vmcnt(" #n ")" ::: "memory")
#define PG8_WAIT_L(n) asm volatile("s_waitcnt lgkmcnt(" #n ")" ::: "memory")
#define PG8_BAR __builtin_amdgcn_s_barrier()
#define PG8_SCHED __builtin_amdgcn_sched_barrier(0)
    Unit cur, nxt; int ui = 0;
    if (!S.next(0, cur)) return;
    f32x4 acc[2][2][4][2];
#pragma unroll
    for (int a = 0; a < 2; ++a)
#pragma unroll
        for (int b = 0; b < 2; ++b)
#pragma unroll
            for (int m = 0; m < 4; ++m)
#pragma unroll
                for (int n = 0; n < 2; ++n) acc[a][b][m][n] = (f32x4){0.f, 0.f, 0.f, 0.f};
    bf16x8 At[4][2], B0[2][2], B1[2][2];
    const char* cA = (const char*)g.A + (size_t)cur.pm * tstep; const char* cB = (const char*)g.Bt + (size_t)cur.pn * tstep;
    S.a_ready(cur);
    PG8_STAGE(PG8_SB(0, 0), cB, voffB); PG8_STAGE(PG8_SA(0, 0), cA, voffA); PG8_STAGE(PG8_SB(0, 1), cB + hstep, voffB); PG8_STAGE(PG8_SA(0, 1), cA + hstep, voffA);
    if (wr == 1) PG8_BAR;
    PG8_WAIT_V(4); PG8_BAR;
    PG8_STAGE(PG8_SB(1, 0), cB + kstep, voffB); PG8_STAGE(PG8_SA(1, 0), cA + kstep, voffA); PG8_STAGE(PG8_SB(1, 1), cB + hstep + kstep, voffB);
    PG8_WAIT_V(6); PG8_BAR;
    PG8_STAMP();
    for (;;) {
        const bool has_next = S.next(ui + 1, nxt);
        const char* nA = has_next ? (const char*)g.A + (size_t)nxt.pm * tstep : cA; const char* nB = has_next ? (const char*)g.Bt + (size_t)nxt.pn * tstep : cB;
        for (int t = 0; t < nt; t += 2) {
            const bool last = (t == nt - 2);
            const char* a1 = cA + (size_t)(t + 1) * kstep;
            const char* a2 = last ? nA : cA + (size_t)(t + 2) * kstep; const char* b2 = last ? nB : cB + (size_t)(t + 2) * kstep;
            const char* a3 = a2 + kstep; const char* b3 = b2 + kstep;
            if (last && has_next) S.a_ready(nxt);
            PG8_LDB(B0, 0, 0); PG8_SCHED; PG8_LDA(At, 0, 0); PG8_STAGE(PG8_SA(1, 1), a1 + hstep, voffA);
            PG8_WAIT_L(8); PG8_BAR; PG8_WAIT_L(0); PG8_MMA(0, 0, At, B0); PG8_BAR; PG8_SCHED;
            PG8_LDB(B1, 0, 1); PG8_STAGE(PG8_SB(0, 0), b2, voffB);
            PG8_BAR; PG8_WAIT_L(0); PG8_MMA(0, 1, At, B1); PG8_BAR;
            PG8_LDA(At, 0, 1); PG8_STAGE(PG8_SA(0, 0), a2, voffA);
            PG8_BAR; PG8_WAIT_L(0); PG8_MMA(1, 0, At, B0); PG8_BAR; PG8_SCHED;
            PG8_STAGE(PG8_SB(0, 1), b2 + hstep, voffB);
            PG8_WAIT_V(6); PG8_BAR; PG8_MMA(1, 1, At, B1); PG8_BAR;
            PG8_LDB(B0, 1, 0); PG8_SCHED; PG8_LDA(At, 1, 0); PG8_STAGE(PG8_SA(0, 1), a2 + hstep, voffA);
            PG8_WAIT_L(8); PG8_BAR; PG8_WAIT_L(0); PG8_MMA(0, 0, At, B0); PG8_BAR; PG8_SCHED;
            PG8_LDB(B1, 1, 1); PG8_STAGE(PG8_SB(1, 0), b3, voffB);
            PG8_BAR; PG8_WAIT_L(0); PG8_MMA(0, 1, At, B1); PG8_BAR;
            PG8_LDA(At, 1, 1); PG8_STAGE(PG8_SA(1, 0), a3, voffA);
            PG8_BAR; PG8_WAIT_L(0); PG8_MMA(1, 0, At, B0); PG8_BAR; PG8_SCHED;
            PG8_STAGE(PG8_SB(1, 1), b3 + hstep, voffB);
            PG8_WAIT_V(6); PG8_BAR; PG8_MMA(1, 1, At, B1); PG8_BAR;
        }
        PG8_STAMP();
        if constexpr (!Epi::AFTER_DRAIN) { E(acc, cur, wr, wc, fr, fq); S.done(cur); }
        PG8_STAMP();
        if (!has_next) break;
#pragma unroll
        for (int a = 0; a < 2; ++a)
#pragma unroll
            for (int b = 0; b < 2; ++b)
#pragma unroll
                for (int m = 0; m < 4; ++m)
#pragma unroll
                    for (int n = 0; n < 2; ++n) acc[a][b][m][n] = (f32x4){0.f, 0.f, 0.f, 0.f};
        cur = nxt; cA = nA; cB = nB; ++ui;
    }
    PG8_WAIT_V(0);
    if (wr == 0) PG8_BAR;
    PG8_BAR;
    if constexpr (Epi::AFTER_DRAIN) { E.fused(acc, cur, wr, wc, fr, fq, lds, wid, lane); S.done(cur); }
    PG8_STAMP();
    if (STAMP && wid == 0) { stamps[lane] = lane < nts ? (((unsigned long long)(unsigned)ts_hi << 32) | (unsigned)ts_lo) : 0ull;
        if (lane == 62) stamps[62] = rt_entry; if (lane == 63) stamps[63] = (unsigned long long)wall_clock64(); }
#undef PG8_STAMP
#undef PG8_SA
#undef PG8_SB
#undef PG8_STAGE
#undef PG8_LDA
#undef PG8_LDB
#undef PG8_MMA
#undef PG8_WAIT_V
#undef PG8_WAIT_L
#undef PG8_BAR
#undef PG8_SCHED
}
}

#ifndef ONE_LAUNCH
#define ONE_LAUNCH 1
#endif
typedef unsigned short u16;
typedef pg8::f32x4 f32x4;
typedef pg8::u32x4 u32x4;
constexpr int MTOK = 32768, DM = 1024, SEQ = 2048, NB = 16, HYW = 768, NHY = 2304, NQKV = 4608, ATW = 512;
constexpr size_t MiB = 1024 * 1024;
constexpr size_t WS_HYT = 0;
constexpr size_t WS_QKV = 144 * MiB;
constexpr size_t WS_HYG = 432 * MiB;
constexpr size_t WS_ATG = 480 * MiB;
constexpr size_t WS_END = 512 * MiB;
constexpr size_t WS_YH = WS_HYT + 48 * MiB, WS_WOUT = WS_HYT + 96 * MiB;
constexpr size_t WS_SG = WS_QKV, WS_TMP = WS_QKV + 64 * MiB, WS_MRG = WS_QKV + 192 * MiB;
constexpr size_t DO_XN = 0, DO_WIN = 64 * MiB, DO_WHY = 84 * MiB, DO_WAT = DO_WHY + 1536 * 1024, DO_HF = 87 * MiB;
constexpr int LDS_BYTES = 144 * 1024;
constexpr int KBL = 4104;
constexpr int KRP = 4112;
constexpr int UP = 2056;

struct Args { const float* in[20]; float* out; unsigned char* ws; int ph_lo, ph_hi; };
struct Frame {
    const float *x, *norm_g, *w_in, *b_in, *conv_w, *conv_b, *w1, *b1, *w2, *b2, *w3, *b3, *w4, *freq, *skip, *qg, *kg, *w_hy, *w_at, *w_out;
    float* out; unsigned char* ws; unsigned char* dob;
    int tid, lane, wid;
};

__device__ __forceinline__ u16 f2bf(float f) { unsigned u = __float_as_uint(f); u += 0x7FFFu + ((u >> 16) & 1u); return (u16)(u >> 16); }
__device__ __forceinline__ float bf2f(u16 b) { return __uint_as_float(((unsigned)b) << 16); }
__device__ __forceinline__ float bflo(unsigned w) { return __uint_as_float(w << 16); }
__device__ __forceinline__ float bfhi(unsigned w) { return __uint_as_float(w & 0xffff0000u); }
typedef float f32x2v __attribute__((ext_vector_type(2)));
typedef __bf16 bf16x2v __attribute__((ext_vector_type(2)));
__device__ __forceinline__ unsigned pk2(float lo, float hi) { const f32x2v v = {lo, hi}; return __builtin_bit_cast(unsigned, __builtin_convertvector(v, bf16x2v)); }
__device__ __forceinline__ float sigmoidf_(float v) { return __builtin_amdgcn_rcpf(1.0f + __builtin_amdgcn_exp2f(-1.4426950408889634f * v)); }
__device__ __forceinline__ float siluf_(float v) { return v * __builtin_amdgcn_rcpf(1.0f + __builtin_amdgcn_exp2f(-1.4426950408889634f * v)); }

typedef unsigned u32x4u __attribute__((ext_vector_type(4), aligned(2)));
__device__ __forceinline__ void transpose_tile_f32(const float* src, int K, int N, u16* dst, int k0, int n0, u16* tile, int tid) {
    const int kl = tid >> 3, nc = (tid & 7) * 8;
    const float4* p = (const float4*)(src + (size_t)(k0 + kl) * N + n0 + nc);
    const float4* p2 = (const float4*)(src + (size_t)(k0 + 64 + kl) * N + n0 + nc);
    const float4 a = p[0], b = p[1], c = p2[0], d = p2[1];
    tile[(nc + 0) * 136 + kl] = f2bf(a.x); tile[(nc + 1) * 136 + kl] = f2bf(a.y); tile[(nc + 2) * 136 + kl] = f2bf(a.z); tile[(nc + 3) * 136 + kl] = f2bf(a.w);
    tile[(nc + 4) * 136 + kl] = f2bf(b.x); tile[(nc + 5) * 136 + kl] = f2bf(b.y); tile[(nc + 6) * 136 + kl] = f2bf(b.z); tile[(nc + 7) * 136 + kl] = f2bf(b.w);
    tile[(nc + 0) * 136 + 64 + kl] = f2bf(c.x); tile[(nc + 1) * 136 + 64 + kl] = f2bf(c.y); tile[(nc + 2) * 136 + 64 + kl] = f2bf(c.z); tile[(nc + 3) * 136 + 64 + kl] = f2bf(c.w);
    tile[(nc + 4) * 136 + 64 + kl] = f2bf(d.x); tile[(nc + 5) * 136 + 64 + kl] = f2bf(d.y); tile[(nc + 6) * 136 + 64 + kl] = f2bf(d.z); tile[(nc + 7) * 136 + 64 + kl] = f2bf(d.w);
    __syncthreads();
    const int nl = tid >> 3, kc = (tid & 7) * 16;
    const uint4 w0 = *(const uint4*)&tile[nl * 136 + kc], w1 = *(const uint4*)&tile[nl * 136 + kc + 8];
    uint4* dp = (uint4*)(dst + (size_t)(n0 + nl) * K + k0 + kc); dp[0] = w0; dp[1] = w1;
    __syncthreads();
}
__device__ void transpose_weight(const float* src, int K, int N, u16* dst, u16* tile, int tid) {
    const int nkt = K / 128, nnt = N / 64;
    for (int t = blockIdx.x; t < nkt * nnt; t += gridDim.x) transpose_tile_f32(src, K, N, dst, (t % nkt) * 128, (t / nkt) * 64, tile, tid);
}

__device__ __forceinline__ void bar4(PG8_LAS unsigned* cnt, unsigned& target, int lane) {
    asm volatile("s_waitcnt lgkmcnt(0)" ::: "memory");
    target += 4u;
    if (lane == 0) {
        __hip_atomic_fetch_add(cnt, 1u, __ATOMIC_RELAXED, __HIP_MEMORY_SCOPE_WORKGROUP);
        while (__hip_atomic_load(cnt, __ATOMIC_RELAXED, __HIP_MEMORY_SCOPE_WORKGROUP) < target) __builtin_amdgcn_s_sleep(1);
    }
    asm volatile("" ::: "memory");
}
__device__ void p0_prologue(const Frame& F, unsigned char* lds) {
    const int tid = F.tid, lane = F.lane, wid = F.wid;
    u16* tile = (u16*)lds;
    transpose_weight(F.w_in, DM, 10240, (u16*)(F.dob + DO_WIN), tile, tid);
    transpose_weight(F.w_hy, HYW, DM, (u16*)(F.dob + DO_WHY), tile, tid);
    transpose_weight(F.w_at, ATW, DM, (u16*)(F.dob + DO_WAT), tile, tid);
    PG8_LAS unsigned* cnt = (PG8_LAS unsigned*)((PG8_LAS unsigned char*)lds + 65536);
    __syncthreads();
    if (tid == 0) *(volatile PG8_LAS unsigned*)cnt = 0u;
    __syncthreads();
    if (wid >= 4) {
        u16* XN = (u16*)(F.dob + DO_XN);
        for (int row = (blockIdx.x * 4 + (wid - 4)) * 4; row < MTOK; row += gridDim.x * 16) {
            const f32x4* xr = (const f32x4*)(F.x + (size_t)row * DM);
            f32x4 v[16]; float ss[4];
#pragma unroll
            for (int i = 0; i < 16; ++i) v[i] = __builtin_nontemporal_load(xr + lane + 64 * i);
#pragma unroll
            for (int r = 0; r < 4; ++r) { ss[r] = 0.f;
#pragma unroll
                for (int i = 0; i < 4; ++i) { const f32x4 t = v[4 * r + i]; ss[r] += t.x * t.x + t.y * t.y + t.z * t.z + t.w * t.w; } }
#pragma unroll
            for (int o = 32; o >= 1; o >>= 1) {
#pragma unroll
                for (int r = 0; r < 4; ++r) ss[r] += __shfl_xor(ss[r], o); }
#pragma unroll
            for (int i = 0; i < 4; ++i) { const float4 g = ((const float4*)F.norm_g)[lane + 64 * i];
#pragma unroll
                for (int r = 0; r < 4; ++r) { const float rs = rsqrtf(ss[r] * (1.0f / DM) + 1e-6f); const f32x4 t = v[4 * r + i];
                    uint2 w; w.x = pk2(t.x * rs * g.x, t.y * rs * g.y); w.y = pk2(t.z * rs * g.z, t.w * rs * g.w);
                    *(uint2*)(XN + (size_t)(row + r) * DM + 4 * (lane + 64 * i)) = w; } }
        }
    } else {
        unsigned target = 0u;
        u16* KB = (u16*)(F.dob + DO_HF);
        float* zs = (float*)lds;
        float* ha = zs + 8 * 40;
        float* hb = ha + 8 * 64;
        float* ws1 = hb + 8 * 64;
        float* ws2 = ws1 + 33 * 64;
        float* ws3 = ws2 + 64 * 64;
        for (int e = tid; e < 33 * 16; e += 256) ((float4*)ws1)[e] = ((const float4*)F.w1)[e];
        for (int e = tid; e < 64 * 16; e += 256) { ((float4*)ws2)[e] = ((const float4*)F.w2)[e]; ((float4*)ws3)[e] = ((const float4*)F.w3)[e]; }
        for (int blk = blockIdx.x; blk < SEQ / 8; blk += gridDim.x) {
            const int t0 = blk * 8;
            bar4(cnt, target, lane);
            for (int e = tid; e < 8 * 33; e += 256) { const int p = e / 33, i = e % 33; const float tt = (float)(t0 + p);
                float val;
                if (i == 0) val = tt * (1.0f / 2047.0f);
                else { const int j = (i - 1) & 15; const float f = 1e-4f + (float)j * ((15.0f - 1e-4f) / 15.0f); const float w = 6.283185307179586f * tt * (1.0f / 2048.0f); const float a = f * w;
                    val = (i <= 16) ? cosf(a) : -sinf(a); }
                zs[p * 40 + i] = val; }
            bar4(cnt, target, lane);
            const int p0 = tid >> 6, j = tid & 63; const float fr = F.freq[j];
#pragma unroll 1
            for (int pp = p0; pp < 8; pp += 4) { float a = F.b1[j];
#pragma unroll 3
                for (int i = 0; i < 33; ++i) a += zs[pp * 40 + i] * ws1[i * 64 + j]; ha[pp * 64 + j] = sinf(fr * a); }
            bar4(cnt, target, lane);
#pragma unroll 1
            for (int pp = p0; pp < 8; pp += 4) { float a = F.b2[j];
#pragma unroll 4
                for (int i = 0; i < 64; ++i) a += ha[pp * 64 + i] * ws2[i * 64 + j]; hb[pp * 64 + j] = sinf(fr * a); }
            bar4(cnt, target, lane);
#pragma unroll 1
            for (int pp = p0; pp < 8; pp += 4) { float a = F.b3[j];
#pragma unroll 4
                for (int i = 0; i < 64; ++i) a += hb[pp * 64 + i] * ws3[i * 64 + j]; ha[pp * 64 + j] = sinf(fr * a); }
            bar4(cnt, target, lane);
#pragma unroll 1
            for (int col = tid; col < 3072; col += 256) {
                float acc[8];
#pragma unroll
                for (int q = 0; q < 8; ++q) acc[q] = 0.f;
                float wv[64];
#pragma unroll
                for (int k = 0; k < 64; ++k) wv[k] = F.w4[k * 3072 + col];
                int hoff = 0; asm volatile("" : "+v"(hoff));
#pragma unroll
                for (int k4 = 0; k4 < 16; ++k4)
#pragma unroll
                    for (int q = 0; q < 8; ++q) { const float4 h = *(const float4*)&ha[hoff + q * 64 + 4 * k4];
                        acc[q] += h.x * wv[4 * k4] + h.y * wv[4 * k4 + 1] + h.z * wv[4 * k4 + 2] + h.w * wv[4 * k4 + 3]; }
                const int o = col / 1536, d = (col % 1536) / 768, c = col % 768;
                const float dmin = 3.0701134573253944f, dmax = 15.350567286626972f;
                const float ad = dmin + (float)c * ((dmax - dmin) / 767.0f);
#pragma unroll
                for (int q = 0; q < 8; ++q) acc[q] *= expf(-((float)(t0 + q) * (1.0f / 2047.0f)) * ad);
                u16* kb = KB + (size_t)(o * HYW + c) * KBL;
                if (d == 0) { u32x4u w; w.x = pk2(acc[7], acc[6]); w.y = pk2(acc[5], acc[4]); w.z = pk2(acc[3], acc[2]); w.w = pk2(acc[1], acc[0]);
                    *(u32x4u*)(kb + 2041 - t0) = w;
                    if (t0 == 0) { kb[0] = 0;
#pragma unroll
                        for (int q = 0; q < 8; ++q) kb[4096 + q] = 0; } }
                else if (t0 > 0) { u32x4u w; w.x = pk2(acc[0], acc[1]); w.y = pk2(acc[2], acc[3]); w.z = pk2(acc[4], acc[5]); w.w = pk2(acc[6], acc[7]); *(u32x4u*)(kb + 2048 + t0) = w; }
                else {
#pragma unroll
                    for (int q = 1; q < 8; ++q) kb[2048 + q] = f2bf(acc[q]); }
            }
        }
    }
    __syncthreads();
}

template <int ACT> __device__ __forceinline__ void store_rm(const f32x4 (&acc)[2][2][4][2], const f32x4 (&bv)[2][2], u16* base, int ldc, int row0, int col0) {
#pragma unroll
    for (int ai = 0; ai < 2; ++ai)
#pragma unroll
        for (int m = 0; m < 4; ++m) { u16* rowp = base + (size_t)(row0 + ai * 128 + m * 16) * ldc + col0;
#pragma unroll
            for (int bj = 0; bj < 2; ++bj) { f32x4 v0 = acc[ai][bj][m][0] + bv[bj][0], v1 = acc[ai][bj][m][1] + bv[bj][1];
                if (ACT) {
#pragma unroll
                    for (int j = 0; j < 4; ++j) { v0[j] = siluf_(v0[j]); v1[j] = siluf_(v1[j]); } }
                u32x4 w; w.x = pk2(v0[0], v0[1]); w.y = pk2(v0[2], v0[3]); w.z = pk2(v1[0], v1[1]); w.w = pk2(v1[2], v1[3]);
                __builtin_nontemporal_store(w, (u32x4*)(rowp + bj * 128)); } }
}
struct Epi1 {
    static constexpr bool PERM = true, AFTER_DRAIN = false;
    u16 *hyt, *qkv, *hyg, *atg; const float* bias; PG8_LAS unsigned char* tr;
    __device__ __forceinline__ void operator()(const f32x4 (&acc)[2][2][4][2], const pg8::Unit& u, int wr, int wc, int fr, int fq) const {
        const int row0 = u.pm * 256 + wr * 64 + fr, colg = u.pn * 256 + wc * 32 + 8 * fq;
        f32x4 bv[2][2];
#pragma unroll
        for (int bj = 0; bj < 2; ++bj)
#pragma unroll
            for (int n = 0; n < 2; ++n) bv[bj][n] = *(const f32x4*)(bias + colg + bj * 128 + 4 * n);
        if (u.pn < 9) {
            const int lane = fr + 16 * fq;
            PG8_LAS unsigned char* T = tr + (wr * 4 + wc) * 2048;
            const int colw = u.pn * 256 + wc * 32, roww = u.pm * 256 + wr * 64;
#pragma unroll
            for (int ai = 0; ai < 2; ++ai)
#pragma unroll
                for (int mp = 0; mp < 2; ++mp)
#pragma unroll
                    for (int bj = 0; bj < 2; ++bj) {
#pragma unroll
                        for (int mm = 0; mm < 2; ++mm)
#pragma unroll
                            for (int n = 0; n < 2; ++n) { const f32x4 v = acc[ai][bj][2 * mp + mm][n] + bv[bj][n];
#pragma unroll
                                for (int j = 0; j < 4; ++j) *(PG8_LAS u16*)(T + (8 * fq + 4 * n + j) * 64 + (16 * mm + fr) * 2) = f2bf(v[j]); }
                        asm volatile("s_waitcnt lgkmcnt(0)" ::: "memory");
                        const u32x4 w0 = *(PG8_LAS const u32x4*)(T + (lane >> 1) * 64 + (lane & 1) * 32), w1 = *(PG8_LAS const u32x4*)(T + (lane >> 1) * 64 + (lane & 1) * 32 + 16);
                        u16* dst = hyt + (size_t)(colw + bj * 128 + (lane >> 1)) * MTOK + roww + ai * 128 + 32 * mp + 16 * (lane & 1);
                        __builtin_nontemporal_store(w0, (u32x4*)dst); __builtin_nontemporal_store(w1, (u32x4*)(dst + 8));
                        asm volatile("" ::: "memory");
                    }
            return;
        }
        if (u.pn < 12) store_rm<1>(acc, bv, hyg, HYW, row0, colg - 2304);
        else if (u.pn < 30) store_rm<0>(acc, bv, qkv, NQKV, row0, colg - 3072);
        else store_rm<1>(acc, bv, atg, ATW, row0, colg - 7680);
    }
};
struct EpiSig {
    static constexpr bool PERM = true, AFTER_DRAIN = false;
    u16* sg; const float* bias;
    __device__ __forceinline__ void operator()(const f32x4 (&acc)[2][2][4][2], const pg8::Unit& u, int wr, int wc, int fr, int fq) const {
        const int row0 = u.pm * 256 + wr * 64 + fr, col0 = u.pn * 256 + wc * 32 + 8 * fq;
        f32x4 bv[2][2];
#pragma unroll
        for (int bj = 0; bj < 2; ++bj)
#pragma unroll
            for (int n = 0; n < 2; ++n) bv[bj][n] = *(const f32x4*)(bias + col0 + bj * 128 + 4 * n);
#pragma unroll
        for (int ai = 0; ai < 2; ++ai)
#pragma unroll
            for (int m = 0; m < 4; ++m) { u16* rowp = sg + (size_t)(row0 + ai * 128 + m * 16) * DM + col0;
#pragma unroll
                for (int bj = 0; bj < 2; ++bj) { f32x4 v0 = acc[ai][bj][m][0] + bv[bj][0], v1 = acc[ai][bj][m][1] + bv[bj][1];
#pragma unroll
                    for (int j = 0; j < 4; ++j) { v0[j] = sigmoidf_(v0[j]); v1[j] = sigmoidf_(v1[j]); }
                    u32x4 w; w.x = pk2(v0[0], v0[1]); w.y = pk2(v0[2], v0[3]); w.z = pk2(v1[0], v1[1]); w.w = pk2(v1[2], v1[3]);
                    *(u32x4*)(rowp + bj * 128) = w; } }
    }
};
template <int MODE  > struct EpiGate {
    static constexpr bool PERM = true, AFTER_DRAIN = false;
    const u16* sg; u16* tmp; u16* mrg;
    __device__ __forceinline__ void operator()(const f32x4 (&acc)[2][2][4][2], const pg8::Unit& u, int wr, int wc, int fr, int fq) const {
        const int row0 = u.pm * 256 + wr * 64 + fr, col0 = u.pn * 256 + wc * 32 + 8 * fq;
#pragma unroll
        for (int ai = 0; ai < 2; ++ai)
#pragma unroll
            for (int m = 0; m < 4; ++m) { const size_t off = (size_t)(row0 + ai * 128 + m * 16) * DM + col0;
#pragma unroll
                for (int bj = 0; bj < 2; ++bj) { const u32x4 s = *(const u32x4*)(sg + off + bj * 128);
                    f32x4 v0 = acc[ai][bj][m][0], v1 = acc[ai][bj][m][1];
                    v0[0] *= bflo(s.x); v0[1] *= bfhi(s.x); v0[2] *= bflo(s.y); v0[3] *= bfhi(s.y); v1[0] *= bflo(s.z); v1[1] *= bfhi(s.z); v1[2] *= bflo(s.w); v1[3] *= bfhi(s.w);
                    if (MODE == 1) { const u32x4 t = *(const u32x4*)(tmp + off + bj * 128);
                        v0[0] += bflo(t.x); v0[1] += bfhi(t.x); v0[2] += bflo(t.y); v0[3] += bfhi(t.y); v1[0] += bflo(t.z); v1[1] += bfhi(t.z); v1[2] += bflo(t.w); v1[3] += bfhi(t.w); }
                    u32x4 w; w.x = pk2(v0[0], v0[1]); w.y = pk2(v0[2], v0[3]); w.z = pk2(v1[0], v1[1]); w.w = pk2(v1[2], v1[3]);
                    *(u32x4*)((MODE == 0 ? tmp : mrg) + off + bj * 128) = w; } }
    }
};
struct EpiOut {
    static constexpr bool PERM = true, AFTER_DRAIN = false;
    const float* x; float* out;
    __device__ __forceinline__ void operator()(const f32x4 (&acc)[2][2][4][2], const pg8::Unit& u, int wr, int wc, int fr, int fq) const {
        const int row0 = u.pm * 256 + wr * 64 + fr, col0 = u.pn * 256 + wc * 32 + 8 * fq;
#pragma unroll
        for (int ai = 0; ai < 2; ++ai) {
            f32x4 xv[4][2][2];
#pragma unroll
            for (int m = 0; m < 4; ++m) { const size_t off = (size_t)(row0 + ai * 128 + m * 16) * DM + col0;
#pragma unroll
                for (int bj = 0; bj < 2; ++bj) { xv[m][bj][0] = *(const f32x4*)(x + off + bj * 128); xv[m][bj][1] = *(const f32x4*)(x + off + bj * 128 + 4); } }
            __builtin_amdgcn_sched_barrier(0);
#pragma unroll
            for (int m = 0; m < 4; ++m) { const size_t off = (size_t)(row0 + ai * 128 + m * 16) * DM + col0;
#pragma unroll
                for (int bj = 0; bj < 2; ++bj) { *(f32x4*)(out + off + bj * 128) = xv[m][bj][0] + acc[ai][bj][m][0]; *(f32x4*)(out + off + bj * 128 + 4) = xv[m][bj][1] + acc[ai][bj][m][1]; } }
            __builtin_amdgcn_sched_barrier(0);
        }
    }
};

typedef pg8::bf16x8 bf16x8;
__device__ __forceinline__ void load_conv(const u16* grow, float w0, float w1, float w2, float cb, u16* dst, int tid) {
#pragma unroll 2
    for (int k = 0; k < 8; ++k) { const int chunk = tid + 512 * k, b = chunk >> 8, t8 = (chunk & 255) * 8; const u16* p = grow + b * SEQ + t8;
        const u32x4 wq = __builtin_nontemporal_load((const u32x4*)p); const uint4 w = (uint4){wq.x, wq.y, wq.z, wq.w}; const float pm = t8 > 0 ? bf2f(p[-1]) : 0.f, pn = t8 + 8 < SEQ ? bf2f(p[8]) : 0.f;
        const float e0 = bflo(w.x), e1 = bfhi(w.x), e2 = bflo(w.y), e3 = bfhi(w.y), e4 = bflo(w.z), e5 = bfhi(w.z), e6 = bflo(w.w), e7 = bfhi(w.w);
        uint4 r; r.x = pk2(cb + w0 * pm + w1 * e0 + w2 * e1, cb + w0 * e0 + w1 * e1 + w2 * e2); r.y = pk2(cb + w0 * e1 + w1 * e2 + w2 * e3, cb + w0 * e2 + w1 * e3 + w2 * e4);
        r.z = pk2(cb + w0 * e3 + w1 * e4 + w2 * e5, cb + w0 * e4 + w1 * e5 + w2 * e6); r.w = pk2(cb + w0 * e5 + w1 * e6 + w2 * e7, cb + w0 * e6 + w1 * e7 + w2 * pn);
        *(uint4*)(dst + b * UP + t8) = r; }
}
__device__ __forceinline__ void build_kr(const u16* kb, u16* KR, int tid) {
#pragma unroll
    for (int k = 0; k < 8; ++k) { const int ch = tid + 512 * k, sg = ch >> 9, x8 = (ch & 511) * 8;
        u32x4u w = (u32x4u){0u, 0u, 0u, 0u};
        if (x8 != 0) w = *(const u32x4u*)(kb + x8 - sg);
        *(uint4*)(KR + sg * KRP + x8) = (uint4){w.x, w.y, w.z, w.w}; }
}
__device__ __forceinline__ void conv_mfma(PG8_LAS const unsigned char* KRb, PG8_LAS const unsigned char* Ub, int wid, int lane, f32x4 (&acc)[16]) {
    const int i = lane & 15, q = lane >> 4, T0 = wid * 16;
    const int abase = (i & 7) * (KRP * 2) + (8 * (q - (i >> 3)) + 2048) * 2;
    const int bbase = i * (UP * 2) + 16 * q;
#pragma unroll
    for (int t = 0; t < 16; ++t) acc[t] = (f32x4){0.f, 0.f, 0.f, 0.f};
#pragma unroll 1
    for (int sr = 0; sr < 4; ++sr) {
        const int S0 = sr * 16;
        bf16x8 Bf[16];
#pragma unroll
        for (int sl = 0; sl < 16; ++sl) Bf[sl] = *(PG8_LAS const bf16x8*)(Ub + bbase + 64 * (S0 + sl));
        PG8_LAS const unsigned char* ap = KRb + (abase - 32 * (T0 - 2 * S0) - 480);
#pragma unroll
        for (int dl = -30; dl <= 15; ++dl) {
            const bf16x8 a = *(PG8_LAS const bf16x8*)(ap + 32 * (15 - dl));
#pragma unroll
            for (int sl = 0; sl < 16; ++sl) { const int t = dl + 2 * sl; if (t >= 0 && t < 16) acc[t] = __builtin_amdgcn_mfma_f32_16x16x32_bf16(a, Bf[sl], acc[t], 0, 0, 0); }
        }
    }
}
__device__ __forceinline__ void hy_epilogue(const f32x4 (&acc)[16], const u16* X, u16* U, float skip, int wid, int lane) {
    const int b = lane & 15, q = lane >> 4;
#pragma unroll
    for (int tl = 0; tl < 16; ++tl) { const int t = 16 * (wid * 16 + tl) + 4 * q;
        const uint2 xv = *(const uint2*)(X + b * UP + t), uv = *(const uint2*)(U + b * UP + t); uint2 r;
        r.x = pk2(bflo(xv.x) * (acc[tl][0] + bflo(uv.x) * skip), bfhi(xv.x) * (acc[tl][1] + bfhi(uv.x) * skip));
        r.y = pk2(bflo(xv.y) * (acc[tl][2] + bflo(uv.y) * skip), bfhi(xv.y) * (acc[tl][3] + bfhi(uv.y) * skip));
        *(uint2*)(U + b * UP + t) = r; }
}
__device__ __forceinline__ unsigned touch64k(const u16* blk, int tid) { return *(const unsigned*)(blk + tid * 64); }
__device__ void hyena_mfma(const Frame& F, unsigned char* lds, bool do_store = true) {
    int tid = threadIdx.x; asm volatile("" : "+v"(tid));
    const int lane = tid & 63, wid = __builtin_amdgcn_readfirstlane(tid >> 6);
    u16* KR = (u16*)lds; u16* U = (u16*)(lds + 8 * KRP * 2);
    PG8_LAS const unsigned char* KRb = (PG8_LAS const unsigned char*)lds; PG8_LAS const unsigned char* Ub = KRb + 8 * KRP * 2;
    const u16* KB = (const u16*)(F.dob + DO_HF);
    u16* HYT = (u16*)(F.ws + WS_HYT);
    for (int c = blockIdx.x; c < HYW; c += gridDim.x) {
        const float wv0 = F.conv_w[c], wv1 = F.conv_w[NHY + c], wv2 = F.conv_w[2 * NHY + c], cbv = F.conv_b[c];
        const float wa0 = F.conv_w[HYW + c], wa1 = F.conv_w[NHY + HYW + c], wa2 = F.conv_w[2 * NHY + HYW + c], cba = F.conv_b[HYW + c];
        const float wb0 = F.conv_w[2 * HYW + c], wb1 = F.conv_w[NHY + 2 * HYW + c], wb2 = F.conv_w[2 * NHY + 2 * HYW + c], cbb = F.conv_b[2 * HYW + c];
        const float skip0 = F.skip[c], skip1 = F.skip[HYW + c];
        f32x4 acc[16];
        __syncthreads();
        load_conv(HYT + (size_t)c * MTOK, wv0, wv1, wv2, cbv, U, tid);
        build_kr(KB + (size_t)(0 * HYW + c) * KBL, KR, tid);
        unsigned tc0 = touch64k(HYT + (size_t)(HYW + c) * MTOK, tid), tc1 = tid < 65 ? touch64k(KB + (size_t)(HYW + c) * KBL, tid) : 0u;
        __syncthreads();
        conv_mfma(KRb, Ub, wid, lane, acc);
        asm volatile("" :: "v"(tc0), "v"(tc1));
        __syncthreads();
        load_conv(HYT + (size_t)(HYW + c) * MTOK, wa0, wa1, wa2, cba, KR, tid);
        __syncthreads();
        hy_epilogue(acc, KR, U, skip0, wid, lane);
        __syncthreads();
        build_kr(KB + (size_t)(1 * HYW + c) * KBL, KR, tid);
        { const int cn = c + (int)gridDim.x < HYW ? c + (int)gridDim.x : c;
          tc0 = touch64k(HYT + (size_t)(2 * HYW + c) * MTOK, tid); tc1 = touch64k(HYT + (size_t)cn * MTOK, tid); }
        __syncthreads();
        conv_mfma(KRb, Ub, wid, lane, acc);
        asm volatile("" :: "v"(tc0), "v"(tc1));
        __syncthreads();
        load_conv(HYT + (size_t)(2 * HYW + c) * MTOK, wb0, wb1, wb2, cbb, KR, tid);
        __syncthreads();
        hy_epilogue(acc, KR, U, skip1, wid, lane);
        __syncthreads();
        if (do_store)
#pragma unroll 2
        for (int k = 0; k < 8; ++k) { const int chunk = tid + 512 * k, b = chunk >> 8, t8 = (chunk & 255) * 8;
            __builtin_nontemporal_store(*(const u32x4*)(U + b * UP + t8), (u32x4*)(HYT + (size_t)c * MTOK + b * SEQ + t8)); }
    }
    __syncthreads();
}

constexpr size_t DO_LG = 111 * MiB;
__device__ __forceinline__ uint4 pk8(const float (&v)[8]) { uint4 r; r.x = pk2(v[0], v[1]); r.y = pk2(v[2], v[3]); r.z = pk2(v[4], v[5]); r.w = pk2(v[6], v[7]); return r; }
__device__ __forceinline__ void up8(const uint4 w, float (&v)[8]) { v[0] = bflo(w.x); v[1] = bfhi(w.x); v[2] = bflo(w.y); v[3] = bfhi(w.y); v[4] = bflo(w.z); v[5] = bfhi(w.z); v[6] = bflo(w.w); v[7] = bfhi(w.w); }
__device__ __forceinline__ bf16x8 as_frag(const uint4 w) { union { uint4 u; bf16x8 f; } c; c.u = w; return c.f; }
struct AChunk { uint4 k[2][2]; uint4 v[4]; };
typedef short s16x4 __attribute__((ext_vector_type(4)));
__device__ void attn_mfma(const Frame& F, unsigned char* lds, bool do_store = true) {
    int tid = threadIdx.x; asm volatile("" : "+v"(tid));
    const int lane = tid & 63, wid = __builtin_amdgcn_readfirstlane(tid >> 6), c16 = lane & 15, q = lane >> 4;
    u16* QKV = (u16*)(F.ws + WS_QKV); float* LG = (float*)(F.dob + DO_LG);
    unsigned char* Vs = lds + wid * 5120;
    PG8_LAS const unsigned char* Vs3 = (PG8_LAS const unsigned char*)Vs;
    const int krow_off = 8 * (c16 >> 2) + (c16 & 3);
    const int tr_off = (8 * q + (c16 >> 2)) * 144 + 8 * (lane & 3);
    const float LOG2E = 1.4426950408889634f;
    float gm = fabsf(F.qg[lane] * F.kg[lane]);
#pragma unroll
    for (int o = 32; o >= 1; o >>= 1) gm = fmaxf(gm, __shfl_xor(gm, o));
    const float cmax2 = 8.0f * gm * LOG2E;
    volatile PG8_LAS float* gqt = (volatile PG8_LAS float*)((PG8_LAS unsigned char*)lds + 8 * 5120);
    __syncthreads();
    if (tid < 64) gqt[tid] = F.qg[tid] * F.kg[tid] * (0.125f * LOG2E);
    __syncthreads();
    const int Gd = gridDim.x, vcu = (Gd % 8 == 0) ? ((int)blockIdx.x % 8) * (Gd / 8) + (int)blockIdx.x / 8 : (int)blockIdx.x;
    for (int item = vcu * 8 + wid; item < NB * 8 * 3 * 32; item += Gd * 8) {
        const int blk = item & 31, rest = item >> 5, g = rest % 3, bh = rest / 3, h = bh & 7, b = bh >> 3;
        const int dsh = 2 * g, n = SEQ >> dsh, nbn = 32 >> dsh, r = blk >> (5 - dsh), nb = blk & (nbn - 1);
        const float ca2 = exp2f(-(float)(h + 1)) * (float)(1 << dsh) * LOG2E;
        const size_t colq = (size_t)g * 512 + h * 64;
        const u16* base = QKV + (size_t)b * SEQ * NQKV;
        const int kc_lo = nb == 0 ? 2 : 0, kc_hi = nb == nbn - 1 ? 4 : 6;
        auto load_chunk = [&](AChunk& c, int j0c) {
#pragma unroll
            for (int kt = 0; kt < 2; ++kt) { int jk = j0c + 4 * kt + krow_off; jk = jk < 0 ? 0 : (jk > n - 1 ? n - 1 : jk);
                const u16* krow = base + (size_t)((jk << dsh) + r) * NQKV + 1536 + colq;
                c.k[kt][0] = *(const uint4*)(krow + 8 * q); c.k[kt][1] = *(const uint4*)(krow + 32 + 8 * q); }
            int jv = j0c + (lane >> 1); jv = jv < 0 ? 0 : (jv > n - 1 ? n - 1 : jv);
            const u16* vrow = base + (size_t)((jv << dsh) + r) * NQKV + 3072 + colq + 32 * (lane & 1);
#pragma unroll
            for (int v4 = 0; v4 < 4; ++v4) c.v[v4] = *(const uint4*)(vrow + 8 * v4);
        };
        AChunk cur;
        bf16x8 Qf[4][2];
#pragma unroll
        for (int qt = 0; qt < 4; ++qt) { const int i = 64 * nb + 16 * qt + c16; const u16* qrow = base + (size_t)((i << dsh) + r) * NQKV + colq;
            float v0[8], v1[8]; up8(*(const uint4*)(qrow + 8 * q), v0); up8(*(const uint4*)(qrow + 32 + 8 * q), v1);
            float ss = 0.f;
#pragma unroll
            for (int e = 0; e < 8; ++e) ss += v0[e] * v0[e] + v1[e] * v1[e];
            ss += __shfl_xor(ss, 16); ss += __shfl_xor(ss, 32);
            const float rq = rsqrtf(ss * (1.0f / 64.0f) + 1e-6f);
#pragma unroll
            for (int e = 0; e < 8; ++e) { v0[e] *= rq * gqt[8 * q + e]; v1[e] *= rq * gqt[32 + 8 * q + e]; }
            Qf[qt][0] = as_frag(pk8(v0)); Qf[qt][1] = as_frag(pk8(v1)); }
        f32x4 Oacc[4][4]; f32x4 Lacc[4];
#pragma unroll
        for (int dt = 0; dt < 4; ++dt)
#pragma unroll
            for (int qt = 0; qt < 4; ++qt) Oacc[dt][qt] = (f32x4){0.f, 0.f, 0.f, 0.f};
#pragma unroll
        for (int qt = 0; qt < 4; ++qt) Lacc[qt] = (f32x4){0.f, 0.f, 0.f, 0.f};
#pragma unroll 1
        for (int kc = kc_lo; kc < kc_hi; ++kc) {
            const int j0c = 64 * (nb - 1) + 32 * kc;
            load_chunk(cur, j0c);
            unsigned tch0 = 0, tch1 = 0;
            if (kc + 1 < kc_hi) {
                int jk = j0c + 32 + (lane >> 1); jk = jk < 0 ? 0 : (jk > n - 1 ? n - 1 : jk);
                const u16* rowp = base + (size_t)((jk << dsh) + r) * NQKV + colq + ((lane & 1) ? 3072 : 1536);
                tch0 = *(const unsigned*)rowp; }
            { unsigned char* dst = Vs + (lane >> 1) * 144 + (lane & 1) * 64;
#pragma unroll
              for (int v4 = 0; v4 < 4; ++v4) *(uint4*)(dst + 16 * v4) = cur.v[v4]; }
            bf16x8 kf[2][2];
#pragma unroll
            for (int kt = 0; kt < 2; ++kt) {
                float v0[8], v1[8]; up8(cur.k[kt][0], v0); up8(cur.k[kt][1], v1);
                float ss = 0.f;
#pragma unroll
                for (int e = 0; e < 8; ++e) ss += v0[e] * v0[e] + v1[e] * v1[e];
                ss += __shfl_xor(ss, 16); ss += __shfl_xor(ss, 32);
                const float rk = rsqrtf(ss * (1.0f / 64.0f) + 1e-6f);
#pragma unroll
                for (int e = 0; e < 8; ++e) { v0[e] *= rk; v1[e] *= rk; }
                kf[kt][0] = as_frag(pk8(v0)); kf[kt][1] = as_frag(pk8(v1)); }
            bf16x8 Pf[4];
            int rel0 = 64 + c16 - 8 * q - 32 * kc;
            asm volatile("" : "+v"(rel0));
            const float relf0 = (float)rel0;
            const bool edge = (kc < 2) || (kc > 3);
#pragma unroll
            for (int qt = 0; qt < 4; ++qt) { float p[8];
#pragma unroll
                for (int kt = 0; kt < 2; ++kt) { f32x4 z = (f32x4){-cmax2, -cmax2, -cmax2, -cmax2};
                    z = __builtin_amdgcn_mfma_f32_16x16x32_bf16(kf[kt][0], Qf[qt][0], z, 0, 0, 0);
                    z = __builtin_amdgcn_mfma_f32_16x16x32_bf16(kf[kt][1], Qf[qt][1], z, 0, 0, 0);
#pragma unroll
                    for (int j = 0; j < 4; ++j) { const float dist = fabsf(relf0 + (float)(16 * qt - 4 * kt - j));
                        const float pv = __builtin_amdgcn_exp2f(z[j] - ca2 * dist);
                        p[4 * kt + j] = (edge && dist > 64.0f) ? 0.f : pv; } }
                Pf[qt] = as_frag(pk8(p)); }
            asm volatile("" ::: "memory");
#pragma unroll
            for (int dt = 0; dt < 4; ++dt) {
                const s16x4 a0 = __builtin_amdgcn_ds_read_tr16_b64_v4i16((PG8_LAS s16x4*)(Vs3 + tr_off + 32 * dt));
                const s16x4 a1 = __builtin_amdgcn_ds_read_tr16_b64_v4i16((PG8_LAS s16x4*)(Vs3 + tr_off + 4 * 144 + 32 * dt));
                const bf16x8 vf = __builtin_shufflevector(a0, a1, 0, 1, 2, 3, 4, 5, 6, 7);
#pragma unroll
                for (int qt = 0; qt < 4; ++qt) Oacc[dt][qt] = __builtin_amdgcn_mfma_f32_16x16x32_bf16(vf, Pf[qt], Oacc[dt][qt], 0, 0, 0); }
            { const bf16x8 ones = (bf16x8){0x3F80, 0x3F80, 0x3F80, 0x3F80, 0x3F80, 0x3F80, 0x3F80, 0x3F80};
#pragma unroll
              for (int qt = 0; qt < 4; ++qt) Lacc[qt] = __builtin_amdgcn_mfma_f32_16x16x32_bf16(ones, Pf[qt], Lacc[qt], 0, 0, 0); }
            asm volatile("" :: "v"(tch0), "v"(tch1) : "memory");
        }
        if (do_store)
#pragma unroll
        for (int qt = 0; qt < 4; ++qt) { const int i = 64 * nb + 16 * qt + c16, tok = (i << dsh) + r;
            const float lt = Lacc[qt][0];
            u16* orow = QKV + (size_t)(b * SEQ + tok) * NQKV + colq;
#pragma unroll
            for (int dp = 0; dp < 2; ++dp) {
                const unsigned ax = pk2(Oacc[2 * dp][qt][0], Oacc[2 * dp][qt][1]), ay = pk2(Oacc[2 * dp][qt][2], Oacc[2 * dp][qt][3]);
                const unsigned bx = pk2(Oacc[2 * dp + 1][qt][0], Oacc[2 * dp + 1][qt][1]), by = pk2(Oacc[2 * dp + 1][qt][2], Oacc[2 * dp + 1][qt][3]);
                const auto r0 = __builtin_amdgcn_permlane16_swap(ax, bx, false, false);
                const auto r1 = __builtin_amdgcn_permlane16_swap(ay, by, false, false);
                const int doff = (q & 1) ? 16 * (2 * dp + 1) + 4 * (q - 1) : 16 * (2 * dp) + 4 * q;
                *(uint4*)(orow + doff) = make_uint4(r0[0], r1[0], r0[1], r1[1]); }
            if (q == 0) LG[((size_t)g * MTOK + b * SEQ + tok) * 8 + h] = lt; }
    }
    __syncthreads();
}
__device__ void attn_combine(const Frame& F) {
    const u16* QKV = (const u16*)(F.ws + WS_QKV); const float* LG = (const float*)(F.dob + DO_LG); u16* ATG = (u16*)(F.ws + WS_ATG);
    const int stride = gridDim.x * 512;
    for (int idx0 = blockIdx.x * 512 + F.tid; idx0 < MTOK * 64; idx0 += 4 * stride) {
        uint4 q0[4], q1[4], q2[4], gv[4]; float l0[4], l1[4], l2[4];
#pragma unroll
        for (int u = 0; u < 4; ++u) { const int idx = idx0 + u * stride;
            if (idx < MTOK * 64) { const int m = idx >> 6, cc = (idx & 63) * 8, h = cc >> 6; const u16* qrow = QKV + (size_t)m * NQKV + cc;
                q0[u] = *(const uint4*)qrow; q1[u] = *(const uint4*)(qrow + 512); q2[u] = *(const uint4*)(qrow + 1024); gv[u] = *(const uint4*)(ATG + (size_t)m * ATW + cc);
                l0[u] = LG[(size_t)m * 8 + h]; l1[u] = LG[((size_t)MTOK + m) * 8 + h]; l2[u] = LG[((size_t)2 * MTOK + m) * 8 + h]; } }
#pragma unroll
        for (int u = 0; u < 4; ++u) { const int idx = idx0 + u * stride;
            if (idx < MTOK * 64) { const int m = idx >> 6, cc = (idx & 63) * 8;
                float o0[8], o1[8], o2[8], gt[8]; up8(q0[u], o0); up8(q1[u], o1); up8(q2[u], o2); up8(gv[u], gt);
                const float il = 1.0f / (l0[u] + l1[u] + l2[u]);
#pragma unroll
                for (int e = 0; e < 8; ++e) o0[e] = (o0[e] + o1[e] + o2[e]) * il * gt[e];
                *(uint4*)(ATG + (size_t)m * ATW + cc) = pk8(o0); } }
    }
}

__device__ void p2b_transpose(const Frame& F, unsigned char* lds) {
    const int tid = F.tid; u16* tl = (u16*)lds;
    const u16* HYT = (const u16*)(F.ws + WS_HYT); const u16* HYG = (const u16*)(F.ws + WS_HYG); u16* YH = (u16*)(F.ws + WS_YH);
    const int cl = tid >> 3, mc = (tid & 7) * 8, ml = tid >> 3, cc = (tid & 7) * 8;
    for (int base = blockIdx.x; base < 12 * 512; base += 4 * gridDim.x) {
        u32x4 wq[4], gq[4];
#pragma unroll
        for (int u = 0; u < 4; ++u) { const int tile = base + u * gridDim.x;
            if (tile < 12 * 512) { const int c0 = (tile % 12) * 64, m0 = (tile / 12) * 64;
                wq[u] = __builtin_nontemporal_load((const u32x4*)(HYT + (size_t)(c0 + cl) * MTOK + m0 + mc));
                gq[u] = *(const u32x4*)(HYG + (size_t)(m0 + ml) * HYW + c0 + cc); } }
#pragma unroll
        for (int u = 0; u < 4; ++u) { const int tile = base + u * gridDim.x;
            if (tile < 12 * 512) { u16* t = tl + u * (64 * 72); const u32x4 w = wq[u];
                t[(mc + 0) * 72 + cl] = (u16)(w.x & 0xffff); t[(mc + 1) * 72 + cl] = (u16)(w.x >> 16); t[(mc + 2) * 72 + cl] = (u16)(w.y & 0xffff); t[(mc + 3) * 72 + cl] = (u16)(w.y >> 16);
                t[(mc + 4) * 72 + cl] = (u16)(w.z & 0xffff); t[(mc + 5) * 72 + cl] = (u16)(w.z >> 16); t[(mc + 6) * 72 + cl] = (u16)(w.w & 0xffff); t[(mc + 7) * 72 + cl] = (u16)(w.w >> 16); } }
        __syncthreads();
#pragma unroll
        for (int u = 0; u < 4; ++u) { const int tile = base + u * gridDim.x;
            if (tile < 12 * 512) { const int c0 = (tile % 12) * 64, m0 = (tile / 12) * 64; const u16* t = tl + u * (64 * 72);
                const uint4 y = *(const uint4*)&t[ml * 72 + cc]; const u32x4 g = gq[u];
                uint4 r; r.x = pk2(bflo(y.x) * bflo(g.x), bfhi(y.x) * bfhi(g.x)); r.y = pk2(bflo(y.y) * bflo(g.y), bfhi(y.y) * bfhi(g.y));
                r.z = pk2(bflo(y.z) * bflo(g.z), bfhi(y.z) * bfhi(g.z)); r.w = pk2(bflo(y.w) * bflo(g.w), bfhi(y.w) * bfhi(g.w));
                __builtin_nontemporal_store((u32x4){r.x, r.y, r.z, r.w}, (u32x4*)(YH + (size_t)(m0 + ml) * HYW + c0 + cc)); } }
        __syncthreads();
    }
    transpose_weight(F.w_out, DM, DM, (u16*)(F.ws + WS_WOUT), tl, tid);
}


__device__ unsigned g_bar[8 * 64 + 64 + 8 * 64];
__device__ __forceinline__ unsigned gb_ld(unsigned* p) { return __hip_atomic_load(p, __ATOMIC_RELAXED, __HIP_MEMORY_SCOPE_AGENT); }
__device__ __forceinline__ unsigned gb_add(unsigned* p) { return __hip_atomic_fetch_add(p, 1u, __ATOMIC_RELAXED, __HIP_MEMORY_SCOPE_AGENT); }
__device__ __forceinline__ void grid_bar() {
    asm volatile("s_waitcnt vmcnt(0) lgkmcnt(0)" ::: "memory");
    __syncthreads();
    if (threadIdx.x == 0) {
        __builtin_amdgcn_fence(__ATOMIC_RELEASE, "agent");
        asm volatile("s_waitcnt vmcnt(0)" ::: "memory");
        const unsigned G = gridDim.x, ng = (G % 8u == 0u) ? 8u : 1u, n = G / ng, g = blockIdx.x % ng;
        const unsigned old = gb_add(&g_bar[g * 64]), gen = old / n;
        if (old % n == n - 1u) {
            const unsigned t = gb_add(&g_bar[512]), want = (t / ng + 1u) * ng;
            while ((int)(gb_ld(&g_bar[512]) - want) < 0) __builtin_amdgcn_s_sleep(10);
            gb_add(&g_bar[576 + g * 64]);
        } else {
            while ((int)(gb_ld(&g_bar[576 + g * 64]) - (gen + 1u)) < 0) __builtin_amdgcn_s_sleep(40);
        }
        __builtin_amdgcn_fence(__ATOMIC_ACQUIRE, "agent");
        asm volatile("s_waitcnt vmcnt(0)" ::: "memory");
    }
    __syncthreads();
}

__global__ void __launch_bounds__(512) mk_fwd(Args args) {
    extern __shared__ __attribute__((aligned(16))) unsigned char lds[];
    cg::grid_group grid = cg::this_grid();
    Frame F;
    F.x = args.in[0]; F.norm_g = args.in[1]; F.w_in = args.in[2]; F.b_in = args.in[3]; F.conv_w = args.in[4]; F.conv_b = args.in[5];
    F.w1 = args.in[6]; F.b1 = args.in[7]; F.w2 = args.in[8]; F.b2 = args.in[9]; F.w3 = args.in[10]; F.b3 = args.in[11]; F.w4 = args.in[12]; F.freq = args.in[13];
    F.skip = args.in[14]; F.qg = args.in[15]; F.kg = args.in[16]; F.w_hy = args.in[17]; F.w_at = args.in[18]; F.w_out = args.in[19];
    F.out = args.out; F.ws = args.ws; F.dob = (unsigned char*)args.out;
    F.tid = threadIdx.x; F.lane = F.tid & 63; F.wid = __builtin_amdgcn_readfirstlane(F.tid >> 6);
    const int lo = args.ph_lo, hi = args.ph_hi;
    PG8_LAS unsigned char* ldsa = (PG8_LAS unsigned char*)lds;
    const int G = gridDim.x, c = blockIdx.x;
#ifdef ONLY
#define IN(k) ((k) == ONLY && lo <= (k) && (k) < hi)
#elif defined(SKIP)
#define IN(k) ((k) != SKIP && lo <= (k) && (k) < hi)
#else
#define IN(k) (lo <= (k) && (k) < hi)
#endif
#define SEAM(k) do { if (IN(k) && IN((k) + 1)) { if (hi > 100) grid.sync(); else grid_bar(); } } while (0)
#ifdef REPEAT
#define NREP(k) ((k) == REPEAT ? 2 : 1)
#else
#define NREP(k) 1
#endif
    if (IN(0)) for (int rep = 0; rep < NREP(0); ++rep) p0_prologue(F, lds);
    SEAM(0);
    if (IN(1)) for (int rep = 0; rep < NREP(1); ++rep) {
        pg8::Gemm g{(const u16*)(F.dob + DO_XN), (const u16*)(F.dob + DO_WIN), MTOK, 8192, DM}; pg8::StaticOrder S; S.init(MTOK, 8192, G, c);
        Epi1 E{(u16*)(F.ws + WS_HYT), (u16*)(F.ws + WS_QKV), (u16*)(F.ws + WS_HYG), (u16*)(F.ws + WS_ATG), F.b_in, ldsa + 131072};
        pg8::gemm_phase<Epi1, pg8::StaticOrder>(ldsa, g, S, E, nullptr);
    }
    SEAM(1);
    if (IN(2)) {
#if defined(REPEAT) && REPEAT == 2
        hyena_mfma(F, lds, hi > 100);
#endif
        hyena_mfma(F, lds);
#if defined(REPEAT) && REPEAT == 6
        attn_mfma(F, lds, hi > 100);
#endif
        attn_mfma(F, lds);
#if defined(REPEAT) && REPEAT == 7
        for (int k = 0; k < 5; ++k) grid.sync();
#endif
    }
    SEAM(2);
    if (IN(3)) { for (int rep = 0; rep < NREP(3); ++rep) p2b_transpose(F, lds); attn_combine(F); }
    SEAM(3);
    if (IN(4)) for (int rep = 0; rep < NREP(4); ++rep) {
        pg8::StaticOrder S; S.init(MTOK, DM, G, c);
        { pg8::Gemm g{(const u16*)(F.dob + DO_XN), (const u16*)(F.dob + DO_WIN) + (size_t)8192 * DM, MTOK, DM, DM}; EpiSig E{(u16*)(F.ws + WS_SG), F.b_in + 8192};
          pg8::gemm_phase<EpiSig, pg8::StaticOrder>(ldsa, g, S, E, nullptr); }
        { pg8::Gemm g{(const u16*)(F.ws + WS_YH), (const u16*)(F.dob + DO_WHY), MTOK, DM, HYW}; EpiGate<0> E{(const u16*)(F.ws + WS_SG), (u16*)(F.ws + WS_TMP), nullptr};
          pg8::gemm_phase<EpiGate<0>, pg8::StaticOrder>(ldsa, g, S, E, nullptr); }
        { pg8::Gemm g{(const u16*)(F.dob + DO_XN), (const u16*)(F.dob + DO_WIN) + (size_t)9216 * DM, MTOK, DM, DM}; EpiSig E{(u16*)(F.ws + WS_SG), F.b_in + 9216};
          pg8::gemm_phase<EpiSig, pg8::StaticOrder>(ldsa, g, S, E, nullptr); }
        { pg8::Gemm g{(const u16*)(F.ws + WS_ATG), (const u16*)(F.dob + DO_WAT), MTOK, DM, ATW}; EpiGate<1> E{(const u16*)(F.ws + WS_SG), (u16*)(F.ws + WS_TMP), (u16*)(F.ws + WS_MRG)};
          pg8::gemm_phase<EpiGate<1>, pg8::StaticOrder>(ldsa, g, S, E, nullptr); }
    }
    SEAM(4);
    if (IN(5)) for (int rep = 0; rep < NREP(5); ++rep) {
        pg8::Gemm g{(const u16*)(F.ws + WS_MRG), (const u16*)(F.ws + WS_WOUT), MTOK, DM, DM}; pg8::StaticOrder S; S.init(MTOK, DM, G, c);
        EpiOut E{F.x, F.out};
        pg8::gemm_phase<EpiOut, pg8::StaticOrder>(ldsa, g, S, E, nullptr);
    }
#undef IN
#undef SEAM
}

extern "C" void kernel_launch(void* const* d_in, const int* in_sizes, int n_in, void* d_out, int out_size, void* d_ws, size_t ws_size, hipStream_t stream) {
    static int grid = 0;
    if (grid == 0) {
        if (n_in != 20 || out_size != MTOK * DM || ws_size < WS_END) { fprintf(stderr, "kernel_launch: unexpected shapes (n_in %d out %d ws %zu)\n", n_in, out_size, ws_size); grid = -1; return; }
        int dev = 0, cus = 0, per_cu = 0;
        hipGetDevice(&dev); hipDeviceGetAttribute(&cus, hipDeviceAttributeMultiprocessorCount, dev);
        if (hipFuncSetAttribute((const void*)mk_fwd, hipFuncAttributeMaxDynamicSharedMemorySize, LDS_BYTES) != hipSuccess) { fprintf(stderr, "kernel_launch: hipFuncSetAttribute failed\n"); grid = -1; return; }
        if (hipOccupancyMaxActiveBlocksPerMultiprocessor(&per_cu, (const void*)mk_fwd, 512, LDS_BYTES) != hipSuccess || per_cu < 1) { fprintf(stderr, "kernel_launch: occupancy query failed (%d)\n", per_cu); per_cu = 1; }
        (void)hipGetLastError();
        grid = cus;
        if (grid != 256) fprintf(stderr, "kernel_launch: note: %d CUs\n", grid);
    }
    if (grid < 0) return;
    Args a{};
    for (int i = 0; i < 20; ++i) a.in[i] = (const float*)d_in[i];
    a.out = (float*)d_out; a.ws = (unsigned char*)d_ws;
#if ONE_LAUNCH
    a.ph_lo = 0; a.ph_hi = 6;
    void* kargs[] = {&a};
    hipError_t e = hipLaunchCooperativeKernel((const void*)mk_fwd, dim3(grid), dim3(512), kargs, LDS_BYTES, stream);
    if (e != hipSuccess) fprintf(stderr, "cooperative launch failed: %s (grid %d)\n", hipGetErrorString(e), grid);
#else
    for (int ph = 0; ph < 6; ++ph) { a.ph_lo = ph; a.ph_hi = ph + 1; hipLaunchKernelGGL(mk_fwd, dim3(grid), dim3(512), LDS_BYTES, stream, a); }
#endif
}
```

```cpp
#include <hip/hip_runtime.h>
#include <hip/hip_cooperative_groups.h>
#include <cstdio>
namespace cg = cooperative_groups;
namespace pg8 {
#define PG8_LAS __attribute__((address_space(3)))
typedef unsigned short bf16_t;
typedef short bf16x8 __attribute__((ext_vector_type(8)));
typedef float f32x4 __attribute__((ext_vector_type(4)));
typedef unsigned u32x4 __attribute__((ext_vector_type(4)));
constexpr int BM = 256, BK = 64, HALF = 128, HTB = HALF * BK * 2  , STAGE_BYTES = 8 * HTB, NXCD = 8, WGM = 8;

__host__ __device__ __forceinline__ int lds_byte(int r, int c) { const int st = (r >> 4) * 2 + (c >> 5), rr = r & 15, cc = c & 31, ob = rr * 64 + cc * 2; return st * 1024 + (ob ^ (((ob >> 9) & 1) << 5)); }
__host__ __device__ __forceinline__ void stage_rc(int b, int& R, int& C) { const int st = b / 1024, sb = b % 1024, swz = sb ^ (((sb >> 9) & 1) << 5); R = (st >> 1) * 16 + swz / 64; C = (st & 1) * 32 + (swz % 64) / 2; }
__host__ __device__ __forceinline__ int perm32(int rho) { const int n = rho >> 4, i = rho & 15; return 8 * (i >> 2) + 4 * n + (i & 3); }

struct Unit { int pm, pn; };
struct Gemm { const bf16_t* A; const bf16_t* Bt; int M, N, K; };

struct StaticOrder {
    int nM, nN, nwg, G, c;
    __host__ __device__ void init(int M, int N, int G_, int c_) { nM = M / BM; nN = N / BM; nwg = nM * nN; G = G_; c = c_; }
    __host__ __device__ bool next(int i, Unit& u) const {
        const long L = (long)i * G + c; if (L >= nwg) return false;
        int wgid = (int)L; { const int q = nwg / NXCD, r = nwg % NXCD, xcd = wgid % NXCD, off = wgid / NXCD; wgid = (xcd < r ? xcd * (q + 1) : r * (q + 1) + (xcd - r) * q) + off; }
        const int nig = WGM * nN, gid = wgid / nig, fm = gid * WGM, gsz = (nM - fm) < WGM ? (nM - fm) : WGM;
        u.pm = fm + ((wgid % nig) % gsz); u.pn = (wgid % nig) / gsz; return true;
    }
    __device__ __forceinline__ void a_ready(const Unit&) const {}
    __device__ __forceinline__ void done(const Unit&) const {}
};
__device__ __forceinline__ unsigned cvt_pk_bf16(float lo, float hi) { unsigned r; asm volatile("v_cvt_pk_bf16_f32 %0, %1, %2" : "=v"(r) : "v"(lo), "v"(hi)); return r; }
typedef float f32x2 __attribute__((ext_vector_type(2)));
template <class Epi, class Sched, bool STAMP = false>
__device__ __forceinline__ void gemm_phase(PG8_LAS unsigned char* lds, const Gemm g, const Sched& S, const Epi& E, unsigned long long* stamps) {
    int tid_ = threadIdx.x; asm volatile("" : "+v"(tid_));
    const int tid = tid_, wid = __builtin_amdgcn_readfirstlane(tid >> 6), lane = tid & 63, wr = wid >> 2, wc = wid & 3, fr = lane & 15, fq = lane >> 4;
    const int K = g.K, nt = K / BK;
    int ts_lo = 0, ts_hi = 0, nts = 0; const unsigned long long rt_entry = STAMP ? (unsigned long long)wall_clock64() : 0ull;
#define PG8_STAMP() do { if (STAMP && wid == 0 && nts < 64) { const unsigned long long _c = (unsigned long long)clock64(); \
        ts_lo = (lane == nts) ? (int)(unsigned)_c : ts_lo; ts_hi = (lane == nts) ? (int)(unsigned)(_c >> 32) : ts_hi; ++nts; } } while (0)
    PG8_STAMP();
    unsigned voffA[2], voffB[2];
#pragma unroll
    for (int i = 0; i < 2; ++i) { int R, C; stage_rc(tid * 16 + i * 8192, R, C); const int Rb = Epi::PERM ? ((R & ~31) + perm32(R & 31)) : R;
        voffA[i] = (unsigned)(R * K + C) * 2u; voffB[i] = (unsigned)(Rb * K + C) * 2u; }
    const size_t kstep = (size_t)(BK * 2);
    const size_t hstep = (size_t)HALF * K * 2;
    const size_t tstep = 2 * hstep;
    const unsigned ldsw = (unsigned)wid * 1024u;
    const int aoff = lds_byte(wr * 64 + fr, fq * 8), boff = lds_byte(wc * 32 + fr, fq * 8);
#define PG8_SA(b, h) (((b) * 2 + (h)) * HTB)
#define PG8_SB(b, h) ((4 + (b) * 2 + (h)) * HTB)
#define PG8_STAGE(bufoff, gbase, voff) do { _Pragma("unroll") for (int _i = 0; _i < 2; ++_i) \
        __builtin_amdgcn_global_load_lds((const unsigned*)((const char*)(gbase) + (voff)[_i]), (PG8_LAS unsigned*)(lds + (bufoff) + ldsw + _i * 8192), 16, 0, 0); } while (0)
#define PG8_LDA(dst, b, h) do { _Pragma("unroll") for (int m = 0; m < 4; ++m) _Pragma("unroll") for (int k = 0; k < 2; ++k) dst[m][k] = *(const PG8_LAS bf16x8*)(lds + PG8_SA(b, h) + aoff + m * 2048 + k * 1024); } while (0)
#define PG8_LDB(dst, b, h) do { _Pragma("unroll") for (int n = 0; n < 2; ++n) _Pragma("unroll") for (int k = 0; k < 2; ++k) dst[n][k] = *(const PG8_LAS bf16x8*)(lds + PG8_SB(b, h) + boff + n * 2048 + k * 1024); } while (0)
#define PG8_MMA(ai, bj, At, Bt) do { __builtin_amdgcn_s_setprio(1); _Pragma("unroll") for (int m = 0; m < 4; ++m) _Pragma("unroll") for (int n = 0; n < 2; ++n) _Pragma("unroll") for (int k = 0; k < 2; ++k) \
        acc[ai][bj][m][n] = __builtin_amdgcn_mfma_f32_16x16x32_bf16(Bt[n][k], At[m][k], acc[ai][bj][m][n], 0, 0, 0); __builtin_amdgcn_s_setprio(0); } while (0)
#define PG8_WAIT_V(n) asm volatile("s_waitcnt vmcnt(" #n ")" ::: "memory")
#define PG8_WAIT_L(n) asm volatile("s_waitcnt lgkmcnt(" #n ")" ::: "memory")
#define PG8_BAR __builtin_amdgcn_s_barrier()
#define PG8_SCHED __builtin_amdgcn_sched_barrier(0)
    Unit cur, nxt; int ui = 0;
    if (!S.next(0, cur)) return;
    f32x4 acc[2][2][4][2];
#pragma unroll
    for (int a = 0; a < 2; ++a)
#pragma unroll
        for (int b = 0; b < 2; ++b)
#pragma unroll
            for (int m = 0; m < 4; ++m)
#pragma unroll
                for (int n = 0; n < 2; ++n) acc[a][b][m][n] = (f32x4){0.f, 0.f, 0.f, 0.f};
    bf16x8 At[4][2], B0[2][2], B1[2][2];
    const char* cA = (const char*)g.A + (size_t)cur.pm * tstep; const char* cB = (const char*)g.Bt + (size_t)cur.pn * tstep;
    S.a_ready(cur);
    PG8_STAGE(PG8_SB(0, 0), cB, voffB); PG8_STAGE(PG8_SA(0, 0), cA, voffA); PG8_STAGE(PG8_SB(0, 1), cB + hstep, voffB); PG8_STAGE(PG8_SA(0, 1), cA + hstep, voffA);
    if (wr == 1) PG8_BAR;
    PG8_WAIT_V(4); PG8_BAR;
    PG8_STAGE(PG8_SB(1, 0), cB + kstep, voffB); PG8_STAGE(PG8_SA(1, 0), cA + kstep, voffA); PG8_STAGE(PG8_SB(1, 1), cB + hstep + kstep, voffB);
    PG8_WAIT_V(6); PG8_BAR;
    PG8_STAMP();
    for (;;) {
        const bool has_next = S.next(ui + 1, nxt);
        const char* nA = has_next ? (const char*)g.A + (size_t)nxt.pm * tstep : cA; const char* nB = has_next ? (const char*)g.Bt + (size_t)nxt.pn * tstep : cB;
        for (int t = 0; t < nt; t += 2) {
            const bool last = (t == nt - 2);
            const char* a1 = cA + (size_t)(t + 1) * kstep;
            const char* a2 = last ? nA : cA + (size_t)(t + 2) * kstep; const char* b2 = last ? nB : cB + (size_t)(t + 2) * kstep;
            const char* a3 = a2 + kstep; const char* b3 = b2 + kstep;
            if (last && has_next) S.a_ready(nxt);
            PG8_LDB(B0, 0, 0); PG8_SCHED; PG8_LDA(At, 0, 0); PG8_STAGE(PG8_SA(1, 1), a1 + hstep, voffA);
            PG8_WAIT_L(8); PG8_BAR; PG8_WAIT_L(0); PG8_MMA(0, 0, At, B0); PG8_BAR; PG8_SCHED;
            PG8_LDB(B1, 0, 1); PG8_STAGE(PG8_SB(0, 0), b2, voffB);
            PG8_BAR; PG8_WAIT_L(0); PG8_MMA(0, 1, At, B1); PG8_BAR;
            PG8_LDA(At, 0, 1); PG8_STAGE(PG8_SA(0, 0), a2, voffA);
            PG8_BAR; PG8_WAIT_L(0); PG8_MMA(1, 0, At, B0); PG8_BAR; PG8_SCHED;
            PG8_STAGE(PG8_SB(0, 1), b2 + hstep, voffB);
            PG8_WAIT_V(6); PG8_BAR; PG8_MMA(1, 1, At, B1); PG8_BAR;
            PG8_LDB(B0, 1, 0); PG8_SCHED; PG8_LDA(At, 1, 0); PG8_STAGE(PG8_SA(0, 1), a2 + hstep, voffA);
            PG8_WAIT_L(8); PG8_BAR; PG8_WAIT_L(0); PG8_MMA(0, 0, At, B0); PG8_BAR; PG8_SCHED;
            PG8_LDB(B1, 1, 1); PG8_STAGE(PG8_SB(1, 0), b3, voffB);
            PG8_BAR; PG8_WAIT_L(0); PG8_MMA(0, 1, At, B1); PG8_BAR;
            PG8_LDA(At, 1, 1); PG8_STAGE(PG8_SA(1, 0), a3, voffA);
            PG8_BAR; PG8_WAIT_L(0); PG8_MMA(1, 0, At, B0); PG8_BAR; PG8_SCHED;
            PG8_STAGE(PG8_SB(1, 1), b3 + hstep, voffB);
            PG8_WAIT_V(6); PG8_BAR; PG8_MMA(1, 1, At, B1); PG8_BAR;
        }
        PG8_STAMP();
        if constexpr (!Epi::AFTER_DRAIN) { E(acc, cur, wr, wc, fr, fq); S.done(cur); }
        PG8_STAMP();
        if (!has_next) break;
#pragma unroll
        for (int a = 0; a < 2; ++a)
#pragma unroll
            for (int b = 0; b < 2; ++b)
#pragma unroll
                for (int m = 0; m < 4; ++m)
#pragma unroll
                    for (int n = 0; n < 2; ++n) acc[a][b][m][n] = (f32x4){0.f, 0.f, 0.f, 0.f};
        cur = nxt; cA = nA; cB = nB; ++ui;
    }
    PG8_WAIT_V(0);
    if (wr == 0) PG8_BAR;
    PG8_BAR;
    if constexpr (Epi::AFTER_DRAIN) { E.fused(acc, cur, wr, wc, fr, fq, lds, wid, lane); S.done(cur); }
    PG8_STAMP();
    if (STAMP && wid == 0) { stamps[lane] = lane < nts ? (((unsigned long long)(unsigned)ts_hi << 32) | (unsigned)ts_lo) : 0ull;
        if (lane == 62) stamps[62] = rt_entry; if (lane == 63) stamps[63] = (unsigned long long)wall_clock64(); }
#undef PG8_STAMP
#undef PG8_SA
#undef PG8_SB
#undef PG8_STAGE
#undef PG8_LDA
#undef PG8_LDB
#undef PG8_MMA
#undef PG8_WAIT_V
#undef PG8_WAIT_L
#undef PG8_BAR
#undef PG8_SCHED
}
}

#ifndef ONE_LAUNCH
#define ONE_LAUNCH 1
#endif
typedef unsigned short u16;
typedef pg8::f32x4 f32x4;
typedef pg8::u32x4 u32x4;
constexpr int MTOK = 32768, DM = 1024, SEQ = 2048, NB = 16, HYW = 768, NHY = 2304, NQKV = 4608, ATW = 512;
constexpr size_t MiB = 1024 * 1024;
constexpr size_t WS_HYT = 0;
constexpr size_t WS_QKV = 144 * MiB;
constexpr size_t WS_HYG = 432 * MiB;
constexpr size_t WS_ATG = 480 * MiB;
constexpr size_t WS_END = 512 * MiB;
constexpr size_t WS_YH = WS_HYT + 48 * MiB, WS_WOUT = WS_HYT + 96 * MiB;
constexpr size_t WS_SG = WS_QKV, WS_TMP = WS_QKV + 64 * MiB, WS_MRG = WS_QKV + 192 * MiB;
constexpr size_t DO_XN = 0, DO_WIN = 64 * MiB, DO_WHY = 84 * MiB, DO_WAT = DO_WHY + 1536 * 1024, DO_HF = 87 * MiB;
constexpr int LDS_BYTES = 144 * 1024;
constexpr int KBL = 4104;
constexpr int KRP = 4112;
constexpr int UP = 2056;

struct Args { const float* in[20]; float* out; unsigned char* ws; int ph_lo, ph_hi; };
struct Frame {
    const float *x, *norm_g, *w_in, *b_in, *conv_w, *conv_b, *w1, *b1, *w2, *b2, *w3, *b3, *w4, *freq, *skip, *qg, *kg, *w_hy, *w_at, *w_out;
    float* out; unsigned char* ws; unsigned char* dob;
    int tid, lane, wid;
};

__device__ __forceinline__ u16 f2bf(float f) { unsigned u = __float_as_uint(f); u += 0x7FFFu + ((u >> 16) & 1u); return (u16)(u >> 16); }
__device__ __forceinline__ float bf2f(u16 b) { return __uint_as_float(((unsigned)b) << 16); }
__device__ __forceinline__ float bflo(unsigned w) { return __uint_as_float(w << 16); }
__device__ __forceinline__ float bfhi(unsigned w) { return __uint_as_float(w & 0xffff0000u); }
typedef float f32x2v __attribute__((ext_vector_type(2)));
typedef __bf16 bf16x2v __attribute__((ext_vector_type(2)));
__device__ __forceinline__ unsigned pk2(float lo, float hi) { const f32x2v v = {lo, hi}; return __builtin_bit_cast(unsigned, __builtin_convertvector(v, bf16x2v)); }
__device__ __forceinline__ float sigmoidf_(float v) { return __builtin_amdgcn_rcpf(1.0f + __builtin_amdgcn_exp2f(-1.4426950408889634f * v)); }
__device__ __forceinline__ float siluf_(float v) { return v * __builtin_amdgcn_rcpf(1.0f + __builtin_amdgcn_exp2f(-1.4426950408889634f * v)); }

typedef unsigned u32x4u __attribute__((ext_vector_type(4), aligned(2)));
__device__ __forceinline__ void transpose_tile_f32(const float* src, int K, int N, u16* dst, int k0, int n0, u16* tile, int tid) {
    const int kl = tid >> 3, nc = (tid & 7) * 8;
    const float4* p = (const float4*)(src + (size_t)(k0 + kl) * N + n0 + nc);
    const float4* p2 = (const float4*)(src + (size_t)(k0 + 64 + kl) * N + n0 + nc);
    const float4 a = p[0], b = p[1], c = p2[0], d = p2[1];
    tile[(nc + 0) * 136 + kl] = f2bf(a.x); tile[(nc + 1) * 136 + kl] = f2bf(a.y); tile[(nc + 2) * 136 + kl] = f2bf(a.z); tile[(nc + 3) * 136 + kl] = f2bf(a.w);
    tile[(nc + 4) * 136 + kl] = f2bf(b.x); tile[(nc + 5) * 136 + kl] = f2bf(b.y); tile[(nc + 6) * 136 + kl] = f2bf(b.z); tile[(nc + 7) * 136 + kl] = f2bf(b.w);
    tile[(nc + 0) * 136 + 64 + kl] = f2bf(c.x); tile[(nc + 1) * 136 + 64 + kl] = f2bf(c.y); tile[(nc + 2) * 136 + 64 + kl] = f2bf(c.z); tile[(nc + 3) * 136 + 64 + kl] = f2bf(c.w);
    tile[(nc + 4) * 136 + 64 + kl] = f2bf(d.x); tile[(nc + 5) * 136 + 64 + kl] = f2bf(d.y); tile[(nc + 6) * 136 + 64 + kl] = f2bf(d.z); tile[(nc + 7) * 136 + 64 + kl] = f2bf(d.w);
    __syncthreads();
    const int nl = tid >> 3, kc = (tid & 7) * 16;
    const uint4 w0 = *(const uint4*)&tile[nl * 136 + kc], w1 = *(const uint4*)&tile[nl * 136 + kc + 8];
    uint4* dp = (uint4*)(dst + (size_t)(n0 + nl) * K + k0 + kc); dp[0] = w0; dp[1] = w1;
    __syncthreads();
}
__device__ void transpose_weight(const float* src, int K, int N, u16* dst, u16* tile, int tid) {
    const int nkt = K / 128, nnt = N / 64;
    for (int t = blockIdx.x; t < nkt * nnt; t += gridDim.x) transpose_tile_f32(src, K, N, dst, (t % nkt) * 128, (t / nkt) * 64, tile, tid);
}

__device__ __forceinline__ void bar4(PG8_LAS unsigned* cnt, unsigned& target, int lane) {
    asm volatile("s_waitcnt lgkmcnt(0)" ::: "memory");
    target += 4u;
    if (lane == 0) {
        __hip_atomic_fetch_add(cnt, 1u, __ATOMIC_RELAXED, __HIP_MEMORY_SCOPE_WORKGROUP);
        while (__hip_atomic_load(cnt, __ATOMIC_RELAXED, __HIP_MEMORY_SCOPE_WORKGROUP) < target) __builtin_amdgcn_s_sleep(1);
    }
    asm volatile("" ::: "memory");
}
__device__ void p0_prologue(const Frame& F, unsigned char* lds) {
    const int tid = F.tid, lane = F.lane, wid = F.wid;
    u16* tile = (u16*)lds;
    transpose_weight(F.w_in, DM, 10240, (u16*)(F.dob + DO_WIN), tile, tid);
    transpose_weight(F.w_hy, HYW, DM, (u16*)(F.dob + DO_WHY), tile, tid);
    transpose_weight(F.w_at, ATW, DM, (u16*)(F.dob + DO_WAT), tile, tid);
    PG8_LAS unsigned* cnt = (PG8_LAS unsigned*)((PG8_LAS unsigned char*)lds + 65536);
    __syncthreads();
    if (tid == 0) *(volatile PG8_LAS unsigned*)cnt = 0u;
    __syncthreads();
    if (wid >= 4) {
        u16* XN = (u16*)(F.dob + DO_XN);
        for (int row = (blockIdx.x * 4 + (wid - 4)) * 4; row < MTOK; row += gridDim.x * 16) {
            const f32x4* xr = (const f32x4*)(F.x + (size_t)row * DM);
            f32x4 v[16]; float ss[4];
#pragma unroll
            for (int i = 0; i < 16; ++i) v[i] = __builtin_nontemporal_load(xr + lane + 64 * i);
#pragma unroll
            for (int r = 0; r < 4; ++r) { ss[r] = 0.f;
#pragma unroll
                for (int i = 0; i < 4; ++i) { const f32x4 t = v[4 * r + i]; ss[r] += t.x * t.x + t.y * t.y + t.z * t.z + t.w * t.w; } }
#pragma unroll
            for (int o = 32; o >= 1; o >>= 1) {
#pragma unroll
                for (int r = 0; r < 4; ++r) ss[r] += __shfl_xor(ss[r], o); }
#pragma unroll
            for (int i = 0; i < 4; ++i) { const float4 g = ((const float4*)F.norm_g)[lane + 64 * i];
#pragma unroll
                for (int r = 0; r < 4; ++r) { const float rs = rsqrtf(ss[r] * (1.0f / DM) + 1e-6f); const f32x4 t = v[4 * r + i];
                    uint2 w; w.x = pk2(t.x * rs * g.x, t.y * rs * g.y); w.y = pk2(t.z * rs * g.z, t.w * rs * g.w);
                    *(uint2*)(XN + (size_t)(row + r) * DM + 4 * (lane + 64 * i)) = w; } }
        }
    } else {
        unsigned target = 0u;
        u16* KB = (u16*)(F.dob + DO_HF);
        float* zs = (float*)lds;
        float* ha = zs + 8 * 40;
        float* hb = ha + 8 * 64;
        float* ws1 = hb + 8 * 64;
        float* ws2 = ws1 + 33 * 64;
        float* ws3 = ws2 + 64 * 64;
        for (int e = tid; e < 33 * 16; e += 256) ((float4*)ws1)[e] = ((const float4*)F.w1)[e];
        for (int e = tid; e < 64 * 16; e += 256) { ((float4*)ws2)[e] = ((const float4*)F.w2)[e]; ((float4*)ws3)[e] = ((const float4*)F.w3)[e]; }
        for (int blk = blockIdx.x; blk < SEQ / 8; blk += gridDim.x) {
            const int t0 = blk * 8;
            bar4(cnt, target, lane);
            for (int e = tid; e < 8 * 33; e += 256) { const int p = e / 33, i = e % 33; const float tt = (float)(t0 + p);
                float val;
                if (i == 0) val = tt * (1.0f / 2047.0f);
                else { const int j = (i - 1) & 15; const float f = 1e-4f + (float)j * ((15.0f - 1e-4f) / 15.0f); const float w = 6.283185307179586f * tt * (1.0f / 2048.0f); const float a = f * w;
                    val = (i <= 16) ? cosf(a) : -sinf(a); }
                zs[p * 40 + i] = val; }
            bar4(cnt, target, lane);
            const int p0 = tid >> 6, j = tid & 63; const float fr = F.freq[j];
#pragma unroll 1
            for (int pp = p0; pp < 8; pp += 4) { float a = F.b1[j];
#pragma unroll 3
                for (int i = 0; i < 33; ++i) a += zs[pp * 40 + i] * ws1[i * 64 + j]; ha[pp * 64 + j] = sinf(fr * a); }
            bar4(cnt, target, lane);
#pragma unroll 1
            for (int pp = p0; pp < 8; pp += 4) { float a = F.b2[j];
#pragma unroll 4
                for (int i = 0; i < 64; ++i) a += ha[pp * 64 + i] * ws2[i * 64 + j]; hb[pp * 64 + j] = sinf(fr * a); }
            bar4(cnt, target, lane);
#pragma unroll 1
            for (int pp = p0; pp < 8; pp += 4) { float a = F.b3[j];
#pragma unroll 4
                for (int i = 0; i < 64; ++i) a += hb[pp * 64 + i] * ws3[i * 64 + j]; ha[pp * 64 + j] = sinf(fr * a); }
            bar4(cnt, target, lane);
#pragma unroll 1
            for (int col = tid; col < 3072; col += 256) {
                float acc[8];
#pragma unroll
                for (int q = 0; q < 8; ++q) acc[q] = 0.f;
                float wv[64];
#pragma unroll
                for (int k = 0; k < 64; ++k) wv[k] = F.w4[k * 3072 + col];
                int hoff = 0; asm volatile("" : "+v"(hoff));
#pragma unroll
                for (int k4 = 0; k4 < 16; ++k4)
#pragma unroll
                    for (int q = 0; q < 8; ++q) { const float4 h = *(const float4*)&ha[hoff + q * 64 + 4 * k4];
                        acc[q] += h.x * wv[4 * k4] + h.y * wv[4 * k4 + 1] + h.z * wv[4 * k4 + 2] + h.w * wv[4 * k4 + 3]; }
                const int o = col / 1536, d = (col % 1536) / 768, c = col % 768;
                const float dmin = 3.0701134573253944f, dmax = 15.350567286626972f;
                const float ad = dmin + (float)c * ((dmax - dmin) / 767.0f);
#pragma unroll
                for (int q = 0; q < 8; ++q) acc[q] *= expf(-((float)(t0 + q) * (1.0f / 2047.0f)) * ad);
                u16* kb = KB + (size_t)(o * HYW + c) * KBL;
                if (d == 0) { u32x4u w; w.x = pk2(acc[7], acc[6]); w.y = pk2(acc[5], acc[4]); w.z = pk2(acc[3], acc[2]); w.w = pk2(acc[1], acc[0]);
                    *(u32x4u*)(kb + 2041 - t0) = w;
                    if (t0 == 0) { kb[0] = 0;
#pragma unroll
                        for (int q = 0; q < 8; ++q) kb[4096 + q] = 0; } }
                else if (t0 > 0) { u32x4u w; w.x = pk2(acc[0], acc[1]); w.y = pk2(acc[2], acc[3]); w.z = pk2(acc[4], acc[5]); w.w = pk2(acc[6], acc[7]); *(u32x4u*)(kb + 2048 + t0) = w; }
                else {
#pragma unroll
                    for (int q = 1; q < 8; ++q) kb[2048 + q] = f2bf(acc[q]); }
            }
        }
    }
    __syncthreads();
}

template <int ACT> __device__ __forceinline__ void store_rm(const f32x4 (&acc)[2][2][4][2], const f32x4 (&bv)[2][2], u16* base, int ldc, int row0, int col0) {
#pragma unroll
    for (int ai = 0; ai < 2; ++ai)
#pragma unroll
        for (int m = 0; m < 4; ++m) { u16* rowp = base + (size_t)(row0 + ai * 128 + m * 16) * ldc + col0;
#pragma unroll
            for (int bj = 0; bj < 2; ++bj) { f32x4 v0 = acc[ai][bj][m][0] + bv[bj][0], v1 = acc[ai][bj][m][1] + bv[bj][1];
                if (ACT) {
#pragma unroll
                    for (int j = 0; j < 4; ++j) { v0[j] = siluf_(v0[j]); v1[j] = siluf_(v1[j]); } }
                u32x4 w; w.x = pk2(v0[0], v0[1]); w.y = pk2(v0[2], v0[3]); w.z = pk2(v1[0], v1[1]); w.w = pk2(v1[2], v1[3]);
                __builtin_nontemporal_store(w, (u32x4*)(rowp + bj * 128)); } }
}
struct Epi1 {
    static constexpr bool PERM = true, AFTER_DRAIN = false;
    u16 *hyt, *qkv, *hyg, *atg; const float* bias; PG8_LAS unsigned char* tr;
    __device__ __forceinline__ void operator()(const f32x4 (&acc)[2][2][4][2], const pg8::Unit& u, int wr, int wc, int fr, int fq) const {
        const int row0 = u.pm * 256 + wr * 64 + fr, colg = u.pn * 256 + wc * 32 + 8 * fq;
        f32x4 bv[2][2];
#pragma unroll
        for (int bj = 0; bj < 2; ++bj)
#pragma unroll
            for (int n = 0; n < 2; ++n) bv[bj][n] = *(const f32x4*)(bias + colg + bj * 128 + 4 * n);
        if (u.pn < 9) {
            const int lane = fr + 16 * fq;
            PG8_LAS unsigned char* T = tr + (wr * 4 + wc) * 2048;
            const int colw = u.pn * 256 + wc * 32, roww = u.pm * 256 + wr * 64;
#pragma unroll
            for (int ai = 0; ai < 2; ++ai)
#pragma unroll
                for (int mp = 0; mp < 2; ++mp)
#pragma unroll
                    for (int bj = 0; bj < 2; ++bj) {
#pragma unroll
                        for (int mm = 0; mm < 2; ++mm)
#pragma unroll
                            for (int n = 0; n < 2; ++n) { const f32x4 v = acc[ai][bj][2 * mp + mm][n] + bv[bj][n];
#pragma unroll
                                for (int j = 0; j < 4; ++j) *(PG8_LAS u16*)(T + (8 * fq + 4 * n + j) * 64 + (16 * mm + fr) * 2) = f2bf(v[j]); }
                        asm volatile("s_waitcnt lgkmcnt(0)" ::: "memory");
                        const u32x4 w0 = *(PG8_LAS const u32x4*)(T + (lane >> 1) * 64 + (lane & 1) * 32), w1 = *(PG8_LAS const u32x4*)(T + (lane >> 1) * 64 + (lane & 1) * 32 + 16);
                        u16* dst = hyt + (size_t)(colw + bj * 128 + (lane >> 1)) * MTOK + roww + ai * 128 + 32 * mp + 16 * (lane & 1);
                        __builtin_nontemporal_store(w0, (u32x4*)dst); __builtin_nontemporal_store(w1, (u32x4*)(dst + 8));
                        asm volatile("" ::: "memory");
                    }
            return;
        }
        if (u.pn < 12) store_rm<1>(acc, bv, hyg, HYW, row0, colg - 2304);
        else if (u.pn < 30) store_rm<0>(acc, bv, qkv, NQKV, row0, colg - 3072);
        else store_rm<1>(acc, bv, atg, ATW, row0, colg - 7680);
    }
};
struct EpiSig {
    static constexpr bool PERM = true, AFTER_DRAIN = false;
    u16* sg; const float* bias;
    __device__ __forceinline__ void operator()(const f32x4 (&acc)[2][2][4][2], const pg8::Unit& u, int wr, int wc, int fr, int fq) const {
        const int row0 = u.pm * 256 + wr * 64 + fr, col0 = u.pn * 256 + wc * 32 + 8 * fq;
        f32x4 bv[2][2];
#pragma unroll
        for (int bj = 0; bj < 2; ++bj)
#pragma unroll
            for (int n = 0; n < 2; ++n) bv[bj][n] = *(const f32x4*)(bias + col0 + bj * 128 + 4 * n);
#pragma unroll
        for (int ai = 0; ai < 2; ++ai)
#pragma unroll
            for (int m = 0; m < 4; ++m) { u16* rowp = sg + (size_t)(row0 + ai * 128 + m * 16) * DM + col0;
#pragma unroll
                for (int bj = 0; bj < 2; ++bj) { f32x4 v0 = acc[ai][bj][m][0] + bv[bj][0], v1 = acc[ai][bj][m][1] + bv[bj][1];
#pragma unroll
                    for (int j = 0; j < 4; ++j) { v0[j] = sigmoidf_(v0[j]); v1[j] = sigmoidf_(v1[j]); }
                    u32x4 w; w.x = pk2(v0[0], v0[1]); w.y = pk2(v0[2], v0[3]); w.z = pk2(v1[0], v1[1]); w.w = pk2(v1[2], v1[3]);
                    *(u32x4*)(rowp + bj * 128) = w; } }
    }
};
template <int MODE  > struct EpiGate {
    static constexpr bool PERM = true, AFTER_DRAIN = false;
    const u16* sg; u16* tmp; u16* mrg;
    __device__ __forceinline__ void operator()(const f32x4 (&acc)[2][2][4][2], const pg8::Unit& u, int wr, int wc, int fr, int fq) const {
        const int row0 = u.pm * 256 + wr * 64 + fr, col0 = u.pn * 256 + wc * 32 + 8 * fq;
#pragma unroll
        for (int ai = 0; ai < 2; ++ai) {
            u32x4 sv[4][2], tv[4][2];
#pragma unroll
            for (int m = 0; m < 4; ++m) { const size_t off = (size_t)(row0 + ai * 128 + m * 16) * DM + col0;
#pragma unroll
                for (int bj = 0; bj < 2; ++bj) { sv[m][bj] = *(const u32x4*)(sg + off + bj * 128); if (MODE == 1) tv[m][bj] = *(const u32x4*)(tmp + off + bj * 128); } }
            __builtin_amdgcn_sched_barrier(0);
#pragma unroll
            for (int m = 0; m < 4; ++m) { const size_t off = (size_t)(row0 + ai * 128 + m * 16) * DM + col0;
#pragma unroll
                for (int bj = 0; bj < 2; ++bj) { const u32x4 s = sv[m][bj];
                    f32x4 v0 = acc[ai][bj][m][0], v1 = acc[ai][bj][m][1];
                    v0[0] *= bflo(s.x); v0[1] *= bfhi(s.x); v0[2] *= bflo(s.y); v0[3] *= bfhi(s.y); v1[0] *= bflo(s.z); v1[1] *= bfhi(s.z); v1[2] *= bflo(s.w); v1[3] *= bfhi(s.w);
                    if (MODE == 1) { const u32x4 t = tv[m][bj];
                        v0[0] += bflo(t.x); v0[1] += bfhi(t.x); v0[2] += bflo(t.y); v0[3] += bfhi(t.y); v1[0] += bflo(t.z); v1[1] += bfhi(t.z); v1[2] += bflo(t.w); v1[3] += bfhi(t.w); }
                    u32x4 w; w.x = pk2(v0[0], v0[1]); w.y = pk2(v0[2], v0[3]); w.z = pk2(v1[0], v1[1]); w.w = pk2(v1[2], v1[3]);
                    *(u32x4*)((MODE == 0 ? tmp : mrg) + off + bj * 128) = w; } }
            __builtin_amdgcn_sched_barrier(0);
        }
    }
};
struct EpiOut {
    static constexpr bool PERM = true, AFTER_DRAIN = false;
    const float* x; float* out;
    __device__ __forceinline__ void operator()(const f32x4 (&acc)[2][2][4][2], const pg8::Unit& u, int wr, int wc, int fr, int fq) const {
        const int row0 = u.pm * 256 + wr * 64 + fr, col0 = u.pn * 256 + wc * 32 + 8 * fq;
#pragma unroll
        for (int ai = 0; ai < 2; ++ai) {
            f32x4 xv[4][2][2];
#pragma unroll
            for (int m = 0; m < 4; ++m) { const size_t off = (size_t)(row0 + ai * 128 + m * 16) * DM + col0;
#pragma unroll
                for (int bj = 0; bj < 2; ++bj) { xv[m][bj][0] = *(const f32x4*)(x + off + bj * 128); xv[m][bj][1] = *(const f32x4*)(x + off + bj * 128 + 4); } }
            __builtin_amdgcn_sched_barrier(0);
#pragma unroll
            for (int m = 0; m < 4; ++m) { const size_t off = (size_t)(row0 + ai * 128 + m * 16) * DM + col0;
#pragma unroll
                for (int bj = 0; bj < 2; ++bj) { *(f32x4*)(out + off + bj * 128) = xv[m][bj][0] + acc[ai][bj][m][0]; *(f32x4*)(out + off + bj * 128 + 4) = xv[m][bj][1] + acc[ai][bj][m][1]; } }
            __builtin_amdgcn_sched_barrier(0);
        }
    }
};

typedef pg8::bf16x8 bf16x8;
__device__ __forceinline__ void load_conv(const u16* grow, float w0, float w1, float w2, float cb, u16* dst, int tid) {
#pragma unroll 2
    for (int k = 0; k < 8; ++k) { const int chunk = tid + 512 * k, b = chunk >> 8, t8 = (chunk & 255) * 8; const u16* p = grow + b * SEQ + t8;
        const u32x4 wq = __builtin_nontemporal_load((const u32x4*)p); const uint4 w = (uint4){wq.x, wq.y, wq.z, wq.w}; const float pm = t8 > 0 ? bf2f(p[-1]) : 0.f, pn = t8 + 8 < SEQ ? bf2f(p[8]) : 0.f;
        const float e0 = bflo(w.x), e1 = bfhi(w.x), e2 = bflo(w.y), e3 = bfhi(w.y), e4 = bflo(w.z), e5 = bfhi(w.z), e6 = bflo(w.w), e7 = bfhi(w.w);
        uint4 r; r.x = pk2(cb + w0 * pm + w1 * e0 + w2 * e1, cb + w0 * e0 + w1 * e1 + w2 * e2); r.y = pk2(cb + w0 * e1 + w1 * e2 + w2 * e3, cb + w0 * e2 + w1 * e3 + w2 * e4);
        r.z = pk2(cb + w0 * e3 + w1 * e4 + w2 * e5, cb + w0 * e4 + w1 * e5 + w2 * e6); r.w = pk2(cb + w0 * e5 + w1 * e6 + w2 * e7, cb + w0 * e6 + w1 * e7 + w2 * pn);
        *(uint4*)(dst + b * UP + t8) = r; }
}
__device__ __forceinline__ void build_kr(const u16* kb, u16* KR, int tid) {
#pragma unroll
    for (int k = 0; k < 8; ++k) { const int ch = tid + 512 * k, sg = ch >> 9, x8 = (ch & 511) * 8;
        u32x4u w = (u32x4u){0u, 0u, 0u, 0u};
        if (x8 != 0) w = *(const u32x4u*)(kb + x8 - sg);
        *(uint4*)(KR + sg * KRP + x8) = (uint4){w.x, w.y, w.z, w.w}; }
}
__device__ __forceinline__ void conv_mfma(PG8_LAS const unsigned char* KRb, PG8_LAS const unsigned char* Ub, int wid, int lane, f32x4 (&acc)[16]) {
    const int i = lane & 15, q = lane >> 4, T0 = wid * 16;
    const int abase = (i & 7) * (KRP * 2) + (8 * (q - (i >> 3)) + 2048) * 2;
    const int bbase = i * (UP * 2) + 16 * q;
#pragma unroll
    for (int t = 0; t < 16; ++t) acc[t] = (f32x4){0.f, 0.f, 0.f, 0.f};
#pragma unroll 1
    for (int sr = 0; sr < 4; ++sr) {
        const int S0 = sr * 16;
        bf16x8 Bf[16];
#pragma unroll
        for (int sl = 0; sl < 16; ++sl) Bf[sl] = *(PG8_LAS const bf16x8*)(Ub + bbase + 64 * (S0 + sl));
        PG8_LAS const unsigned char* ap = KRb + (abase - 32 * (T0 - 2 * S0) - 480);
#pragma unroll
        for (int dl = -30; dl <= 15; ++dl) {
            const bf16x8 a = *(PG8_LAS const bf16x8*)(ap + 32 * (15 - dl));
#pragma unroll
            for (int sl = 0; sl < 16; ++sl) { const int t = dl + 2 * sl; if (t >= 0 && t < 16) acc[t] = __builtin_amdgcn_mfma_f32_16x16x32_bf16(a, Bf[sl], acc[t], 0, 0, 0); }
        }
    }
}
__device__ __forceinline__ void hy_epilogue(const f32x4 (&acc)[16], const u16* X, u16* U, float skip, int wid, int lane) {
    const int b = lane & 15, q = lane >> 4;
#pragma unroll
    for (int tl = 0; tl < 16; ++tl) { const int t = 16 * (wid * 16 + tl) + 4 * q;
        const uint2 xv = *(const uint2*)(X + b * UP + t), uv = *(const uint2*)(U + b * UP + t); uint2 r;
        r.x = pk2(bflo(xv.x) * (acc[tl][0] + bflo(uv.x) * skip), bfhi(xv.x) * (acc[tl][1] + bfhi(uv.x) * skip));
        r.y = pk2(bflo(xv.y) * (acc[tl][2] + bflo(uv.y) * skip), bfhi(xv.y) * (acc[tl][3] + bfhi(uv.y) * skip));
        *(uint2*)(U + b * UP + t) = r; }
}
__device__ __forceinline__ unsigned touch64k(const u16* blk, int tid) { return *(const unsigned*)(blk + tid * 64); }
__device__ void hyena_mfma(const Frame& F, unsigned char* lds, bool do_store = true) {
    int tid = threadIdx.x; asm volatile("" : "+v"(tid));
    const int lane = tid & 63, wid = __builtin_amdgcn_readfirstlane(tid >> 6);
    u16* KR = (u16*)lds; u16* U = (u16*)(lds + 8 * KRP * 2);
    PG8_LAS const unsigned char* KRb = (PG8_LAS const unsigned char*)lds; PG8_LAS const unsigned char* Ub = KRb + 8 * KRP * 2;
    const u16* KB = (const u16*)(F.dob + DO_HF);
    u16* HYT = (u16*)(F.ws + WS_HYT);
    for (int c = blockIdx.x; c < HYW; c += gridDim.x) {
        const float wv0 = F.conv_w[c], wv1 = F.conv_w[NHY + c], wv2 = F.conv_w[2 * NHY + c], cbv = F.conv_b[c];
        const float wa0 = F.conv_w[HYW + c], wa1 = F.conv_w[NHY + HYW + c], wa2 = F.conv_w[2 * NHY + HYW + c], cba = F.conv_b[HYW + c];
        const float wb0 = F.conv_w[2 * HYW + c], wb1 = F.conv_w[NHY + 2 * HYW + c], wb2 = F.conv_w[2 * NHY + 2 * HYW + c], cbb = F.conv_b[2 * HYW + c];
        const float skip0 = F.skip[c], skip1 = F.skip[HYW + c];
        f32x4 acc[16];
        __syncthreads();
        load_conv(HYT + (size_t)c * MTOK, wv0, wv1, wv2, cbv, U, tid);
        build_kr(KB + (size_t)(0 * HYW + c) * KBL, KR, tid);
        unsigned tc0 = touch64k(HYT + (size_t)(HYW + c) * MTOK, tid), tc1 = tid < 65 ? touch64k(KB + (size_t)(HYW + c) * KBL, tid) : 0u;
        __syncthreads();
        conv_mfma(KRb, Ub, wid, lane, acc);
        asm volatile("" :: "v"(tc0), "v"(tc1));
        __syncthreads();
        load_conv(HYT + (size_t)(HYW + c) * MTOK, wa0, wa1, wa2, cba, KR, tid);
        __syncthreads();
        hy_epilogue(acc, KR, U, skip0, wid, lane);
        __syncthreads();
        build_kr(KB + (size_t)(1 * HYW + c) * KBL, KR, tid);
        { const int cn = c + (int)gridDim.x < HYW ? c + (int)gridDim.x : c;
          tc0 = touch64k(HYT + (size_t)(2 * HYW + c) * MTOK, tid); tc1 = touch64k(HYT + (size_t)cn * MTOK, tid); }
        __syncthreads();
        conv_mfma(KRb, Ub, wid, lane, acc);
        asm volatile("" :: "v"(tc0), "v"(tc1));
        __syncthreads();
        load_conv(HYT + (size_t)(2 * HYW + c) * MTOK, wb0, wb1, wb2, cbb, KR, tid);
        __syncthreads();
        hy_epilogue(acc, KR, U, skip1, wid, lane);
        __syncthreads();
        if (do_store)
#pragma unroll 2
        for (int k = 0; k < 8; ++k) { const int chunk = tid + 512 * k, b = chunk >> 8, t8 = (chunk & 255) * 8;
            __builtin_nontemporal_store(*(const u32x4*)(U + b * UP + t8), (u32x4*)(HYT + (size_t)c * MTOK + b * SEQ + t8)); }
    }
    __syncthreads();
}

constexpr size_t DO_LG = 111 * MiB;
__device__ __forceinline__ uint4 pk8(const float (&v)[8]) { uint4 r; r.x = pk2(v[0], v[1]); r.y = pk2(v[2], v[3]); r.z = pk2(v[4], v[5]); r.w = pk2(v[6], v[7]); return r; }
__device__ __forceinline__ void up8(const uint4 w, float (&v)[8]) { v[0] = bflo(w.x); v[1] = bfhi(w.x); v[2] = bflo(w.y); v[3] = bfhi(w.y); v[4] = bflo(w.z); v[5] = bfhi(w.z); v[6] = bflo(w.w); v[7] = bfhi(w.w); }
__device__ __forceinline__ bf16x8 as_frag(const uint4 w) { union { uint4 u; bf16x8 f; } c; c.u = w; return c.f; }
struct AChunk { uint4 k[2][2]; uint4 v[4]; };
typedef short s16x4 __attribute__((ext_vector_type(4)));
__device__ void attn_mfma(const Frame& F, unsigned char* lds, bool do_store = true) {
    int tid = threadIdx.x; asm volatile("" : "+v"(tid));
    const int lane = tid & 63, wid = __builtin_amdgcn_readfirstlane(tid >> 6), c16 = lane & 15, q = lane >> 4;
    u16* QKV = (u16*)(F.ws + WS_QKV); float* LG = (float*)(F.dob + DO_LG);
    unsigned char* Vs = lds + wid * 5120;
    PG8_LAS const unsigned char* Vs3 = (PG8_LAS const unsigned char*)Vs;
    const int krow_off = 8 * (c16 >> 2) + (c16 & 3);
    const int tr_off = (8 * q + (c16 >> 2)) * 144 + 8 * (lane & 3);
    const float LOG2E = 1.4426950408889634f;
    float gm = fabsf(F.qg[lane] * F.kg[lane]);
#pragma unroll
    for (int o = 32; o >= 1; o >>= 1) gm = fmaxf(gm, __shfl_xor(gm, o));
    const float cmax2 = 8.0f * gm * LOG2E;
    volatile PG8_LAS float* gqt = (volatile PG8_LAS float*)((PG8_LAS unsigned char*)lds + 8 * 5120);
    __syncthreads();
    if (tid < 64) gqt[tid] = F.qg[tid] * F.kg[tid] * (0.125f * LOG2E);
    __syncthreads();
    const int Gd = gridDim.x, vcu = (Gd % 8 == 0) ? ((int)blockIdx.x % 8) * (Gd / 8) + (int)blockIdx.x / 8 : (int)blockIdx.x;
    for (int item = vcu * 8 + wid; item < NB * 8 * 3 * 32; item += Gd * 8) {
        const int blk = item & 31, rest = item >> 5, g = rest % 3, bh = rest / 3, h = bh & 7, b = bh >> 3;
        const int dsh = 2 * g, n = SEQ >> dsh, nbn = 32 >> dsh, r = blk >> (5 - dsh), nb = blk & (nbn - 1);
        const float ca2 = exp2f(-(float)(h + 1)) * (float)(1 << dsh) * LOG2E;
        const size_t colq = (size_t)g * 512 + h * 64;
        const u16* base = QKV + (size_t)b * SEQ * NQKV;
        const int kc_lo = nb == 0 ? 2 : 0, kc_hi = nb == nbn - 1 ? 4 : 6;
        auto load_chunk = [&](AChunk& c, int j0c) {
#pragma unroll
            for (int kt = 0; kt < 2; ++kt) { int jk = j0c + 4 * kt + krow_off; jk = jk < 0 ? 0 : (jk > n - 1 ? n - 1 : jk);
                const u16* krow = base + (size_t)((jk << dsh) + r) * NQKV + 1536 + colq;
                c.k[kt][0] = *(const uint4*)(krow + 8 * q); c.k[kt][1] = *(const uint4*)(krow + 32 + 8 * q); }
            int jv = j0c + (lane >> 1); jv = jv < 0 ? 0 : (jv > n - 1 ? n - 1 : jv);
            const u16* vrow = base + (size_t)((jv << dsh) + r) * NQKV + 3072 + colq + 32 * (lane & 1);
#pragma unroll
            for (int v4 = 0; v4 < 4; ++v4) c.v[v4] = *(const uint4*)(vrow + 8 * v4);
        };
        AChunk cur;
        bf16x8 Qf[4][2];
#pragma unroll
        for (int qt = 0; qt < 4; ++qt) { const int i = 64 * nb + 16 * qt + c16; const u16* qrow = base + (size_t)((i << dsh) + r) * NQKV + colq;
            float v0[8], v1[8]; up8(*(const uint4*)(qrow + 8 * q), v0); up8(*(const uint4*)(qrow + 32 + 8 * q), v1);
            float ss = 0.f;
#pragma unroll
            for (int e = 0; e < 8; ++e) ss += v0[e] * v0[e] + v1[e] * v1[e];
            ss += __shfl_xor(ss, 16); ss += __shfl_xor(ss, 32);
            const float rq = rsqrtf(ss * (1.0f / 64.0f) + 1e-6f);
#pragma unroll
            for (int e = 0; e < 8; ++e) { v0[e] *= rq * gqt[8 * q + e]; v1[e] *= rq * gqt[32 + 8 * q + e]; }
            Qf[qt][0] = as_frag(pk8(v0)); Qf[qt][1] = as_frag(pk8(v1)); }
        f32x4 Oacc[4][4]; f32x4 Lacc[4];
#pragma unroll
        for (int dt = 0; dt < 4; ++dt)
#pragma unroll
            for (int qt = 0; qt < 4; ++qt) Oacc[dt][qt] = (f32x4){0.f, 0.f, 0.f, 0.f};
#pragma unroll
        for (int qt = 0; qt < 4; ++qt) Lacc[qt] = (f32x4){0.f, 0.f, 0.f, 0.f};
#pragma unroll 1
        for (int kc = kc_lo; kc < kc_hi; ++kc) {
            const int j0c = 64 * (nb - 1) + 32 * kc;
            load_chunk(cur, j0c);
            unsigned tch0 = 0, tch1 = 0;
            if (kc + 1 < kc_hi) {
                int jk = j0c + 32 + (lane >> 1); jk = jk < 0 ? 0 : (jk > n - 1 ? n - 1 : jk);
                const u16* rowp = base + (size_t)((jk << dsh) + r) * NQKV + colq + ((lane & 1) ? 3072 : 1536);
                tch0 = *(const unsigned*)rowp; }
            { unsigned char* dst = Vs + (lane >> 1) * 144 + (lane & 1) * 64;
#pragma unroll
              for (int v4 = 0; v4 < 4; ++v4) *(uint4*)(dst + 16 * v4) = cur.v[v4]; }
            bf16x8 kf[2][2];
#pragma unroll
            for (int kt = 0; kt < 2; ++kt) {
                float v0[8], v1[8]; up8(cur.k[kt][0], v0); up8(cur.k[kt][1], v1);
                float ss = 0.f;
#pragma unroll
                for (int e = 0; e < 8; ++e) ss += v0[e] * v0[e] + v1[e] * v1[e];
                ss += __shfl_xor(ss, 16); ss += __shfl_xor(ss, 32);
                const float rk = rsqrtf(ss * (1.0f / 64.0f) + 1e-6f);
#pragma unroll
                for (int e = 0; e < 8; ++e) { v0[e] *= rk; v1[e] *= rk; }
                kf[kt][0] = as_frag(pk8(v0)); kf[kt][1] = as_frag(pk8(v1)); }
            bf16x8 Pf[4];
            int rel0 = 64 + c16 - 8 * q - 32 * kc;
            asm volatile("" : "+v"(rel0));
            const float relf0 = (float)rel0;
            const bool edge = (kc < 2) || (kc > 3);
#pragma unroll
            for (int qt = 0; qt < 4; ++qt) { float p[8];
#pragma unroll
                for (int kt = 0; kt < 2; ++kt) { f32x4 z = (f32x4){-cmax2, -cmax2, -cmax2, -cmax2};
                    z = __builtin_amdgcn_mfma_f32_16x16x32_bf16(kf[kt][0], Qf[qt][0], z, 0, 0, 0);
                    z = __builtin_amdgcn_mfma_f32_16x16x32_bf16(kf[kt][1], Qf[qt][1], z, 0, 0, 0);
#pragma unroll
                    for (int j = 0; j < 4; ++j) { const float dist = fabsf(relf0 + (float)(16 * qt - 4 * kt - j));
                        const float pv = __builtin_amdgcn_exp2f(z[j] - ca2 * dist);
                        p[4 * kt + j] = (edge && dist > 64.0f) ? 0.f : pv; } }
                Pf[qt] = as_frag(pk8(p)); }
            asm volatile("" ::: "memory");
#pragma unroll
            for (int dt = 0; dt < 4; ++dt) {
                const s16x4 a0 = __builtin_amdgcn_ds_read_tr16_b64_v4i16((PG8_LAS s16x4*)(Vs3 + tr_off + 32 * dt));
                const s16x4 a1 = __builtin_amdgcn_ds_read_tr16_b64_v4i16((PG8_LAS s16x4*)(Vs3 + tr_off + 4 * 144 + 32 * dt));
                const bf16x8 vf = __builtin_shufflevector(a0, a1, 0, 1, 2, 3, 4, 5, 6, 7);
#pragma unroll
                for (int qt = 0; qt < 4; ++qt) Oacc[dt][qt] = __builtin_amdgcn_mfma_f32_16x16x32_bf16(vf, Pf[qt], Oacc[dt][qt], 0, 0, 0); }
            { const bf16x8 ones = (bf16x8){0x3F80, 0x3F80, 0x3F80, 0x3F80, 0x3F80, 0x3F80, 0x3F80, 0x3F80};
#pragma unroll
              for (int qt = 0; qt < 4; ++qt) Lacc[qt] = __builtin_amdgcn_mfma_f32_16x16x32_bf16(ones, Pf[qt], Lacc[qt], 0, 0, 0); }
            asm volatile("" :: "v"(tch0), "v"(tch1) : "memory");
        }
        if (do_store)
#pragma unroll
        for (int qt = 0; qt < 4; ++qt) { const int i = 64 * nb + 16 * qt + c16, tok = (i << dsh) + r;
            const float lt = Lacc[qt][0];
            u16* orow = QKV + (size_t)(b * SEQ + tok) * NQKV + colq;
#pragma unroll
            for (int dp = 0; dp < 2; ++dp) {
                const unsigned ax = pk2(Oacc[2 * dp][qt][0], Oacc[2 * dp][qt][1]), ay = pk2(Oacc[2 * dp][qt][2], Oacc[2 * dp][qt][3]);
                const unsigned bx = pk2(Oacc[2 * dp + 1][qt][0], Oacc[2 * dp + 1][qt][1]), by = pk2(Oacc[2 * dp + 1][qt][2], Oacc[2 * dp + 1][qt][3]);
                const auto r0 = __builtin_amdgcn_permlane16_swap(ax, bx, false, false);
                const auto r1 = __builtin_amdgcn_permlane16_swap(ay, by, false, false);
                const int doff = (q & 1) ? 16 * (2 * dp + 1) + 4 * (q - 1) : 16 * (2 * dp) + 4 * q;
                *(uint4*)(orow + doff) = make_uint4(r0[0], r1[0], r0[1], r1[1]); }
            if (q == 0) LG[((size_t)g * MTOK + b * SEQ + tok) * 8 + h] = lt; }
    }
    __syncthreads();
}
__device__ void attn_combine(const Frame& F) {
    const u16* QKV = (const u16*)(F.ws + WS_QKV); const float* LG = (const float*)(F.dob + DO_LG); u16* ATG = (u16*)(F.ws + WS_ATG);
    const int stride = gridDim.x * 512;
    for (int idx0 = blockIdx.x * 512 + F.tid; idx0 < MTOK * 64; idx0 += 4 * stride) {
        uint4 q0[4], q1[4], q2[4], gv[4]; float l0[4], l1[4], l2[4];
#pragma unroll
        for (int u = 0; u < 4; ++u) { const int idx = idx0 + u * stride;
            if (idx < MTOK * 64) { const int m = idx >> 6, cc = (idx & 63) * 8, h = cc >> 6; const u16* qrow = QKV + (size_t)m * NQKV + cc;
                q0[u] = *(const uint4*)qrow; q1[u] = *(const uint4*)(qrow + 512); q2[u] = *(const uint4*)(qrow + 1024); gv[u] = *(const uint4*)(ATG + (size_t)m * ATW + cc);
                l0[u] = LG[(size_t)m * 8 + h]; l1[u] = LG[((size_t)MTOK + m) * 8 + h]; l2[u] = LG[((size_t)2 * MTOK + m) * 8 + h]; } }
#pragma unroll
        for (int u = 0; u < 4; ++u) { const int idx = idx0 + u * stride;
            if (idx < MTOK * 64) { const int m = idx >> 6, cc = (idx & 63) * 8;
                float o0[8], o1[8], o2[8], gt[8]; up8(q0[u], o0); up8(q1[u], o1); up8(q2[u], o2); up8(gv[u], gt);
                const float il = 1.0f / (l0[u] + l1[u] + l2[u]);
#pragma unroll
                for (int e = 0; e < 8; ++e) o0[e] = (o0[e] + o1[e] + o2[e]) * il * gt[e];
                *(uint4*)(ATG + (size_t)m * ATW + cc) = pk8(o0); } }
    }
}

__device__ void p2b_transpose(const Frame& F, unsigned char* lds) {
    const int tid = F.tid; u16* tl = (u16*)lds;
    const u16* HYT = (const u16*)(F.ws + WS_HYT); const u16* HYG = (const u16*)(F.ws + WS_HYG); u16* YH = (u16*)(F.ws + WS_YH);
    const int cl = tid >> 3, mc = (tid & 7) * 8, ml = tid >> 3, cc = (tid & 7) * 8;
    for (int base = blockIdx.x; base < 12 * 512; base += 4 * gridDim.x) {
        u32x4 wq[4], gq[4];
#pragma unroll
        for (int u = 0; u < 4; ++u) { const int tile = base + u * gridDim.x;
            if (tile < 12 * 512) { const int c0 = (tile % 12) * 64, m0 = (tile / 12) * 64;
                wq[u] = __builtin_nontemporal_load((const u32x4*)(HYT + (size_t)(c0 + cl) * MTOK + m0 + mc));
                gq[u] = *(const u32x4*)(HYG + (size_t)(m0 + ml) * HYW + c0 + cc); } }
#pragma unroll
        for (int u = 0; u < 4; ++u) { const int tile = base + u * gridDim.x;
            if (tile < 12 * 512) { u16* t = tl + u * (64 * 72); const u32x4 w = wq[u];
                t[(mc + 0) * 72 + cl] = (u16)(w.x & 0xffff); t[(mc + 1) * 72 + cl] = (u16)(w.x >> 16); t[(mc + 2) * 72 + cl] = (u16)(w.y & 0xffff); t[(mc + 3) * 72 + cl] = (u16)(w.y >> 16);
                t[(mc + 4) * 72 + cl] = (u16)(w.z & 0xffff); t[(mc + 5) * 72 + cl] = (u16)(w.z >> 16); t[(mc + 6) * 72 + cl] = (u16)(w.w & 0xffff); t[(mc + 7) * 72 + cl] = (u16)(w.w >> 16); } }
        __syncthreads();
#pragma unroll
        for (int u = 0; u < 4; ++u) { const int tile = base + u * gridDim.x;
            if (tile < 12 * 512) { const int c0 = (tile % 12) * 64, m0 = (tile / 12) * 64; const u16* t = tl + u * (64 * 72);
                const uint4 y = *(const uint4*)&t[ml * 72 + cc]; const u32x4 g = gq[u];
                uint4 r; r.x = pk2(bflo(y.x) * bflo(g.x), bfhi(y.x) * bfhi(g.x)); r.y = pk2(bflo(y.y) * bflo(g.y), bfhi(y.y) * bfhi(g.y));
                r.z = pk2(bflo(y.z) * bflo(g.z), bfhi(y.z) * bfhi(g.z)); r.w = pk2(bflo(y.w) * bflo(g.w), bfhi(y.w) * bfhi(g.w));
                __builtin_nontemporal_store((u32x4){r.x, r.y, r.z, r.w}, (u32x4*)(YH + (size_t)(m0 + ml) * HYW + c0 + cc)); } }
        __syncthreads();
    }
    transpose_weight(F.w_out, DM, DM, (u16*)(F.ws + WS_WOUT), tl, tid);
}


__device__ unsigned g_bar[8 * 64 + 64 + 8 * 64];
__device__ __forceinline__ unsigned gb_ld(unsigned* p) { return __hip_atomic_load(p, __ATOMIC_RELAXED, __HIP_MEMORY_SCOPE_AGENT); }
__device__ __forceinline__ unsigned gb_add(unsigned* p) { return __hip_atomic_fetch_add(p, 1u, __ATOMIC_RELAXED, __HIP_MEMORY_SCOPE_AGENT); }
__device__ __forceinline__ void grid_bar() {
    asm volatile("s_waitcnt vmcnt(0) lgkmcnt(0)" ::: "memory");
    __syncthreads();
    if (threadIdx.x == 0) {
        __builtin_amdgcn_fence(__ATOMIC_RELEASE, "agent");
        asm volatile("s_waitcnt vmcnt(0)" ::: "memory");
        const unsigned G = gridDim.x, ng = (G % 8u == 0u) ? 8u : 1u, n = G / ng, g = blockIdx.x % ng;
        const unsigned old = gb_add(&g_bar[g * 64]), gen = old / n;
        if (old % n == n - 1u) {
            const unsigned t = gb_add(&g_bar[512]), want = (t / ng + 1u) * ng;
            while ((int)(gb_ld(&g_bar[512]) - want) < 0) __builtin_amdgcn_s_sleep(10);
            gb_add(&g_bar[576 + g * 64]);
        } else {
            while ((int)(gb_ld(&g_bar[576 + g * 64]) - (gen + 1u)) < 0) __builtin_amdgcn_s_sleep(40);
        }
        __builtin_amdgcn_fence(__ATOMIC_ACQUIRE, "agent");
        asm volatile("s_waitcnt vmcnt(0)" ::: "memory");
    }
    __syncthreads();
}

__global__ void __launch_bounds__(512) mk_fwd(Args args) {
    extern __shared__ __attribute__((aligned(16))) unsigned char lds[];
    cg::grid_group grid = cg::this_grid();
    Frame F;
    F.x = args.in[0]; F.norm_g = args.in[1]; F.w_in = args.in[2]; F.b_in = args.in[3]; F.conv_w = args.in[4]; F.conv_b = args.in[5];
    F.w1 = args.in[6]; F.b1 = args.in[7]; F.w2 = args.in[8]; F.b2 = args.in[9]; F.w3 = args.in[10]; F.b3 = args.in[11]; F.w4 = args.in[12]; F.freq = args.in[13];
    F.skip = args.in[14]; F.qg = args.in[15]; F.kg = args.in[16]; F.w_hy = args.in[17]; F.w_at = args.in[18]; F.w_out = args.in[19];
    F.out = args.out; F.ws = args.ws; F.dob = (unsigned char*)args.out;
    F.tid = threadIdx.x; F.lane = F.tid & 63; F.wid = __builtin_amdgcn_readfirstlane(F.tid >> 6);
    const int lo = args.ph_lo, hi = args.ph_hi;
    PG8_LAS unsigned char* ldsa = (PG8_LAS unsigned char*)lds;
    const int G = gridDim.x, c = blockIdx.x;
#ifdef ONLY
#define IN(k) ((k) == ONLY && lo <= (k) && (k) < hi)
#elif defined(SKIP)
#define IN(k) ((k) != SKIP && lo <= (k) && (k) < hi)
#else
#define IN(k) (lo <= (k) && (k) < hi)
#endif
#define SEAM(k) do { if (IN(k) && IN((k) + 1)) { if (hi > 100) grid.sync(); else grid_bar(); } } while (0)
#ifdef REPEAT
#define NREP(k) ((k) == REPEAT ? 2 : 1)
#else
#define NREP(k) 1
#endif
    if (IN(0)) for (int rep = 0; rep < NREP(0); ++rep) p0_prologue(F, lds);
    SEAM(0);
    if (IN(1)) for (int rep = 0; rep < NREP(1); ++rep) {
        pg8::Gemm g{(const u16*)(F.dob + DO_XN), (const u16*)(F.dob + DO_WIN), MTOK, 8192, DM}; pg8::StaticOrder S; S.init(MTOK, 8192, G, c);
        Epi1 E{(u16*)(F.ws + WS_HYT), (u16*)(F.ws + WS_QKV), (u16*)(F.ws + WS_HYG), (u16*)(F.ws + WS_ATG), F.b_in, ldsa + 131072};
        pg8::gemm_phase<Epi1, pg8::StaticOrder>(ldsa, g, S, E, nullptr);
    }
    SEAM(1);
    if (IN(2)) {
#if defined(REPEAT) && REPEAT == 2
        hyena_mfma(F, lds, hi > 100);
#endif
        hyena_mfma(F, lds);
#if defined(REPEAT) && REPEAT == 6
        attn_mfma(F, lds, hi > 100);
#endif
        attn_mfma(F, lds);
#if defined(REPEAT) && REPEAT == 7
        for (int k = 0; k < 5; ++k) grid.sync();
#endif
    }
    SEAM(2);
    if (IN(3)) { for (int rep = 0; rep < NREP(3); ++rep) p2b_transpose(F, lds); attn_combine(F); }
    SEAM(3);
    if (IN(4)) for (int rep = 0; rep < NREP(4); ++rep) {
        pg8::StaticOrder S; S.init(MTOK, DM, G, c);
        { pg8::Gemm g{(const u16*)(F.dob + DO_XN), (const u16*)(F.dob + DO_WIN) + (size_t)8192 * DM, MTOK, DM, DM}; EpiSig E{(u16*)(F.ws + WS_SG), F.b_in + 8192};
          pg8::gemm_phase<EpiSig, pg8::StaticOrder>(ldsa, g, S, E, nullptr); }
        { pg8::Gemm g{(const u16*)(F.ws + WS_YH), (const u16*)(F.dob + DO_WHY), MTOK, DM, HYW}; EpiGate<0> E{(const u16*)(F.ws + WS_SG), (u16*)(F.ws + WS_TMP), nullptr};
          pg8::gemm_phase<EpiGate<0>, pg8::StaticOrder>(ldsa, g, S, E, nullptr); }
        { pg8::Gemm g{(const u16*)(F.dob + DO_XN), (const u16*)(F.dob + DO_WIN) + (size_t)9216 * DM, MTOK, DM, DM}; EpiSig E{(u16*)(F.ws + WS_SG), F.b_in + 9216};
          pg8::gemm_phase<EpiSig, pg8::StaticOrder>(ldsa, g, S, E, nullptr); }
        { pg8::Gemm g{(const u16*)(F.ws + WS_ATG), (const u16*)(F.dob + DO_WAT), MTOK, DM, ATW}; EpiGate<1> E{(const u16*)(F.ws + WS_SG), (u16*)(F.ws + WS_TMP), (u16*)(F.ws + WS_MRG)};
          pg8::gemm_phase<EpiGate<1>, pg8::StaticOrder>(ldsa, g, S, E, nullptr); }
    }
    SEAM(4);
    if (IN(5)) for (int rep = 0; rep < NREP(5); ++rep) {
        pg8::Gemm g{(const u16*)(F.ws + WS_MRG), (const u16*)(F.ws + WS_WOUT), MTOK, DM, DM}; pg8::StaticOrder S; S.init(MTOK, DM, G, c);
        EpiOut E{F.x, F.out};
        pg8::gemm_phase<EpiOut, pg8::StaticOrder>(ldsa, g, S, E, nullptr);
    }
#undef IN
#undef SEAM
}

extern "C" void kernel_launch(void* const* d_in, const int* in_sizes, int n_in, void* d_out, int out_size, void* d_ws, size_t ws_size, hipStream_t stream) {
    static int grid = 0;
    if (grid == 0) {
        if (n_in != 20 || out_size != MTOK * DM || ws_size < WS_END) { fprintf(stderr, "kernel_launch: unexpected shapes (n_in %d out %d ws %zu)\n", n_in, out_size, ws_size); grid = -1; return; }
        int dev = 0, cus = 0, per_cu = 0;
        hipGetDevice(&dev); hipDeviceGetAttribute(&cus, hipDeviceAttributeMultiprocessorCount, dev);
        if (hipFuncSetAttribute((const void*)mk_fwd, hipFuncAttributeMaxDynamicSharedMemorySize, LDS_BYTES) != hipSuccess) { fprintf(stderr, "kernel_launch: hipFuncSetAttribute failed\n"); grid = -1; return; }
        if (hipOccupancyMaxActiveBlocksPerMultiprocessor(&per_cu, (const void*)mk_fwd, 512, LDS_BYTES) != hipSuccess || per_cu < 1) { fprintf(stderr, "kernel_launch: occupancy query failed (%d)\n", per_cu); per_cu = 1; }
        (void)hipGetLastError();
        grid = cus;
        if (grid != 256) fprintf(stderr, "kernel_launch: note: %d CUs\n", grid);
    }
    if (grid < 0) return;
    Args a{};
    for (int i = 0; i < 20; ++i) a.in[i] = (const float*)d_in[i];
    a.out = (float*)d_out; a.ws = (unsigned char*)d_ws;
#if ONE_LAUNCH
    a.ph_lo = 0; a.ph_hi = 6;
    void* kargs[] = {&a};
    hipError_t e = hipLaunchCooperativeKernel((const void*)mk_fwd, dim3(grid), dim3(512), kargs, LDS_BYTES, stream);
    if (e != hipSuccess) fprintf(stderr, "cooperative launch failed: %s (grid %d)\n", hipGetErrorString(e), grid);
#else
    for (int ph = 0; ph < 6; ++ph) { a.ph_lo = ph; a.ph_hi = ph + 1; hipLaunchKernelGGL(mk_fwd, dim3(grid), dim3(512), LDS_BYTES, stream, a); }
#endif
}
```
